# Optimizing an MI355X kernel written in HIP

```python
import math
import jax, jax.numpy as jnp
from jax import lax
import numpy as np

D_MODEL = 1024
BATCH = 4
SEQ = 4096
DEPTH = 4

GRID_W = 64
CTX_LEN = 256
N_BRANCH = 4
BRANCH_W = 512
RET_HEADS = 4
RET_DK = 128
RET_DV = 128
RET_CHUNK = 128
HY_ORDER = 2
HY_EMB = 33
HY_HID = 64
HY_FAST_PCT = 0.3
HY_SLOW_PCT = 1.5
HY_TARGET = 1e-2
ATT_HEADS = 4
ATT_KV_HEADS = 2
HEAD_DIM = 128
Q_BLOCK = 128
ROPE_THETA = 10000.0
FF_DENSE = 2816
N_EXPERTS = 8
TOP_K = 2
FF_EXPERT = 3584
MOE_BLOCK = 256
N_MOD = 6
ALPHA = (2 * DEPTH) ** 0.25
BETA = (8 * DEPTH) ** -0.25

A_W = 3 * BRANCH_W
R_W = 2 * RET_HEADS * RET_DK + 2 * RET_HEADS * RET_DV
H_W = (HY_ORDER + 1) * BRANCH_W
D_W = (ATT_HEADS + 2 * ATT_KV_HEADS) * HEAD_DIM
IN_W = A_W + R_W + H_W + D_W
IN_SPLITS = (A_W, A_W + R_W, A_W + R_W + H_W)
HY_FILT_OUT = HY_ORDER * 2 * BRANCH_W

kernel_name = "hybrid_dit_gated_branch_block"


def layer_norm(x, g, b, eps=1e-6):
    xf = x.astype(jnp.float32)
    mu = jnp.mean(xf, -1, keepdims=True)
    var = jnp.mean(jnp.square(xf - mu), -1, keepdims=True)
    return ((xf - mu) * lax.rsqrt(var + eps) * g + b).astype(x.dtype)


def rms_norm(x, g, eps=1e-6):
    xf = x.astype(jnp.float32)
    return (xf * lax.rsqrt(jnp.mean(xf * xf, -1, keepdims=True) + eps) * g).astype(x.dtype)


def head_norm(o, eps=1e-6):
    mu = jnp.mean(o, -1, keepdims=True)
    var = jnp.mean(jnp.square(o - mu), -1, keepdims=True)
    return (o - mu) * lax.rsqrt(var + eps)


def heads(z, n):
    b, l, _ = z.shape
    return z.reshape(b, l, n, -1).transpose(0, 2, 1, 3)


def merge_heads(z):
    b, n, l, d = z.shape
    return z.transpose(0, 2, 1, 3).reshape(b, l, n * d)


def flip(a):
    return a[:, :, ::-1]


def dwconv3(x, w, b):
    xp = jnp.pad(x, ((0, 0), (1, 1), (0, 0)))
    return xp[:, :-2] * w[0] + xp[:, 1:-1] * w[1] + xp[:, 2:] * w[2] + b


def axial_rope_tables(rows):
    row = jnp.repeat(jnp.arange(rows, dtype=jnp.float32), GRID_W)
    col = jnp.tile(jnp.arange(GRID_W, dtype=jnp.float32), rows)
    n_freq = HEAD_DIM // 4
    inv = ROPE_THETA ** (-jnp.arange(n_freq, dtype=jnp.float32) / n_freq)
    ang = jnp.stack([row[:, None] * inv, col[:, None] * inv], axis=1)
    return jnp.cos(ang), jnp.sin(ang)


def apply_rope(x, cos, sin):
    b, h, l, _ = x.shape
    xr = x.astype(jnp.float32).reshape(b, h, l, 2, 2, HEAD_DIM // 4)
    x1, x2 = xr[..., 0, :], xr[..., 1, :]
    o1 = x1 * cos - x2 * sin
    o2 = x2 * cos + x1 * sin
    return jnp.stack([o1, o2], axis=-2).reshape(x.shape).astype(x.dtype)


def short_conv_mixer(z, w, b):
    bg, cg, xv = jnp.split(z, 3, axis=-1)
    return bg * dwconv3(cg * xv, w, b)


def retention_scan(q, k, v, log_gamma, state0):
    b, h, l, _ = q.shape
    n = l // RET_CHUNK
    i = jnp.arange(RET_CHUNK, dtype=jnp.float32)
    lg = log_gamma.astype(jnp.float32)[:, None]
    rel = i[:, None] - i[None, :]
    intra = jnp.where(rel >= 0, jnp.exp(lg[..., None] * jnp.maximum(rel, 0.0)), 0.0)
    q_dec = jnp.exp(lg * (i + 1.0))[:, :, None]
    k_dec = jnp.exp(lg * (RET_CHUNK - 1.0 - i))[:, :, None]
    c_dec = jnp.exp(lg[:, 0] * RET_CHUNK)[:, None, None]

    def to_chunks(a):
        return a.reshape(b, h, n, RET_CHUNK, a.shape[-1]).transpose(2, 0, 1, 3, 4)

    def step(state, inp):
        qc, kc, vc = inp
        s = jnp.einsum('bhid,bhjd->bhij', qc, kc) * intra
        o = jnp.einsum('bhij,bhjv->bhiv', s, vc) + jnp.einsum('bhid,bhdv->bhiv', qc * q_dec, state)
        state = c_dec * state + jnp.einsum('bhjd,bhjv->bhdv', kc * k_dec, vc)
        return state, o

    state, o = lax.scan(step, state0, (to_chunks(q), to_chunks(k), to_chunks(v)))
    return o.transpose(1, 2, 0, 3, 4).reshape(b, h, l, v.shape[-1]), state


def retention_out(o, g):
    return jax.nn.silu(g) * merge_heads(head_norm(o)).astype(g.dtype)


def retention_mixer(z, zc, cos, sin, log_gamma, need_ctx):
    hk, hv = RET_HEADS * RET_DK, RET_HEADS * RET_DV

    def prep(zz, rotate):
        q, k, v, g = jnp.split(zz, (hk, 2 * hk, 2 * hk + hv), axis=-1)
        q = heads(q, RET_HEADS).astype(jnp.float32)
        k = heads(k, RET_HEADS).astype(jnp.float32) * RET_DK ** -0.5
        v = heads(v, RET_HEADS).astype(jnp.float32)
        if rotate:
            q, k = apply_rope(q, cos, sin), apply_rope(k, cos, sin)
        return q, k, v, g

    q, k, v, g = prep(z, True)
    qc, kc, vc, gc = prep(zc, False)
    zero = jnp.zeros((z.shape[0], RET_HEADS, RET_DK, RET_DV), jnp.float32)
    oc_f, st_f = retention_scan(qc, kc, vc, log_gamma[0], zero)
    oc_b, st_b = retention_scan(flip(qc), flip(kc), flip(vc), log_gamma[1], zero)
    o_f, _ = retention_scan(q, k, v, log_gamma[0], st_f)
    o_b, _ = retention_scan(flip(q), flip(k), flip(v), log_gamma[1], st_b)
    y = retention_out(o_f + flip(o_b), g)
    yc = retention_out(oc_f + flip(oc_b), gc) if need_ctx else None
    return y, yc


def hyena_filters(l, w1, b1, w2, b2, w3, freq):
    t = jnp.linspace(0.0, 1.0, l, dtype=jnp.float32)[:, None]
    bands = (HY_EMB - 1) // 2
    w = 2.0 * math.pi * jnp.arange(l, dtype=jnp.float32) / l
    f = jnp.linspace(1e-4, bands - 1, bands, dtype=jnp.float32)
    ang = w[:, None] * f[None, :]
    feats = jnp.concatenate([t, jnp.cos(ang), -jnp.sin(ang)], axis=-1)
    hdn = jnp.sin(freq[0] * (feats @ w1 + b1))
    hdn = jnp.sin(freq[1] * (hdn @ w2 + b2))
    filt = (hdn @ w3).astype(jnp.float32)
    max_decay = math.log(HY_TARGET) / HY_FAST_PCT
    min_decay = math.log(HY_TARGET) / HY_SLOW_PCT
    deltas = jnp.linspace(min_decay, max_decay, HY_FILT_OUT, dtype=jnp.float32)
    filt = filt * jnp.exp(-t * jnp.abs(deltas))
    return filt.reshape(l, HY_ORDER, 2, BRANCH_W).transpose(1, 2, 0, 3)


def bidir_fftconv(u, hf, hb):
    l = u.shape[1]
    filt = jnp.concatenate([hf, jnp.zeros_like(hf[:1]), hb[:0:-1]], axis=0)
    ff = jnp.fft.rfft(filt, axis=0)
    uf = jnp.fft.rfft(u, n=2 * l, axis=1)
    return jnp.fft.irfft(uf * ff, n=2 * l, axis=1)[:, :l]


def hyena_mixer(z, conv_w, conv_b, filt, skip):
    z = dwconv3(z, conv_w, conv_b)
    v, x1, x2 = jnp.split(z, 3, axis=-1)
    y = v.astype(jnp.float32)
    for o, gate in enumerate((x1, x2)):
        y = gate.astype(jnp.float32) * (bidir_fftconv(y, filt[o, 0], filt[o, 1]) + skip[o] * y)
    return y.astype(z.dtype)


def attention_mixer(z, zc, cos, sin, gq, gk, need_ctx):
    qw, kw = ATT_HEADS * HEAD_DIM, ATT_KV_HEADS * HEAD_DIM
    grp = ATT_HEADS // ATT_KV_HEADS
    scale = HEAD_DIM ** -0.5

    def prep(zz):
        q, k, v = jnp.split(zz, (qw, qw + kw), axis=-1)
        q = rms_norm(heads(q, ATT_HEADS), gq)
        k = rms_norm(heads(k, ATT_KV_HEADS), gk)
        return q, k, heads(v, ATT_KV_HEADS)

    def group(a):
        b, _, l, d = a.shape
        return a.reshape(b, ATT_KV_HEADS, grp, l, d)

    def attend(qg, keys, vals):
        s = jnp.einsum('bkgqd,bksd->bkgqs', qg, keys).astype(jnp.float32) * scale
        p = jax.nn.softmax(s, axis=-1).astype(vals.dtype)
        return jnp.einsum('bkgqs,bksd->bkgqd', p, vals)

    q, k, v = prep(z)
    qc, kc, vc = prep(zc)
    q, k = apply_rope(q, cos, sin), apply_rope(k, cos, sin)
    b, _, l, _ = q.shape
    nb = l // Q_BLOCK
    k_all = jnp.concatenate([k, kc], axis=2)
    v_all = jnp.concatenate([v, vc], axis=2)
    qb = group(q).reshape(b, ATT_KV_HEADS, grp, nb, Q_BLOCK, HEAD_DIM).transpose(3, 0, 1, 2, 4, 5)
    ob = lax.map(lambda qi: attend(qi, k_all, v_all), qb)
    y = merge_heads(ob.transpose(1, 2, 3, 0, 4, 5).reshape(b, ATT_HEADS, l, HEAD_DIM))
    if not need_ctx:
        return y, None
    oc = attend(group(qc), kc, vc)
    yc = merge_heads(oc.reshape(b, ATT_HEADS, zc.shape[1], HEAD_DIM))
    return y, yc


def merge_branches(u, ys, w_gate, b_gate, w_branch, w_o):
    m = 0.0
    for i, y in enumerate(ys):
        m = m + jax.nn.sigmoid(u @ w_gate[i] + b_gate[i]) * (y @ w_branch[i])
    return m @ w_o


def swiglu(u, w1, w3, w2):
    return (jax.nn.silu(u @ w1) * (u @ w3)) @ w2


def moe_ffn(t, w_r, w1, w3, w2):
    n_tok = t.shape[0]
    n_pair = n_tok * TOP_K
    logits = (t @ w_r).astype(jnp.float32)
    top_v, top_i = lax.top_k(logits, TOP_K)
    wts = jax.nn.softmax(top_v, axis=-1)
    e_flat = top_i.reshape(-1)
    tok = jnp.repeat(jnp.arange(n_tok, dtype=jnp.int32), TOP_K)
    order = jnp.argsort(e_flat)
    e_s, tok_s, w_s = e_flat[order], tok[order], wts.reshape(-1)[order]
    counts = jnp.bincount(e_flat, length=N_EXPERTS)
    padded = (counts + MOE_BLOCK - 1) // MOE_BLOCK * MOE_BLOCK
    start = jnp.cumsum(counts) - counts
    pad_end = jnp.cumsum(padded)
    pad_start = pad_end - padded
    dest = pad_start[e_s] + jnp.arange(n_pair, dtype=jnp.int32) - start[e_s]
    n_blk = -(-n_pair // MOE_BLOCK) + N_EXPERTS
    row_tok = jnp.zeros((n_blk * MOE_BLOCK,), jnp.int32).at[dest].set(tok_s)
    blk_e = jnp.minimum(jnp.searchsorted(pad_end, jnp.arange(n_blk) * MOE_BLOCK, side='right'), N_EXPERTS - 1)
    xb = t[row_tok].reshape(n_blk, MOE_BLOCK, t.shape[-1])
    yb = lax.map(lambda a: swiglu(a[0], w1[a[1]], w3[a[1]], w2[a[1]]), (xb, blk_e))
    yb = yb.reshape(n_blk * MOE_BLOCK, t.shape[-1])
    return jnp.zeros_like(t).at[tok_s].add(yb[dest] * w_s[:, None].astype(t.dtype))


def setup_inputs(seed: int = 0) -> dict:
    key = jax.random.key(seed)
    ks = iter(jax.random.split(key, 48))
    D = D_MODEL
    n_dense, n_moe = (DEPTH + 1) // 2, DEPTH // 2

    def nrm(shape, s):
        return jax.random.normal(next(ks), shape, jnp.float32) * s

    base = np.log(-np.log(1.0 - 2.0 ** (-5.0 - np.arange(RET_HEADS))))
    return {
        "x": nrm((BATCH, SEQ, D), 1.0),
        "c": nrm((BATCH, D), 1.0),
        "ctx": nrm((BATCH, CTX_LEN, D), 1.0),
        "c_ctx": nrm((D,), 1.0),
        "w_mod": nrm((DEPTH, D, N_MOD * D), D ** -0.5),
        "b_mod": nrm((DEPTH, N_MOD * D), 0.02),
        "w_in": nrm((DEPTH, D, IN_W), D ** -0.5),
        "conv_a_w": nrm((DEPTH, 3, BRANCH_W), 3 ** -0.5),
        "conv_a_b": nrm((DEPTH, BRANCH_W), 0.02),
        "ret_decay": jnp.asarray(base, jnp.float32) + nrm((DEPTH, 2, RET_HEADS), 0.1),
        "hy_conv_w": nrm((DEPTH, 3, H_W), 3 ** -0.5),
        "hy_conv_b": nrm((DEPTH, H_W), 0.02),
        "hy_w1": nrm((DEPTH, HY_EMB, HY_HID), HY_EMB ** -0.5),
        "hy_b1": nrm((DEPTH, HY_HID), 0.02),
        "hy_w2": nrm((DEPTH, HY_HID, HY_HID), HY_HID ** -0.5),
        "hy_b2": nrm((DEPTH, HY_HID), 0.02),
        "hy_w3": nrm((DEPTH, HY_HID, HY_FILT_OUT), 0.03 * HY_HID ** -0.5),
        "hy_freq": 1.0 + nrm((DEPTH, 2, HY_HID), 0.05),
        "hy_skip": nrm((DEPTH, HY_ORDER, BRANCH_W), 0.5),
        "q_norm": 1.0 + nrm((DEPTH, HEAD_DIM), 0.02),
        "k_norm": 1.0 + nrm((DEPTH, HEAD_DIM), 0.02),
        "w_gate": nrm((DEPTH, N_BRANCH, D, D), D ** -0.5),
        "b_gate": nrm((DEPTH, N_BRANCH, D), 0.02),
        "w_branch": nrm((DEPTH, N_BRANCH, BRANCH_W, D), BRANCH_W ** -0.5 * BETA),
        "w_o": nrm((DEPTH, D, D), D ** -0.5 * BETA),
        "ln_g": 1.0 + nrm((DEPTH, 2, D), 0.02),
        "ln_b": nrm((DEPTH, 2, D), 0.02),
        "ffn_w1": nrm((n_dense, D, FF_DENSE), D ** -0.5),
        "ffn_w3": nrm((n_dense, D, FF_DENSE), D ** -0.5),
        "ffn_w2": nrm((n_dense, FF_DENSE, D), FF_DENSE ** -0.5 * BETA),
        "router": nrm((n_moe, D, N_EXPERTS), D ** -0.5),
        "moe_w1": nrm((n_moe, N_EXPERTS, D, FF_EXPERT), D ** -0.5),
        "moe_w3": nrm((n_moe, N_EXPERTS, D, FF_EXPERT), D ** -0.5),
        "moe_w2": nrm((n_moe, N_EXPERTS, FF_EXPERT, D), FF_EXPERT ** -0.5 * BETA),
    }


def reference(x, c, ctx, c_ctx, w_mod, b_mod, w_in, conv_a_w, conv_a_b, ret_decay,
              hy_conv_w, hy_conv_b, hy_w1, hy_b1, hy_w2, hy_b2, hy_w3, hy_freq, hy_skip,
              q_norm, k_norm, w_gate, b_gate, w_branch, w_o, ln_g, ln_b,
              ffn_w1, ffn_w3, ffn_w2, router, moe_w1, moe_w3, moe_w2):
    n_lat, n_ctx = x.shape[1], ctx.shape[1]
    rows = n_lat // GRID_W
    cos, sin = axial_rope_tables(rows)
    c_act = jax.nn.silu(c)[:, None, :]
    cc_act = jax.nn.silu(c_ctx)
    h = ctx
    for l in range(DEPTH):
        need_ctx = l < DEPTH - 1
        mod = jnp.split(c_act @ w_mod[l] + b_mod[l], N_MOD, axis=-1)
        mod_c = jnp.split(cc_act @ w_mod[l] + b_mod[l], N_MOD, axis=-1)

        u = x * (1.0 + mod[1]) + mod[0]
        uc = h * (1.0 + mod_c[1]) + mod_c[0]
        zA, zR, zH, zD = jnp.split(u @ w_in[l], IN_SPLITS, axis=-1)
        cA, cR, cH, cD = jnp.split(uc @ w_in[l], IN_SPLITS, axis=-1)
        log_gamma = -jnp.exp(ret_decay[l].astype(jnp.float32))
        yR, yRc = retention_mixer(zR, cR, cos, sin, log_gamma, need_ctx)
        yD, yDc = attention_mixer(zD, cD, cos, sin, q_norm[l], k_norm[l], need_ctx)
        yA = short_conv_mixer(zA, conv_a_w[l], conv_a_b[l])
        filt = hyena_filters(n_lat, hy_w1[l], hy_b1[l], hy_w2[l], hy_b2[l], hy_w3[l], hy_freq[l])
        yH = hyena_mixer(zH, hy_conv_w[l], hy_conv_b[l], filt, hy_skip[l])
        mix = merge_branches(u, (yA, yR, yH, yD), w_gate[l], b_gate[l], w_branch[l], w_o[l])
        x = layer_norm(ALPHA * x + mod[2] * mix, ln_g[l, 0], ln_b[l, 0])
        if need_ctx:
            yAc = short_conv_mixer(cA, conv_a_w[l], conv_a_b[l])
            filt_c = hyena_filters(n_ctx, hy_w1[l], hy_b1[l], hy_w2[l], hy_b2[l], hy_w3[l], hy_freq[l])
            yHc = hyena_mixer(cH, hy_conv_w[l], hy_conv_b[l], filt_c, hy_skip[l])
            mix_c = merge_branches(uc, (yAc, yRc, yHc, yDc), w_gate[l], b_gate[l], w_branch[l], w_o[l])
            h = layer_norm(ALPHA * h + mod_c[2] * mix_c, ln_g[l, 0], ln_b[l, 0])

        u = x * (1.0 + mod[4]) + mod[3]
        i = l // 2
        if l % 2 == 0:
            f = swiglu(u, ffn_w1[i], ffn_w3[i], ffn_w2[i])
            if need_ctx:
                uc = h * (1.0 + mod_c[4]) + mod_c[3]
                fc = swiglu(uc, ffn_w1[i], ffn_w3[i], ffn_w2[i])
        else:
            flat = u.reshape(-1, D_MODEL)
            if need_ctx:
                uc = h * (1.0 + mod_c[4]) + mod_c[3]
                flat = jnp.concatenate([flat, uc.reshape(-1, D_MODEL)], axis=0)
            fo = moe_ffn(flat, router[i], moe_w1[i], moe_w3[i], moe_w2[i])
            n_u = u.shape[0] * n_lat
            f = fo[:n_u].reshape(u.shape)
            if need_ctx:
                fc = fo[n_u:].reshape(h.shape)
        x = layer_norm(ALPHA * x + mod[5] * f, ln_g[l, 1], ln_b[l, 1])
        if need_ctx:
            h = layer_norm(ALPHA * h + mod_c[5] * fc, ln_g[l, 1], ln_b[l, 1])
    return x
```

```cpp
#include <hip/hip_runtime.h>
#include <cstdio>
#include <cstdint>

#define LAS __attribute__((address_space(3)))
#define GAS __attribute__((address_space(1)))
typedef unsigned short bf16_t;
typedef short bf16x8 __attribute__((ext_vector_type(8)));
typedef short s16x4 __attribute__((ext_vector_type(4)));
typedef float f32x2 __attribute__((ext_vector_type(2)));
typedef float f32x4 __attribute__((ext_vector_type(4)));
typedef float f32x8 __attribute__((ext_vector_type(8)));
typedef float f32x16 __attribute__((ext_vector_type(16)));
typedef unsigned u32x2 __attribute__((ext_vector_type(2)));
typedef unsigned u32x4 __attribute__((ext_vector_type(4)));
typedef int i32x4 __attribute__((ext_vector_type(4)));
typedef int i32x8 __attribute__((ext_vector_type(8)));

constexpr int DM = 1024, NBATCH = 4, SEQ = 4096, DEPTH = 4, NCTX = 256;
constexpr int T_LAT = NBATCH * SEQ, T_CTX = NBATCH * NCTX, T_ALL = T_LAT + T_CTX;
constexpr int INW = 6144, ZGW = 10240, FFD = 2816, FFE = 3584, NEXP = 8;
constexpr int OFF_R = 1536, OFF_H = 3584, OFF_D = 5120, OFF_G = 6144;
constexpr int YW = 2048;
constexpr int NCH = 34;
constexpr int SLOT_MAX = 144 * 256;
constexpr float ALPHA = 1.681792830507429f;
constexpr float LN_EPS = 1e-6f;
constexpr int NTHREADS = 512, NWAVES = 8;

enum { I_X = 0, I_C, I_CTX, I_CCTX, I_WMOD, I_BMOD, I_WIN, I_CAW, I_CAB, I_RDEC, I_HCW, I_HCB, I_HW1, I_HB1, I_HW2, I_HB2, I_HW3, I_HFREQ, I_HSKIP,
       I_QN, I_KN, I_WGATE, I_BGATE, I_WBR, I_WO, I_LNG, I_LNB, I_FW1, I_FW3, I_FW2, I_ROUTER, I_MW1, I_MW3, I_MW2, N_IN };

constexpr size_t al256(size_t x) { return (x + 255) / 256 * 256; }
constexpr size_t WS_CTL   = 0;
constexpr size_t CTL_BYTES = 128 * 1024;
constexpr size_t WS_MOD   = WS_CTL + CTL_BYTES;
constexpr size_t WS_ROPE  = al256(WS_MOD + (size_t)DEPTH * 5 * 6144 * 4);
constexpr size_t WS_GF    = al256(WS_ROPE + 2 * 64 * 32 * 4);
constexpr size_t WS_GC    = al256(WS_GF + (size_t)DEPTH * 2 * 512 * 8192 * 2);
constexpr size_t WS_WCAT  = al256(WS_GC + (size_t)DEPTH * 2 * 512 * 512 * 4);
constexpr size_t WS_WB    = al256(WS_WCAT + (size_t)ZGW * DM * 2);
constexpr size_t WS_WO4   = al256(WS_WB + (size_t)4096 * 512 * 2);
constexpr size_t WS_W13   = al256(WS_WO4 + (size_t)1024 * 4096 * 2);
constexpr size_t WS_W13D  = WS_W13 + (size_t)NEXP * 2 * FFE * DM;
constexpr size_t WS_W2D   = WS_W13D + (size_t)2 * FFD * DM;
static_assert(WS_W2D + (size_t)DM * FFD <= WS_W13 + (size_t)NEXP * 2 * FFE * DM * 2, "dense FFN weights must fit in the W13 region");
constexpr size_t WS_W2    = al256(WS_W13 + (size_t)NEXP * 2 * FFE * DM * 2);
constexpr size_t WS_XF    = al256(WS_W2 + (size_t)NEXP * DM * FFE * 2);
constexpr size_t WS_U     = al256(WS_XF + (size_t)T_ALL * DM * 4);
constexpr size_t WS_ZG    = al256(WS_U + (size_t)T_ALL * DM * 2);
constexpr size_t WS_HID   = WS_ZG;
constexpr size_t WS_XG    = al256(WS_HID + (size_t)SLOT_MAX * FFE * 2);
constexpr size_t WS_Y     = al256(WS_ZG + (size_t)T_ALL * ZGW * 2);
constexpr size_t WS_YO    = WS_Y;
constexpr size_t WS_ZHT   = al256(WS_Y + (size_t)T_ALL * YW * 2);
constexpr size_t WS_ZHTC  = al256(WS_ZHT + (size_t)NBATCH * 1536 * SEQ * 2);
constexpr size_t WS_YHT   = al256(WS_ZHTC + (size_t)NBATCH * 1536 * NCTX * 2);
constexpr size_t WS_YHTC  = al256(WS_YHT + (size_t)NBATCH * 512 * SEQ * 2);
constexpr size_t WS_QP    = al256(WS_YHTC + (size_t)NBATCH * 512 * NCTX * 2);
constexpr size_t WS_QC    = al256(WS_QP + (size_t)NBATCH * 4 * SEQ * 128 * 2);
constexpr size_t WS_KALL  = al256(WS_QC + (size_t)NBATCH * 4 * NCTX * 128 * 2);
constexpr size_t WS_VALL  = al256(WS_KALL + (size_t)NBATCH * 2 * 4352 * 128 * 2);
constexpr size_t WS_KVS   = al256(WS_VALL + (size_t)NBATCH * 2 * 4352 * 128 * 2);
constexpr size_t WS_PAIR  = al256(WS_KVS + (size_t)NBATCH * 4 * 2 * NCH * 16384 * 4);
constexpr size_t WS_U8M   = al256(WS_PAIR + (size_t)T_ALL * 32);
constexpr size_t WS_WG8   = al256(WS_U8M + (size_t)T_ALL * DM);
constexpr size_t WS_END   = al256(WS_WG8 + (size_t)4096 * DM);
static_assert(WS_XG + (size_t)SLOT_MAX * DM * 2 <= WS_Y, "H + XG must fit inside the ZG region");
static_assert(WS_YO + (size_t)SLOT_MAX * DM * 2 <= WS_ZHTC, "YO must fit inside Y + ZHT");

constexpr int CW_BAR = 0;
constexpr int CW_QHEAD = 4096;
constexpr int CW_MOE = 8192;

__device__ __forceinline__ unsigned pk2(float lo, float hi) { unsigned r; asm("v_cvt_pk_bf16_f32 %0, %1, %2" : "=v"(r) : "v"(lo), "v"(hi)); return r; }
__device__ __forceinline__ bf16_t f2bf(float f) { return (bf16_t)(pk2(f, 0.f) & 0xffffu); }
__device__ __forceinline__ float bflo(unsigned w) { return __uint_as_float(w << 16); }
__device__ __forceinline__ float bfhi(unsigned w) { return __uint_as_float(w & 0xffff0000u); }
__device__ __forceinline__ f32x4 bf4_f32(u32x2 w) { f32x4 f; f.x = bflo(w.x); f.y = bfhi(w.x); f.z = bflo(w.y); f.w = bfhi(w.y); return f; }
__device__ __forceinline__ u32x2 f32_bf4(f32x4 v) { u32x2 w; w.x = pk2(v.x, v.y); w.y = pk2(v.z, v.w); return w; }
__device__ __forceinline__ float bf1(bf16_t h) { return __uint_as_float(((unsigned)h) << 16); }
__device__ __forceinline__ void unpack8(u32x4 w, float* f) { f[0] = bflo(w.x); f[1] = bfhi(w.x); f[2] = bflo(w.y); f[3] = bfhi(w.y); f[4] = bflo(w.z); f[5] = bfhi(w.z); f[6] = bflo(w.w); f[7] = bfhi(w.w); }
__device__ __forceinline__ u32x4 pack8(const float* f) { u32x4 w; w.x = pk2(f[0], f[1]); w.y = pk2(f[2], f[3]); w.z = pk2(f[4], f[5]); w.w = pk2(f[6], f[7]); return w; }
__device__ __forceinline__ float shfl_xor_l(float v, int o, int lane) { return __int_as_float(__builtin_amdgcn_ds_bpermute((lane ^ o) << 2, __float_as_int(v))); }
__device__ __forceinline__ float wave_sum(float v, int lane) {
#pragma unroll
    for (int o = 1; o < 64; o <<= 1) v += shfl_xor_l(v, o, lane);
    return v;
}
__device__ __forceinline__ float sigmoidf_(float x) { return __builtin_amdgcn_rcpf(1.f + __expf(-x)); }
__device__ __forceinline__ float siluf_(float x) { return x * sigmoidf_(x); }
__device__ __forceinline__ int crow(int r, int hi) { return (r & 3) + 8 * (r >> 2) + 4 * hi; }
#define LDS_WAIT() asm volatile("s_waitcnt lgkmcnt(0)" ::: "memory")
constexpr float F8_WSCALE = 64.0f;
__device__ __forceinline__ float clamp448(float x) { return __builtin_amdgcn_fmed3f(x, -448.f, 448.f); }
__device__ __forceinline__ unsigned pk4_fp8(float a, float b, float c, float d) {
    int w = __builtin_amdgcn_cvt_pk_fp8_f32(clamp448(a), clamp448(b), 0, false); w = __builtin_amdgcn_cvt_pk_fp8_f32(clamp448(c), clamp448(d), w, true); return (unsigned)w; }

#define XB_TMO      128
#define XB_XCNT(j)  (256  + 64 * (j))
#define XB_XSUB(j)  (1280 + 64 * (j))
#define XB_XGEN(j)  (2304 + 64 * (j))
#define XB_TOP      3328
#define XB_TOPGEN   3392
#define XCD_BAR_WORDS 3456
#define XB_SPIN_CAP (1u << 22)

__device__ __forceinline__ unsigned xb_ld(unsigned* p)              { return __hip_atomic_load(p, __ATOMIC_RELAXED, __HIP_MEMORY_SCOPE_AGENT); }
__device__ __forceinline__ unsigned xb_add(unsigned* p, unsigned v) { return __hip_atomic_fetch_add(p, v, __ATOMIC_RELAXED, __HIP_MEMORY_SCOPE_AGENT); }
__device__ __forceinline__ unsigned xb_xcc_id() { return (unsigned)__builtin_amdgcn_s_getreg((3 << 11) | 20) & 0xFu; }
#define XB_SPIN(cond, bar) do { unsigned _sp = 0; while (cond) { __builtin_amdgcn_s_sleep(1); \
    if ((++_sp & 255u) == 0u) { if (xb_ld(&(bar)[XB_TMO])) break; if (_sp > XB_SPIN_CAP) { atomicAdd(&(bar)[XB_TMO], 1u); break; } } } } while (0)

struct XcdBarrier { unsigned* bar; unsigned x; volatile LAS unsigned* st; };

__device__ __forceinline__ XcdBarrier xcd_barrier_post(unsigned* bar, volatile LAS unsigned* st) {
    XcdBarrier b; b.bar = bar; b.x = xb_xcc_id(); b.st = st;
    if (threadIdx.x == 0) (void)xb_add(&bar[XB_XCNT(b.x)], 1u);
    return b;
}
__device__ __forceinline__ void xcd_barrier_complete(unsigned* bar, unsigned x, unsigned& nloc, unsigned& nx) {
    const unsigned G = gridDim.x * gridDim.y * gridDim.z;
    unsigned sum, cnt, mine, sp = 0u;
    for (;;) {
        sum = 0u; cnt = 0u; mine = 0u;
#pragma unroll
        for (unsigned j = 0; j < 16; ++j) { const unsigned c = xb_ld(&bar[XB_XCNT(j)]); sum += c; cnt += (c > 0u) ? 1u : 0u; mine = (j == x) ? c : mine; }
        if (sum == G) break;
        __builtin_amdgcn_s_sleep(1);
        if ((++sp & 255u) == 0u) { if (xb_ld(&bar[XB_TMO])) break; if (sp > XB_SPIN_CAP) { atomicAdd(&bar[XB_TMO], 1u); break; } }
    }
    nloc = mine > 0u ? mine : 1u; nx = cnt > 0u ? cnt : 1u;
}
__device__ __forceinline__ void xcd_barrier(const XcdBarrier& b) {
    asm volatile("s_waitcnt vmcnt(0)" ::: "memory");
    __syncthreads();
    int t0_ = threadIdx.x; asm volatile("" : "+v"(t0_));
    if (t0_ == 0) {
        unsigned* bar = b.bar; unsigned bx = b.x;
        asm volatile("" : "+s"(bar), "+s"(bx));
        __builtin_amdgcn_s_waitcnt(0);
        unsigned nloc = b.st[0], nx = b.st[1];
        if (nloc == 0u) { xcd_barrier_complete(bar, bx, nloc, nx); b.st[0] = nloc; b.st[1] = nx; }
        const unsigned old = xb_add(&bar[XB_XSUB(bx)], 1u);
        const unsigned gen = old / nloc;
        if (old + 1u == (gen + 1u) * nloc) {
            __builtin_amdgcn_fence(__ATOMIC_RELEASE, "agent");
            asm volatile("s_waitcnt vmcnt(0)" ::: "memory");
            const unsigned og = xb_add(&bar[XB_TOP], 1u);
            const unsigned tg = og / nx;
            if (og + 1u == (tg + 1u) * nx) xb_add(&bar[XB_TOPGEN], 1u);
            else XB_SPIN(xb_ld(&bar[XB_TOPGEN]) == tg, bar);
            __builtin_amdgcn_fence(__ATOMIC_ACQUIRE, "agent");
            xb_add(&bar[XB_XGEN(bx)], 1u);
            asm volatile("s_waitcnt vmcnt(0)" ::: "memory");
        } else {
            XB_SPIN(xb_ld(&bar[XB_XGEN(bx)]) == gen, bar);
            __builtin_amdgcn_fence(__ATOMIC_ACQUIRE, "agent");
            asm volatile("s_waitcnt vmcnt(0)" ::: "memory");
        }
    }
    __syncthreads();
}

namespace pg8 {
constexpr int BM = 256, BK = 64, HALF = 128, HTB = HALF * BK * 2, STAGE_BYTES = 8 * HTB, NXCD = 8, WGM = 8;
__device__ __forceinline__ int lds_byte(int r, int c) { const int st = (r >> 4) * 2 + (c >> 5), rr = r & 15, cc = c & 31, ob = rr * 64 + cc * 2; return st * 1024 + (ob ^ (((ob >> 9) & 1) << 5)); }
__device__ __forceinline__ void stage_rc(int b, int& R, int& C) { const int st = b / 1024, sb = b % 1024, swz = sb ^ (((sb >> 9) & 1) << 5); R = (st >> 1) * 16 + swz / 64; C = (st & 1) * 32 + (swz % 64) / 2; }
__device__ __forceinline__ int perm32(int rho) { const int n = rho >> 4, i = rho & 15; return 8 * (i >> 2) + 4 * n + (i & 3); }

struct Unit { const char* A; const char* B; int pm, pn, e, pad; };
struct Gemm { int K, lda, ldb; int kstep = BK * 2, kstepb = BK * 2; };

struct GSched {
    int nM, nN, nwg, G, c;
    const char* A; const char* B; unsigned a_tile, b_tile, a_col; int a_sh;
    __device__ void init(int nM_, int nN_, int G_, int c_, const void* A_, unsigned a_tile_, const void* B_, unsigned b_tile_, int a_sh_ = 30, unsigned a_col_ = 0) {
        nM = nM_; nN = nN_; nwg = nM * nN; G = G_; c = c_; A = (const char*)A_; B = (const char*)B_; a_tile = a_tile_; b_tile = b_tile_; a_sh = a_sh_; a_col = a_col_; }
    __device__ __forceinline__ bool next(int i, Unit& u) const {
        const int L = i * G + c; if (L >= nwg) return false;
        int wgid = L; { const int q = nwg / NXCD, r = nwg % NXCD, xcd = wgid % NXCD, off = wgid / NXCD; wgid = (xcd < r ? xcd * (q + 1) : r * (q + 1) + (xcd - r) * q) + off; }
        const int nig = WGM * nN, gid = wgid / nig, fm = gid * WGM, gsz = (nM - fm) < WGM ? (nM - fm) : WGM;
        u.pm = fm + ((wgid % nig) % gsz); u.pn = (wgid % nig) / gsz; u.e = 0; u.pad = 0;
        u.A = A + (size_t)((unsigned)u.pm * a_tile + (unsigned)(u.pn >> a_sh) * a_col); u.B = B + (size_t)((unsigned)u.pn * b_tile); return true;
    }
};
struct SameSched { GSched s; __device__ __forceinline__ bool next(int i, Unit& u) const { Unit t; if (!s.next(i, t)) return false; s.next(0, u); return true; } };
struct MoeSched {
    int G, c, nN, ntiles; int ts[NEXP];
    const char* A; const char* B; unsigned a_tile, b_tile;
    __device__ __forceinline__ bool next(int i, Unit& u) const {
        const int L = i * G + c; if (L >= ntiles * nN) return false;
        const int rt = L / nN, pn = L % nN; int e = 0;
#pragma unroll
        for (int k = 1; k < NEXP; ++k) e += (rt >= ts[k]) ? 1 : 0;
        u.pm = rt; u.pn = pn; u.e = e; u.pad = 0; u.A = A + (size_t)((unsigned)rt * a_tile); u.B = B + (size_t)((unsigned)(e * nN + pn) * b_tile); return true;
    }
};

__device__ __forceinline__ unsigned cvt_pk_bf16(float lo, float hi) { return pk2(lo, hi); }

template <bool F8 = false, int PROBE = 0, class Epi, class Sched>
__device__ __forceinline__ void gemm_phase(LAS unsigned char* lds, const Gemm g, const Sched& S, const Epi& E, const int tid) {
    const int wid = __builtin_amdgcn_readfirstlane(tid >> 6), lane = tid & 63, wr = wid >> 2, wc = wid & 3, fr = lane & 15, fq = lane >> 4;
    const int K = g.K, nt = K / BK;
    unsigned voffA[2], voffB[2];
#pragma unroll
    for (int i = 0; i < 2; ++i) { int R, C; stage_rc(tid * 16 + i * 8192, R, C); const int Rb = Epi::PERM ? ((R & ~31) + perm32(R & 31)) : R;
        voffA[i] = (unsigned)(R * g.lda + C) * 2u; voffB[i] = (unsigned)(Rb * g.ldb + C) * 2u; }
    const size_t kstep = (size_t)g.kstep, kstepb = (size_t)g.kstepb;
    const size_t hstepA = (size_t)HALF * g.lda * 2, hstepB = (size_t)HALF * g.ldb * 2;
    const unsigned ldsw = (unsigned)wid * 1024u;
    const int aoff = lds_byte(wr * 64 + fr, fq * 8), boff = lds_byte(wc * 32 + fr, fq * 8);
#define PG8_SA(b, h) (((b) * 2 + (h)) * HTB)
#define PG8_SB(b, h) ((4 + (b) * 2 + (h)) * HTB)
#define PG8_STAGE(bufoff, gbase, voff) do { if constexpr (PROBE == 1 || PROBE == 3) break; _Pragma("unroll") for (int _i = 0; _i < 2; ++_i) { unsigned _vo = (voff)[_i]; if constexpr (F8) asm volatile("" : "+v"(_vo));     \
        __builtin_amdgcn_global_load_lds((const unsigned*)((const char*)(gbase) + _vo), (LAS unsigned*)(lds + (bufoff) + ldsw + _i * 8192), 16, 0, 0); } } while (0)
#define PG8_CAT(x0, x1) __builtin_shufflevector(__builtin_bit_cast(i32x4, x0), __builtin_bit_cast(i32x4, x1), 0, 1, 2, 3, 4, 5, 6, 7)
#define PG8_LDA(dst, b, h) do { if constexpr (PROBE == 3) { _Pragma("unroll") for (int m = 0; m < 4; ++m) asm volatile("" : "+v"(dst[m][0]), "+v"(dst[m][1])); break; } _Pragma("unroll") for (int m = 0; m < 4; ++m) { const bf16x8 _x0 = *(const LAS bf16x8*)(lds + PG8_SA(b, h) + aoff + m * 2048), _x1 = *(const LAS bf16x8*)(lds + PG8_SA(b, h) + aoff + m * 2048 + 1024); \
        if constexpr (F8) dst##8[m] = PG8_CAT(_x0, _x1); else { dst[m][0] = _x0; dst[m][1] = _x1; } } } while (0)
#define PG8_LDB(dst, b, h) do { if constexpr (PROBE == 3) { _Pragma("unroll") for (int n = 0; n < 2; ++n) asm volatile("" : "+v"(dst[n][0]), "+v"(dst[n][1])); break; } _Pragma("unroll") for (int n = 0; n < 2; ++n) { const bf16x8 _x0 = *(const LAS bf16x8*)(lds + PG8_SB(b, h) + boff + n * 2048), _x1 = *(const LAS bf16x8*)(lds + PG8_SB(b, h) + boff + n * 2048 + 1024); \
        if constexpr (F8) dst##8[n] = PG8_CAT(_x0, _x1); else { dst[n][0] = _x0; dst[n][1] = _x1; } } } while (0)
#define PG8_MMA(ai, bj, At, Bt) do { if constexpr (PROBE == 2) { _Pragma("unroll") for (int m = 0; m < 4; ++m) asm volatile("" :: "v"(At[m][0]), "v"(At[m][1])); _Pragma("unroll") for (int n = 0; n < 2; ++n) asm volatile("" :: "v"(Bt[n][0]), "v"(Bt[n][1])); break; } __builtin_amdgcn_s_setprio(1); _Pragma("unroll") for (int m = 0; m < 4; ++m) _Pragma("unroll") for (int n = 0; n < 2; ++n) { \
        if constexpr (F8) asm volatile("v_mfma_f32_16x16x128_f8f6f4 %0, %1, %2, %0" : "+v"(acc[ai][bj][m][n]) : "v"(Bt##8[n]), "v"(At##8[m]));     \
        else { _Pragma("unroll") for (int k = 0; k < 2; ++k) acc[ai][bj][m][n] = __builtin_amdgcn_mfma_f32_16x16x32_bf16(Bt[n][k], At[m][k], acc[ai][bj][m][n], 0, 0, 0); } } __builtin_amdgcn_s_setprio(0); } while (0)
#define PG8_WAIT_V(n) asm volatile("s_waitcnt vmcnt(" #n ")" ::: "memory")
#define PG8_WAIT_L(n) asm volatile("s_waitcnt lgkmcnt(" #n ")" ::: "memory")
#define PG8_BAR __builtin_amdgcn_s_barrier()
#define PG8_SCHED __builtin_amdgcn_sched_barrier(0)
    Unit cur, nxt; int ui = 0;
    if (!S.next(0, cur)) return;
    f32x4 acc[2][2][4][2];
    float zero_ = 0.f; asm volatile("" : "+v"(zero_));
#pragma unroll
    for (int a = 0; a < 2; ++a)
#pragma unroll
        for (int b = 0; b < 2; ++b)
#pragma unroll
            for (int m = 0; m < 4; ++m)
#pragma unroll
                for (int n = 0; n < 2; ++n) acc[a][b][m][n] = (f32x4){zero_, zero_, zero_, zero_};
    bf16x8 At[4][2], B0[2][2], B1[2][2]; i32x8 At8[4], B08[2], B18[2];
    if constexpr (PROBE == 3) { _Pragma("unroll") for (int m = 0; m < 4; ++m) { At[m][0] = (bf16x8)0; At[m][1] = (bf16x8)0; } _Pragma("unroll") for (int n = 0; n < 2; ++n) { B0[n][0] = (bf16x8)0; B0[n][1] = (bf16x8)0; B1[n][0] = (bf16x8)0; B1[n][1] = (bf16x8)0; } }
    const char* cA = cur.A; const char* cB = cur.B;
    PG8_STAGE(PG8_SB(0, 0), cB, voffB); PG8_STAGE(PG8_SA(0, 0), cA, voffA); PG8_STAGE(PG8_SB(0, 1), cB + hstepB, voffB); PG8_STAGE(PG8_SA(0, 1), cA + hstepA, voffA);
    if (wr == 1) PG8_BAR;
    PG8_WAIT_V(4); PG8_BAR;
    PG8_STAGE(PG8_SB(1, 0), cB + kstepb, voffB); PG8_STAGE(PG8_SA(1, 0), cA + kstep, voffA); PG8_STAGE(PG8_SB(1, 1), cB + hstepB + kstepb, voffB); PG8_STAGE(PG8_SA(1, 1), cA + hstepA + kstep, voffA);
    PG8_WAIT_V(8); PG8_BAR;
    for (;;) {
        const bool has_next = S.next(ui + 1, nxt);
        const char* nA = has_next ? nxt.A : cA; const char* nB = has_next ? nxt.B : cB;
#pragma clang loop unroll(disable)
        for (int t = 0; t < nt; t += 2) {
            const bool last = (t == nt - 2), first = (t == 0);
            const char* a1 = cA + (size_t)(t + 1) * kstep;
            const char* a2 = last ? nA : cA + (size_t)(t + 2) * kstep; const char* b2 = last ? nB : cB + (size_t)(t + 2) * kstepb;
            const char* a3 = a2 + kstep; const char* b3 = b2 + kstepb;
            PG8_LDB(B0, 0, 0); PG8_SCHED; PG8_LDA(At, 0, 0); if (!first) PG8_STAGE(PG8_SA(1, 1), a1 + hstepA, voffA);
            PG8_WAIT_L(8); PG8_BAR; PG8_WAIT_L(0); PG8_MMA(0, 0, At, B0); PG8_BAR; PG8_SCHED;
            PG8_LDB(B1, 0, 1); PG8_STAGE(PG8_SB(0, 0), b2, voffB);
            PG8_BAR; PG8_WAIT_L(0); PG8_MMA(0, 1, At, B1); PG8_BAR;
            PG8_LDA(At, 0, 1); PG8_STAGE(PG8_SA(0, 0), a2, voffA);
            PG8_BAR; PG8_WAIT_L(0); PG8_MMA(1, 0, At, B0); PG8_BAR; PG8_SCHED;
            PG8_STAGE(PG8_SB(0, 1), b2 + hstepB, voffB);
            if (first && ui > 0) { if constexpr (Epi::NST == 16) PG8_WAIT_V(22); else if constexpr (Epi::NST == 8) PG8_WAIT_V(14); else if constexpr (Epi::NST == 4) PG8_WAIT_V(10); else PG8_WAIT_V(6); }
            else PG8_WAIT_V(6);
            PG8_BAR; PG8_MMA(1, 1, At, B1); PG8_BAR;
            PG8_LDB(B0, 1, 0); PG8_SCHED; PG8_LDA(At, 1, 0); PG8_STAGE(PG8_SA(0, 1), a2 + hstepA, voffA);
            PG8_WAIT_L(8); PG8_BAR; PG8_WAIT_L(0); PG8_MMA(0, 0, At, B0); PG8_BAR; PG8_SCHED;
            PG8_LDB(B1, 1, 1); PG8_STAGE(PG8_SB(1, 0), b3, voffB);
            PG8_BAR; PG8_WAIT_L(0); PG8_MMA(0, 1, At, B1); PG8_BAR;
            PG8_LDA(At, 1, 1); PG8_STAGE(PG8_SA(1, 0), a3, voffA);
            PG8_BAR; PG8_WAIT_L(0); PG8_MMA(1, 0, At, B0); PG8_BAR; PG8_SCHED;
            PG8_STAGE(PG8_SB(1, 1), b3 + hstepB, voffB);
            PG8_WAIT_V(6); PG8_BAR; PG8_MMA(1, 1, At, B1); PG8_BAR;
        }
        const auto epre = E.pre(cur, wr, wc, fr, fq); asm volatile("" ::: "memory");
        PG8_STAGE(PG8_SA(1, 1), nA + kstep + hstepA, voffA); asm volatile("" ::: "memory");
        if constexpr (F8) asm volatile("s_nop 15\n\ts_nop 15" ::: "memory");
        E(acc, cur, wr, wc, fr, fq, epre);
        if (!has_next) break;
        asm volatile("" : "+v"(zero_));
#pragma unroll
        for (int a = 0; a < 2; ++a)
#pragma unroll
            for (int b = 0; b < 2; ++b)
#pragma unroll
                for (int m = 0; m < 4; ++m)
#pragma unroll
                    for (int n = 0; n < 2; ++n) acc[a][b][m][n] = (f32x4){zero_, zero_, zero_, zero_};
        cur = nxt; cA = nA; cB = nB; ++ui;
    }
    PG8_WAIT_V(0);
    if (wr == 0) PG8_BAR;
    PG8_BAR;
#undef PG8_SA
#undef PG8_SB
#undef PG8_STAGE
#undef PG8_LDA
#undef PG8_LDB
#undef PG8_MMA
#undef PG8_CAT
#undef PG8_WAIT_V
#undef PG8_WAIT_L
#undef PG8_BAR
#undef PG8_SCHED
}

typedef f32x4 Acc[2][2][4][2];

struct EpiPreNone {};
struct EpiZG { static constexpr bool PERM = true; static constexpr int NST = 16;
    GAS bf16_t* ZG; const GAS float* bgate; float sc;
    struct Pre { f32x4 bv[2][2]; };
    __device__ __forceinline__ Pre pre(const Unit& u, int wr, int wc, int fr, int fq) const {
        const int col0 = u.pn * BM + wc * 32 + 8 * fq; const bool gate = (u.pn >= 24); Pre p;
#pragma unroll
        for (int bj = 0; bj < 2; ++bj)
#pragma unroll
            for (int n = 0; n < 2; ++n) p.bv[bj][n] = gate ? *(const GAS f32x4*)(bgate + (col0 - OFF_G) + bj * HALF + 4 * n) : (f32x4){0.f, 0.f, 0.f, 0.f};
        return p; }
    __device__ __forceinline__ void operator()(const Acc& acc, const Unit& u, int wr, int wc, int fr, int fq, const Pre& p) const {
        const int row0 = u.pm * BM + wr * 64 + fr, col0 = u.pn * BM + wc * 32 + 8 * fq; const bool gate = (u.pn >= 24);
#pragma unroll
        for (int ai = 0; ai < 2; ++ai)
#pragma unroll
            for (int m = 0; m < 4; ++m) { GAS bf16_t* rowp = ZG + (size_t)(row0 + ai * HALF + m * 16) * ZGW + col0;
#pragma unroll
                for (int bj = 0; bj < 2; ++bj) { f32x4 v0 = acc[ai][bj][m][0] * sc + p.bv[bj][0], v1 = acc[ai][bj][m][1] * sc + p.bv[bj][1];
                    if (gate) {
#pragma unroll
                        for (int j = 0; j < 4; ++j) { v0[j] = sigmoidf_(v0[j]); v1[j] = sigmoidf_(v1[j]); } }
                    u32x4 w; w.x = pk2(v0[0], v0[1]); w.y = pk2(v0[2], v0[3]); w.z = pk2(v1[0], v1[1]); w.w = pk2(v1[2], v1[3]);
                    *(GAS u32x4*)(rowp + bj * HALF) = w; } }
    }
};
struct EpiShift { static constexpr bool PERM = true; static constexpr int NST = 16; EpiZG e;
    typedef EpiZG::Pre Pre;
    __device__ __forceinline__ Pre pre(const Unit& u, int wr, int wc, int fr, int fq) const { Unit u2 = u; u2.pn += 24; return e.pre(u2, wr, wc, fr, fq); }
    __device__ __forceinline__ void operator()(const Acc& acc, const Unit& u, int wr, int wc, int fr, int fq, const Pre& p) const { Unit u2 = u; u2.pn += 24; e(acc, u2, wr, wc, fr, fq, p); } };
struct EpiGate { static constexpr bool PERM = true; static constexpr int NST = 16;
    GAS bf16_t* ZG;
    struct Pre { u32x4 gw[2][4][2]; };
    __device__ __forceinline__ Pre pre(const Unit& u, int wr, int wc, int fr, int fq) const {
        const int row0 = u.pm * BM + wr * 64 + fr, col0 = OFF_G + u.pn * BM + wc * 32 + 8 * fq;
        GAS bf16_t* base = ZG + (size_t)row0 * ZGW + col0; Pre p;
#pragma unroll
        for (int ai = 0; ai < 2; ++ai)
#pragma unroll
            for (int m = 0; m < 4; ++m)
#pragma unroll
                for (int bj = 0; bj < 2; ++bj) p.gw[ai][m][bj] = *(const GAS u32x4*)(base + (size_t)(ai * HALF + m * 16) * ZGW + bj * HALF);
        return p; }
    __device__ __forceinline__ void operator()(const Acc& acc, const Unit& u, int wr, int wc, int fr, int fq, const Pre& p) const {
        const int row0 = u.pm * BM + wr * 64 + fr, col0 = OFF_G + u.pn * BM + wc * 32 + 8 * fq;
        GAS bf16_t* base = ZG + (size_t)row0 * ZGW + col0;
#pragma unroll
        for (int ai = 0; ai < 2; ++ai)
#pragma unroll
            for (int m = 0; m < 4; ++m)
#pragma unroll
                for (int bj = 0; bj < 2; ++bj) { float gf[8]; unpack8(p.gw[ai][m][bj], gf);
                    const f32x4 v0 = acc[ai][bj][m][0], v1 = acc[ai][bj][m][1];
                    u32x4 w; w.x = pk2(v0[0] * gf[0], v0[1] * gf[1]); w.y = pk2(v0[2] * gf[2], v0[3] * gf[3]); w.z = pk2(v1[0] * gf[4], v1[1] * gf[5]); w.w = pk2(v1[2] * gf[6], v1[3] * gf[7]);
                    *(GAS u32x4*)(base + (size_t)(ai * HALF + m * 16) * ZGW + bj * HALF) = w; }
    }
};
struct EpiSwiglu { static constexpr bool PERM = true; static constexpr int NST = 4;
    GAS unsigned char* H; int ldh; float sc;
    typedef EpiPreNone Pre; __device__ __forceinline__ Pre pre(const Unit&, int, int, int, int) const { return Pre{}; }
    __device__ __forceinline__ void operator()(const Acc& acc, const Unit& u, int wr, int wc, int fr, int fq, const Pre&) const {
        const int row0 = u.pm * BM + wr * 64 + fr;
        u32x2 w[2][4];
#pragma unroll
        for (int ai = 0; ai < 2; ++ai)
#pragma unroll
            for (int m = 0; m < 4; ++m) {
                const f32x4 a0 = acc[ai][0][m][0] * sc, a1 = acc[ai][0][m][1] * sc, b0 = acc[ai][1][m][0] * sc, b1 = acc[ai][1][m][1] * sc;
                float h[8];
#pragma unroll
                for (int j = 0; j < 4; ++j) { h[j] = siluf_(a0[j]) * b0[j]; h[4 + j] = siluf_(a1[j]) * b1[j]; }
                w[ai][m].x = pk4_fp8(h[0], h[1], h[2], h[3]); w[ai][m].y = pk4_fp8(h[4], h[5], h[6], h[7]); }
        const int colb = u.pn * HALF + wc * 32 + 16 * (fq >> 1), msel = fq & 1;
#pragma unroll
        for (int ai = 0; ai < 2; ++ai)
#pragma unroll
            for (int mp = 0; mp < 4; mp += 2) {
                const auto r0 = __builtin_amdgcn_permlane16_swap(w[ai][mp].x, w[ai][mp + 1].x, false, false);
                const auto r1 = __builtin_amdgcn_permlane16_swap(w[ai][mp].y, w[ai][mp + 1].y, false, false);
                u32x4 o; o.x = r0[0]; o.y = r1[0]; o.z = r0[1]; o.w = r1[1];
                *(GAS u32x4*)(H + (size_t)(row0 + ai * HALF + (mp + msel) * 16) * ldh + colb) = o; }
    }
};
struct EpiPlain { static constexpr bool PERM = true; static constexpr int NST = 16;
    GAS bf16_t* O; int ldo; float sc;
    typedef EpiPreNone Pre; __device__ __forceinline__ Pre pre(const Unit&, int, int, int, int) const { return Pre{}; }
    __device__ __forceinline__ void operator()(const Acc& acc, const Unit& u, int wr, int wc, int fr, int fq, const Pre&) const {
        const int row0 = u.pm * BM + wr * 64 + fr, col0 = u.pn * BM + wc * 32 + 8 * fq;
#pragma unroll
        for (int ai = 0; ai < 2; ++ai)
#pragma unroll
            for (int m = 0; m < 4; ++m) { GAS bf16_t* rowp = O + (size_t)(row0 + ai * HALF + m * 16) * ldo + col0;
#pragma unroll
                for (int bj = 0; bj < 2; ++bj) { const f32x4 v0 = acc[ai][bj][m][0] * sc, v1 = acc[ai][bj][m][1] * sc;
                    u32x4 w; w.x = pk2(v0[0], v0[1]); w.y = pk2(v0[2], v0[3]); w.z = pk2(v1[0], v1[1]); w.w = pk2(v1[2], v1[3]);
                    *(GAS u32x4*)(rowp + bj * HALF) = w; } }
    }
};
struct EpiZGNoStore { static constexpr bool PERM = true; static constexpr int NST = 0; float sc;
    typedef EpiPreNone Pre; __device__ __forceinline__ Pre pre(const Unit&, int, int, int, int) const { return Pre{}; }
    __device__ __forceinline__ void operator()(const Acc& acc, const Unit& u, int wr, int wc, int fr, int fq, const Pre&) const {
#pragma unroll
        for (int ai = 0; ai < 2; ++ai)
#pragma unroll
            for (int m = 0; m < 4; ++m)
#pragma unroll
                for (int bj = 0; bj < 2; ++bj) { f32x4 v0 = acc[ai][bj][m][0] * sc, v1 = acc[ai][bj][m][1] * sc;
                    u32x4 w; w.x = pk2(v0[0], v0[1]); w.y = pk2(v0[2], v0[3]); w.z = pk2(v1[0], v1[1]); w.w = pk2(v1[2], v1[3]);
                    asm volatile("" :: "v"(w)); }
    }
};
struct EpiContig { static constexpr bool PERM = true; static constexpr int NST = 16; GAS unsigned char* O; float sc;
    typedef EpiPreNone Pre; __device__ __forceinline__ Pre pre(const Unit&, int, int, int, int) const { return Pre{}; }
    __device__ __forceinline__ void operator()(const Acc& acc, const Unit& u, int wr, int wc, int fr, int fq, const Pre&) const {
        GAS unsigned char* base = O + (size_t)((u.pm * 24 + u.pn) & 511) * 131072u + (size_t)((wr * 4 + wc) * 1024 + (fq * 16 + fr) * 16);
#pragma unroll
        for (int ai = 0; ai < 2; ++ai)
#pragma unroll
            for (int m = 0; m < 4; ++m)
#pragma unroll
                for (int bj = 0; bj < 2; ++bj) { f32x4 v0 = acc[ai][bj][m][0] * sc, v1 = acc[ai][bj][m][1] * sc;
                    u32x4 w; w.x = pk2(v0[0], v0[1]); w.y = pk2(v0[2], v0[3]); w.z = pk2(v1[0], v1[1]); w.w = pk2(v1[2], v1[3]);
                    *(GAS u32x4*)(base + ((ai * 4 + m) * 2 + bj) * 8192) = w; }
    }
};
struct EpiNull { static constexpr bool PERM = true; static constexpr int NST = 0;
    typedef EpiPreNone Pre; __device__ __forceinline__ Pre pre(const Unit&, int, int, int, int) const { return Pre{}; }
    __device__ __forceinline__ void operator()(const Acc& acc, const Unit& u, int wr, int wc, int fr, int fq, const Pre&) const {
#pragma unroll
        for (int ai = 0; ai < 2; ++ai)
#pragma unroll
            for (int bj = 0; bj < 2; ++bj)
#pragma unroll
                for (int m = 0; m < 4; ++m)
#pragma unroll
                    for (int n = 0; n < 2; ++n) asm volatile("" :: "v"(acc[ai][bj][m][n]));
    }
};
}

namespace attn {
constexpr int D = 128, NW = 8, QBLK = 32, KVBLK = 64;
constexpr float SCALE = 0.088388347648318440f;
constexpr float THR = 8.f;
constexpr int LDQ = 128, LDK = 128;
constexpr size_t SHM_V = KVBLK * D * 2, SHM_K = KVBLK * D * 2, SHM_ATTN = 2 * SHM_V + 2 * SHM_K + NW * 64 * 4;
#define KSWZ(row, colB) ((row) * 256 + ((colB) ^ (((row) & 7) << 4)))
#define SBAR() __builtin_amdgcn_sched_barrier(0)
__device__ __forceinline__ unsigned cvtpk(float lo, float hi) { unsigned r; asm volatile("v_cvt_pk_bf16_f32 %0, %1, %2" : "=v"(r) : "v"(lo), "v"(hi)); return r; }
__device__ __forceinline__ bf16x8 ld8(const bf16_t* p) { return *reinterpret_cast<const bf16x8*>(p); }

__device__ __forceinline__ void partialSM(f32x16& p0, f32x16& p1, float& m_reg, float& mn, float& alpha) {
  constexpr float C = SCALE * 1.4426950408889634f;
  float pmax = p0[0]; for (int r = 1; r < 16; ++r) pmax = fmaxf(pmax, p0[r]); for (int r = 0; r < 16; ++r) pmax = fmaxf(pmax, p1[r]);
  { auto rr = __builtin_amdgcn_permlane32_swap(__float_as_uint(pmax), __float_as_uint(pmax), false, false);
    pmax = fmaxf(__uint_as_float(rr[0]), __uint_as_float(rr[1])); }
  if (__builtin_expect(__all(pmax - m_reg <= THR / SCALE), 1)) { mn = m_reg; alpha = 1.f; }
  else { mn = fmaxf(m_reg, pmax); alpha = __builtin_amdgcn_exp2f((m_reg - mn) * C); m_reg = mn; }
  float mnC = -mn * C;
  for (int r = 0; r < 16; ++r) p0[r] = fmaf(p0[r], C, mnC); for (int r = 0; r < 16; ++r) p1[r] = fmaf(p1[r], C, mnC);
  for (int r = 0; r < 16; ++r) p0[r] = __builtin_amdgcn_exp2f(p0[r]);
}
__device__ __forceinline__ void finishSM(f32x16& p0, f32x16& p1, float alpha, float& l_reg, bf16x8& pa0, bf16x8& pa1, bf16x8& pa2, bf16x8& pa3) {
  for (int r = 0; r < 16; ++r) p1[r] = __builtin_amdgcn_exp2f(p1[r]);
  float ps = 0; for (int r = 0; r < 16; ++r) ps += p0[r]; for (int r = 0; r < 16; ++r) ps += p1[r];
  { auto rr = __builtin_amdgcn_permlane32_swap(__float_as_uint(ps), __float_as_uint(ps), false, false);
    ps = __uint_as_float(rr[0]) + __uint_as_float(rr[1]); }
  l_reg = l_reg * alpha + ps;
#define PK4(P, BASE, OUT) do { unsigned a0 = cvtpk(P[BASE + 0], P[BASE + 1]), a1 = cvtpk(P[BASE + 2], P[BASE + 3]);   \
    unsigned b0 = cvtpk(P[BASE + 4], P[BASE + 5]), b1 = cvtpk(P[BASE + 6], P[BASE + 7]);                              \
    auto r0 = __builtin_amdgcn_permlane32_swap(a0, b0, false, false); auto r1 = __builtin_amdgcn_permlane32_swap(a1, b1, false, false); \
    u32x4 w = {r0[0], r1[0], r0[1], r1[1]}; OUT = *reinterpret_cast<bf16x8*>(&w); } while (0)
  PK4(p0, 0, pa0); PK4(p0, 8, pa1); PK4(p1, 0, pa2); PK4(p1, 8, pa3);
#undef PK4
}
__device__ __forceinline__ void qkt(f32x16& p0, f32x16& p1, const bf16_t* Ks, const bf16x8* qr, int r32, int hi) {
  p0 = f32x16{}; p1 = f32x16{};
  for (int d0 = 0; d0 < 8; ++d0) { int cb = (d0 * 16 + hi * 8) * 2;
    bf16x8 b0 = *reinterpret_cast<const bf16x8*>((const char*)Ks + KSWZ(r32, cb));
    bf16x8 b1 = *reinterpret_cast<const bf16x8*>((const char*)Ks + KSWZ(32 + r32, cb));
    p0 = __builtin_amdgcn_mfma_f32_32x32x16_bf16(b0, qr[d0], p0, 0, 0, 0);
    p1 = __builtin_amdgcn_mfma_f32_32x32x16_bf16(b1, qr[d0], p1, 0, 0, 0); }
}
__device__ __forceinline__ int v_st(int k, int c) { const int kk = (k & ~0xC) | ((k & 4) << 1) | ((k & 8) >> 1); return ((kk >> 3) * 4 + (c >> 5)) * 512 + ((kk & 7) * 32 + (c & 31)) * 2; }
__device__ __forceinline__ int v_rd_base(int lane) { return ((lane & 3) << 3) | (((lane >> 2) & 3) << 6) | (((lane >> 4) & 1) << 5) | (((lane >> 5) & 1) << 8); }
constexpr int v_rd_off(int d0, int ks, int half) { return d0 * 512 + ks * 4096 + half * 2048; }
template <int OFF> __device__ __forceinline__ s16x4 tr_read(int vb) {
  s16x4 r; asm volatile("ds_read_b64_tr_b16 %0, %1 offset:%2" : "=&v"(r) : "v"(vb), "i"(OFF) : "memory"); return r;
}
template <int D0> __device__ __forceinline__ void pv_one(f32x16& od, int vb, bf16x8 pa0, bf16x8 pa1, bf16x8 pa2, bf16x8 pa3) {
  const s16x4 l0 = tr_read<v_rd_off(D0, 0, 0)>(vb), h0 = tr_read<v_rd_off(D0, 0, 1)>(vb), l1 = tr_read<v_rd_off(D0, 1, 0)>(vb), h1 = tr_read<v_rd_off(D0, 1, 1)>(vb);
  const s16x4 l2 = tr_read<v_rd_off(D0, 2, 0)>(vb), h2 = tr_read<v_rd_off(D0, 2, 1)>(vb), l3 = tr_read<v_rd_off(D0, 3, 0)>(vb), h3 = tr_read<v_rd_off(D0, 3, 1)>(vb);
  asm volatile("s_waitcnt lgkmcnt(0)" ::: "memory"); SBAR();
#define PK(L, H) (bf16x8){L[0], L[1], L[2], L[3], H[0], H[1], H[2], H[3]}
  od = __builtin_amdgcn_mfma_f32_32x32x16_bf16(pa0, PK(l0, h0), od, 0, 0, 0);
  od = __builtin_amdgcn_mfma_f32_32x32x16_bf16(pa1, PK(l1, h1), od, 0, 0, 0);
  od = __builtin_amdgcn_mfma_f32_32x32x16_bf16(pa2, PK(l2, h2), od, 0, 0, 0);
  od = __builtin_amdgcn_mfma_f32_32x32x16_bf16(pa3, PK(l3, h3), od, 0, 0, 0);
#undef PK
}
__device__ __forceinline__ void pv_d0(f32x16* o, int vb, bf16x8 pa0, bf16x8 pa1, bf16x8 pa2, bf16x8 pa3) {
  pv_one<0>(o[0], vb, pa0, pa1, pa2, pa3); pv_one<1>(o[1], vb, pa0, pa1, pa2, pa3); pv_one<2>(o[2], vb, pa0, pa1, pa2, pa3); pv_one<3>(o[3], vb, pa0, pa1, pa2, pa3);
}
__device__ __forceinline__ void attn_dense_body(const bf16_t* __restrict__ Qb, const bf16_t* __restrict__ Kh, const bf16_t* __restrict__ Vh,
                                                bf16_t* __restrict__ Ob, int ldo, int seq, char* lds, const int tid) {
  const int wid = tid >> 6, lane = tid & 63, r32 = lane & 31, hi = lane >> 5;
  bf16_t* V_lds = (bf16_t*)lds; bf16_t* K_lds = (bf16_t*)(lds + 2 * SHM_V);
  float* ws = (float*)(lds + 2 * SHM_V + 2 * SHM_K) + wid * 64; float* li_l = ws; float* al_l = ws + 32;
  float m_reg = -1e30f, l_reg = 0; f32x16 o[4] = {}; bf16x8 qr[8];
  const bf16_t* Qw = Qb + (long)(wid * QBLK + r32) * LDQ + hi * 8;
#pragma unroll
  for (int d0 = 0; d0 < 8; ++d0) qr[d0] = ld8(Qw + d0 * 16);
  const int sr = tid >> 4, sc = (tid & 15) * 8, vst0 = v_st(sr, sc), vst1 = v_st(32 + sr, sc);
  const int vb0 = (int)(uintptr_t)V_lds + v_rd_base(lane);
  struct { bf16x8 vs0, vs1, ks0, ks1; } sr_[2];
#define SLOAD(i, k0) do { sr_[i].vs0 = ld8(&Vh[(long)((k0) + sr) * LDK + sc]); sr_[i].vs1 = ld8(&Vh[(long)((k0) + 32 + sr) * LDK + sc]); \
    sr_[i].ks0 = ld8(&Kh[(long)((k0) + sr) * LDK + sc]); sr_[i].ks1 = ld8(&Kh[(long)((k0) + 32 + sr) * LDK + sc]); } while (0)
#define SWRITE(b, i) do { *(bf16x8*)((char*)V_lds + (b) * SHM_V + vst0) = sr_[i].vs0;          \
    *(bf16x8*)((char*)V_lds + (b) * SHM_V + vst1) = sr_[i].vs1; int kc = sc * 2;               \
    *(bf16x8*)((char*)K_lds + (b) * SHM_K + KSWZ(sr, kc)) = sr_[i].ks0;                       \
    *(bf16x8*)((char*)K_lds + (b) * SHM_K + KSWZ(32 + sr, kc)) = sr_[i].ks1; } while (0)
#define SWAIT() asm volatile("s_waitcnt vmcnt(4)" ::: "memory")
#define RESC(a) do { if (__any((a) < 1.f)) { if (hi == 0) al_l[r32] = (a); asm volatile("s_waitcnt lgkmcnt(0)" ::: "memory"); \
    for (int d = 0; d < 4; ++d) for (int r = 0; r < 16; ++r) o[d][r] *= al_l[crow(r, hi)]; } } while (0)
  f32x16 pA0, pA1, pB0, pB1; float mnA, mnB, alA, alB; bf16x8 pa0, pa1, pa2, pa3; const int NT = seq / KVBLK;
  constexpr int SE = 0, SO = 1;
  SLOAD(SE, 0); asm volatile("s_waitcnt vmcnt(0)" ::: "memory"); SWRITE(0, SE); __syncthreads();
  qkt(pA0, pA1, K_lds, qr, r32, hi); partialSM(pA0, pA1, m_reg, mnA, alA);
  SLOAD(SO, KVBLK); if (2 < NT) SLOAD(SE, 2 * KVBLK);
  SWAIT(); SWRITE(1, SO); __syncthreads();
  for (int j = 1; j + 1 < NT; j += 2) {
    SBAR(); qkt(pB0, pB1, (bf16_t*)((char*)K_lds + SHM_K), qr, r32, hi);
    finishSM(pA0, pA1, alA, l_reg, pa0, pa1, pa2, pa3); SBAR();
    SLOAD(SO, (j + 2) * KVBLK); SBAR();
    pv_d0(o, vb0, pa0, pa1, pa2, pa3); partialSM(pB0, pB1, m_reg, mnB, alB);
    __syncthreads(); SWAIT(); SWRITE(0, SE);
    RESC(alB); __syncthreads();
    SBAR(); qkt(pA0, pA1, K_lds, qr, r32, hi);
    finishSM(pB0, pB1, alB, l_reg, pa0, pa1, pa2, pa3); SBAR();
    if (j + 3 < NT) SLOAD(SE, (j + 3) * KVBLK); SBAR();
    pv_d0(o, vb0 + (int)SHM_V, pa0, pa1, pa2, pa3); partialSM(pA0, pA1, m_reg, mnA, alA);
    __syncthreads(); SWAIT(); SWRITE(1, SO);
    RESC(alA); __syncthreads();
  }
  SBAR(); qkt(pB0, pB1, (bf16_t*)((char*)K_lds + SHM_K), qr, r32, hi);
  finishSM(pA0, pA1, alA, l_reg, pa0, pa1, pa2, pa3); SBAR();
  pv_d0(o, vb0, pa0, pa1, pa2, pa3); partialSM(pB0, pB1, m_reg, mnB, alB);
  __syncthreads(); RESC(alB);
  finishSM(pB0, pB1, alB, l_reg, pa0, pa1, pa2, pa3); SBAR();
  pv_d0(o, vb0 + (int)SHM_V, pa0, pa1, pa2, pa3);
  if (hi == 0) li_l[r32] = l_reg; asm volatile("s_waitcnt lgkmcnt(0)" ::: "memory");
  float rli[16];
#pragma unroll
  for (int r = 0; r < 16; ++r) rli[r] = __builtin_amdgcn_rcpf(li_l[crow(r, hi)]);
  int wid_o = __builtin_amdgcn_readfirstlane(wid); asm volatile("" : "+s"(wid_o));
  bf16_t* Ow = Ob + (long)(wid_o * QBLK) * ldo;
  int lane_o = lane; asm volatile("" : "+v"(lane_o)); const int r32o = lane_o & 31, hio = lane_o >> 5;
#pragma unroll
  for (int r = 0; r < 16; ++r) { int orow = crow(r, hio);
    for (int d0 = 0; d0 < 4; ++d0) Ow[(long)orow * ldo + d0 * 32 + r32o] = f2bf(o[d0][r] * rli[r]); }
  __syncthreads();
#undef SLOAD
#undef SWRITE
#undef SWAIT
#undef RESC
}
}

struct Args { const float* in[N_IN]; float* out; unsigned char* ws; int ph_lo, ph_hi; };
struct Frame {
    LAS unsigned char* lds;
    unsigned char* ldsg;
    float* out; unsigned char* ws; unsigned* ctl;
    unsigned char* ws0; unsigned lds0;
    int tid, lane, wave, G, gw, NGW, bid;
    int wave0;
};
#define CAS __attribute__((address_space(4)))
__device__ __forceinline__ const float* inptr(int i) { const CAS char* k = (const CAS char*)__builtin_amdgcn_kernarg_segment_ptr(); return *(const float* const volatile CAS*)(k + 8 * i); }
constexpr int LDS_CTL = 64;
constexpr int LDS_REGION = 156 * 1024;
constexpr int LDS_BYTES = LDS_CTL + LDS_REGION;

__device__ __forceinline__ void frame_tid(Frame& F) { int t = F.wave0 * 64 + (int)__builtin_amdgcn_mbcnt_hi(~0u, __builtin_amdgcn_mbcnt_lo(~0u, 0u)); asm volatile("" : "+v"(t)); F.tid = t; F.lane = t & 63; F.wave = __builtin_amdgcn_readfirstlane(t >> 6);
    int bid = blockIdx.x; asm volatile("" : "+s"(bid)); F.bid = bid; F.gw = bid * NWAVES + F.wave;
    unsigned char* w = F.ws0; unsigned lb = F.lds0; asm volatile("" : "+s"(w), "+s"(lb));
    F.ws = w; F.ctl = (unsigned*)(w + WS_CTL); F.lds = (LAS unsigned char*)(uintptr_t)lb + LDS_CTL; F.ldsg = (unsigned char*)F.lds; }
template <typename T> __device__ __forceinline__ T* wsp(const Frame& F, size_t off) { return (T*)(F.ws + off); }

struct CvtItem { const float* src; unsigned ld_src; int f8; unsigned char* dst; };
__device__ __forceinline__ size_t wtile_off(int n, int kbyte, int kb) { return (size_t)(n >> 8) * 256u * (size_t)kb + (size_t)(kbyte >> 7) * 32768u + (size_t)(n & 255) * 128u + (size_t)(kbyte & 127); }
__device__ __forceinline__ void cvt_load(const CvtItem& c, f32x4* v, int lane) {
    const int r4 = lane >> 4, c4 = (lane & 15) * 4;
#pragma unroll
    for (int i = 0; i < 16; ++i) v[i] = *(const f32x4*)(c.src + (size_t)(4 * i + r4) * c.ld_src + c4);
}
__device__ __forceinline__ void cvt_store(const CvtItem& c, const f32x4* v, LAS float* scr, int lane) {
    const int r4 = lane >> 4, c4 = (lane & 15) * 4;
#pragma unroll
    for (int i = 0; i < 16; ++i) { LAS float* q = scr + (4 * i + r4) * 65 + c4; q[0] = v[i].x; q[1] = v[i].y; q[2] = v[i].z; q[3] = v[i].w; }
    LDS_WAIT();
    const int cc = lane & 7;
    if (c.f8) {
#pragma unroll
        for (int j = 0; j < 8; ++j) { const int n = (lane >> 3) + 8 * j; const LAS float* t = scr + (8 * cc) * 65 + n;
            u32x2 o; o.x = pk4_fp8(t[0 * 65] * F8_WSCALE, t[1 * 65] * F8_WSCALE, t[2 * 65] * F8_WSCALE, t[3 * 65] * F8_WSCALE); o.y = pk4_fp8(t[4 * 65] * F8_WSCALE, t[5 * 65] * F8_WSCALE, t[6 * 65] * F8_WSCALE, t[7 * 65] * F8_WSCALE);
            *(u32x2*)(c.dst + (size_t)n * 128 + 8 * cc) = o; }
    } else {
#pragma unroll
        for (int j = 0; j < 8; ++j) { const int n = (lane >> 3) + 8 * j; const LAS float* t = scr + (8 * cc) * 65 + n;
            u32x4 o; o.x = pk2(t[0 * 65], t[1 * 65]); o.y = pk2(t[2 * 65], t[3 * 65]); o.z = pk2(t[4 * 65], t[5 * 65]); o.w = pk2(t[6 * 65], t[7 * 65]);
            *(u32x4*)(c.dst + (size_t)n * 128 + 16 * cc) = o; }
    }
    LDS_WAIT();
}
constexpr int TR_SCR = 64 * 65;
constexpr int CVT_NMIX = 16 * 96 + 4 * 16 * 16 + 4 * 8 * 16 + 16 * 16;
__device__ __forceinline__ int cvt_count(int l) { return CVT_NMIX + (((l & 1) == 0) ? (2 * 16 * 44 + 44 * 16) : NEXP * (2 * 16 * 56 + 56 * 16)); }
__device__ __forceinline__ CvtItem cvt_item(const Frame& F, int l, int r) {
    CvtItem c; constexpr int N1 = 16 * 96, N2 = 4 * 16 * 16, N3 = 4 * 8 * 16, N4 = 16 * 16;
    if (r < N1) { const int kb = r / 96, nb = r % 96; c.src = inptr(I_WIN) + (size_t)l * DM * INW + (size_t)(64 * kb) * INW + 64 * nb; c.ld_src = INW; c.f8 = 0; c.dst = wsp<unsigned char>(F, WS_WCAT) + wtile_off(64 * nb, 128 * kb, 2 * DM); return c; } r -= N1;
    if (r < N2) { const int i = r / 256, r2 = r % 256, kb = r2 / 16, nb = r2 % 16; c.src = inptr(I_WGATE) + (size_t)l * 4 * DM * DM + (size_t)i * DM * DM + (size_t)(64 * kb) * DM + 64 * nb; c.ld_src = DM; c.f8 = 1;
        c.dst = wsp<unsigned char>(F, WS_WG8) + wtile_off(i * 1024 + 64 * nb, 64 * kb, DM); return c; } r -= N2;
    if (r < N3) { const int i = r / 128, r2 = r % 128, kb = r2 / 16, nb = r2 % 16; c.src = inptr(I_WBR) + (size_t)l * 4 * 512 * DM + (size_t)i * 512 * DM + (size_t)(64 * kb) * DM + 64 * nb; c.ld_src = DM; c.f8 = 0;
        c.dst = wsp<unsigned char>(F, WS_WB) + wtile_off(i * 1024 + 64 * nb, 128 * kb, 1024); return c; } r -= N3;
    if (r < N4) { const int kb = r / 16, nb = r % 16; c.src = inptr(I_WO) + (size_t)l * DM * DM + (size_t)(64 * kb) * DM + 64 * nb; c.ld_src = DM; c.f8 = 0; c.dst = wsp<unsigned char>(F, WS_WO4) + wtile_off(64 * nb, 128 * kb, 2 * DM); return c; } r -= N4;
    unsigned char* W13 = wsp<unsigned char>(F, (l & 1) ? WS_W13 : WS_W13D); unsigned char* W2 = wsp<unsigned char>(F, (l & 1) ? WS_W2 : WS_W2D);
    const int i = l >> 1; c.f8 = 1;
    if ((l & 1) == 0) { constexpr int NA = 16 * 44;
        if (r < 2 * NA) { const int which = r / NA; r %= NA; const int kb = r / 44, nb = r % 44, n0 = 64 * nb, drow = (n0 >> 7) * 256 + (n0 & 127) + which * 128;
            c.src = inptr(which ? I_FW3 : I_FW1) + (size_t)i * DM * FFD + (size_t)(64 * kb) * FFD + n0; c.ld_src = FFD; c.dst = W13 + wtile_off(drow, 64 * kb, DM); return c; } r -= 2 * NA;
        { const int kb = r / 16, nb = r % 16; c.src = inptr(I_FW2) + (size_t)i * FFD * DM + (size_t)(64 * kb) * DM + 64 * nb; c.ld_src = DM; c.dst = W2 + wtile_off(64 * nb, 64 * kb, FFD); return c; }
    } else { constexpr int NA = 16 * 56, NC = 56 * 16;
        if (r < NEXP * 2 * NA) { const int e = r / (2 * NA); r %= 2 * NA; const int which = r / NA; r %= NA; const int kb = r / 56, nb = r % 56, n0 = 64 * nb, drow = e * 2 * FFE + (n0 >> 7) * 256 + (n0 & 127) + which * 128;
            c.src = inptr(which ? I_MW3 : I_MW1) + (size_t)(i * NEXP + e) * DM * FFE + (size_t)(64 * kb) * FFE + n0; c.ld_src = FFE; c.dst = W13 + wtile_off(drow, 64 * kb, DM); return c; } r -= NEXP * 2 * NA;
        { const int e = r / NC; r %= NC; const int kb = r / 16, nb = r % 16; c.src = inptr(I_MW2) + (size_t)(i * NEXP + e) * FFE * DM + (size_t)(64 * kb) * DM + 64 * nb; c.ld_src = DM; c.dst = W2 + wtile_off(e * DM + 64 * nb, 64 * kb, FFE); return c; }
    }
}
__device__ __forceinline__ void cvt_range(const Frame& F, int l, int i0, int i1, int b0) {
    if (F.bid < b0) return;
    LAS float* scr = (LAS float*)(F.lds) + F.wave * TR_SCR;
    const int stride = (256 - b0) * NWAVES; int it = i0 + (F.bid - b0) * NWAVES + F.wave; if (it >= i1) return;
    CvtItem cur = cvt_item(F, l, it); f32x4 v[16]; cvt_load(cur, v, F.lane);
    for (;;) {
        const int nx = it + stride; const bool has = nx < i1; CvtItem nxt = cur; f32x4 vn[16];
        if (has) { nxt = cvt_item(F, l, nx); cvt_load(nxt, vn, F.lane); }
        cvt_store(cur, v, scr, F.lane);
        if (!has) break;
        cur = nxt; it = nx;
#pragma unroll
        for (int i = 0; i < 16; ++i) v[i] = vn[i];
    }
}
constexpr int CVT_NF_D = 2 * 16 * 44 + 44 * 16, CVT_NF_M = NEXP * (2 * 16 * 56 + 56 * 16), CVT_D1 = 5000, CVT_A1 = 11000, CVT_B1 = 14800;
template <int K> __device__ __forceinline__ void cvt_ffn_share(const Frame& F, int l, int b0) {
    if ((l & 1) || l + 1 >= DEPTH) return;
    const int lo = K == 0 ? CVT_D1 : (K == 1 ? CVT_A1 : CVT_B1), hi = K == 0 ? CVT_A1 : (K == 1 ? CVT_B1 : CVT_NF_M);
    cvt_range(F, l + 1, CVT_NMIX + lo, CVT_NMIX + hi, b0);
}
__device__ __forceinline__ int cvt_e1(int l) { return (l & 1) ? CVT_D1 : CVT_NF_D; }

__device__ __forceinline__ void p0_mod(const Frame& F) {
    LAS float* act = (LAS float*)(F.lds);
    LAS float* red = act + 5 * 1024;
    const float* c = inptr(I_C); const float* cc = inptr(I_CCTX);
    for (int i = F.tid; i < 5 * 1024; i += NTHREADS) { const float v = (i < 4096) ? c[i] : cc[i - 4096]; act[i] = siluf_(v); }
    __syncthreads();
    float* MOD = wsp<float>(F, WS_MOD);
    for (int u = F.bid; u < DEPTH * 96; u += F.G) {
        const int l = u / 96, cg = u % 96, cl = F.tid & 63, ks = F.tid >> 6, col = cg * 64 + cl;
        const float* w = inptr(I_WMOD) + (size_t)l * DM * 6144 + col;
        float a0 = 0.f, a1 = 0.f, a2 = 0.f, a3 = 0.f, a4 = 0.f;
#pragma unroll 16
        for (int k = ks * 128; k < ks * 128 + 128; ++k) { const float wv = w[(size_t)k * 6144];
            a0 += act[k] * wv; a1 += act[1024 + k] * wv; a2 += act[2048 + k] * wv; a3 += act[3072 + k] * wv; a4 += act[4096 + k] * wv; }
        red[(ks * 5 + 0) * 64 + cl] = a0; red[(ks * 5 + 1) * 64 + cl] = a1; red[(ks * 5 + 2) * 64 + cl] = a2; red[(ks * 5 + 3) * 64 + cl] = a3; red[(ks * 5 + 4) * 64 + cl] = a4;
        __syncthreads();
        if (F.tid < 320) { const int j = F.tid >> 6, c2 = F.tid & 63; float s = inptr(I_BMOD)[(size_t)l * 6144 + cg * 64 + c2];
#pragma unroll
            for (int k2 = 0; k2 < 8; ++k2) s += red[(k2 * 5 + j) * 64 + c2];
            MOD[((size_t)l * 5 + j) * 6144 + cg * 64 + c2] = s; }
        __syncthreads();
    }
}

__device__ __forceinline__ void p0_filters(const Frame& F) {
    constexpr int NR = 96, HLD = 72;
    LAS float* FT = (LAS float*)(F.lds);
    LAS float* H1 = FT + NR * 33;
    LAS bf16_t* H2 = (LAS bf16_t*)(H1 + NR * 64);
    LAS float* W1 = (LAS float*)(H2 + 98 * HLD);
    LAS float* W2 = W1 + 33 * 64;
    LAS bf16_t* W3T = (LAS bf16_t*)(W2 + 64 * 64);
    bf16_t* GF = wsp<bf16_t>(F, WS_GF); float* GC = wsp<float>(F, WS_GC);
    const float min_decay = -3.0701134573253944f, max_decay = -15.350567286626972f;
    const int lane = F.lane, r32 = lane & 31, hi = lane >> 5;
    for (int u = F.bid; u < DEPTH * 64; u += F.G) {
        const int l = u / 64, q = u % 64; const bool hasctx = q < 16;
        const float* w1 = inptr(I_HW1) + (size_t)l * 33 * 64; const float* b1 = inptr(I_HB1) + l * 64; const float* w2 = inptr(I_HW2) + (size_t)l * 64 * 64; const float* b2 = inptr(I_HB2) + l * 64;
        const float* w3 = inptr(I_HW3) + (size_t)l * 64 * 2048; const float* fr0 = inptr(I_HFREQ) + l * 128; const float* fr1 = fr0 + 64;
        for (int i = F.tid; i < 33 * 64; i += NTHREADS) W1[i] = w1[i];
        for (int i = F.tid; i < 64 * 64; i += NTHREADS) W2[i] = w2[i];
        for (int idx = F.tid; idx < NR * 33; idx += NTHREADS) { const int R = idx / 33, f = idx % 33; const bool isctx = R >= 68;
            const int L = isctx ? NCTX : SEQ, p = isctx ? 16 * q + R - 68 : 64 * q + R;
            const float t = (float)p / (float)(L - 1); float v;
            if (f == 0) v = t; else { const int k = (f - 1) & 15; const float fk = 1e-4f + (float)k * ((15.0f - 1e-4f) / 15.0f); float qq = (float)p * fk / (float)L; qq -= floorf(qq);
                v = (f <= 16) ? __builtin_amdgcn_cosf(qq) : -__builtin_amdgcn_sinf(qq); }
            FT[idx] = v; }
        __syncthreads();
        for (int idx = F.tid; idx < NR * 64; idx += NTHREADS) { const int R = idx >> 6, jj = idx & 63; float sacc = b1[jj];
#pragma unroll 11
            for (int f = 0; f < 33; ++f) sacc += FT[R * 33 + f] * W1[f * 64 + jj];
            H1[idx] = __builtin_amdgcn_sinf(fr0[jj] * sacc * 0.15915494309189535f); }
        __syncthreads();
        for (int idx = F.tid; idx < NR * 64; idx += NTHREADS) { const int R = idx >> 6, jj = idx & 63; float sacc = b2[jj];
#pragma unroll 16
            for (int k = 0; k < 64; ++k) sacc += H1[R * 64 + k] * W2[k * 64 + jj];
            H2[R * HLD + jj] = f2bf(__builtin_amdgcn_sinf(fr1[jj] * sacc * 0.15915494309189535f)); }
        if (F.tid < 64) H2[NR * HLD + F.tid] = 0;
        __syncthreads();
#pragma unroll 1
        for (int r = 0; r < 4; ++r) {
            const int o = r >> 1, dir = r & 1;
            { const int j = F.tid + 512 * r; float wc[64];
#pragma unroll
              for (int k = 0; k < 64; ++k) wc[k] = w3[(size_t)k * 2048 + j];
#pragma unroll
              for (int k = 0; k < 64; k += 8) *(LAS u32x4*)(W3T + F.tid * HLD + k) = pack8(wc + k); }
            __syncthreads();
#pragma unroll 1
            for (int t2 = 0; t2 < 2; ++t2) {
                const int n0 = 32 * (2 * F.wave + t2), ch = n0 + r32, j = ch + 512 * r;
                f32x16 acc[3] = {};
                const LAS bf16_t* ap = H2 + (r32 + dir) * HLD + 8 * hi; const LAS bf16_t* bp = W3T + (n0 + r32) * HLD + 8 * hi;
#pragma unroll
                for (int k0 = 0; k0 < 64; k0 += 16) { const bf16x8 bv = *(const LAS bf16x8*)(bp + k0);
#pragma unroll
                    for (int mt = 0; mt < 3; ++mt) acc[mt] = __builtin_amdgcn_mfma_f32_32x32x16_bf16(*(const LAS bf16x8*)(ap + mt * 32 * HLD + k0), bv, acc[mt], 0, 0, 0); }
                const float adelta = fabsf(min_decay + (float)j * ((max_decay - min_decay) / 2047.0f));
                bf16_t* grow = GF + (((size_t)l * 2 + o) * 512 + ch) * 8192; float* crow_ = GC + (((size_t)l * 2 + o) * 512 + ch) * 512;
#pragma unroll
                for (int mt = 0; mt < 2; ++mt)
#pragma unroll
                    for (int g = 0; g < 4; ++g) { const int X = 64 * q + 32 * mt + 8 * g + 4 * hi; float v[4];
#pragma unroll
                        for (int e = 0; e < 4; ++e) { const int p = X + dir + e; v[e] = (p < SEQ) ? acc[mt][4 * g + e] * __expf(-(float)p * (1.f / (float)(SEQ - 1)) * adelta) : 0.f; }
                        u32x2 w; if (dir == 0) { w.x = pk2(v[0], v[1]); w.y = pk2(v[2], v[3]); *(u32x2*)(grow + 4096 + X) = w; }
                        else { w.x = pk2(v[3], v[2]); w.y = pk2(v[1], v[0]); *(u32x2*)(grow + 4092 - X) = w; } }
                if (hasctx) {
#pragma unroll
                    for (int g = 0; g < 3; ++g) { const int rr = 8 * g + 4 * hi; if (rr >= 4 && rr < 20) {
#pragma unroll
                        for (int e = 0; e < 4; ++e) { const int p = 16 * q + (rr - 4) + dir + e; const float val = (p < NCTX) ? acc[2][4 * g + e] * __expf(-(float)p * (1.f / (float)(NCTX - 1)) * adelta) : 0.f;
                            if (dir == 0) crow_[256 + p] = val; else crow_[256 - p] = val; } } } }
            }
            __syncthreads();
        }
    }
    if (F.bid == 0) { float* TB = wsp<float>(F, WS_ROPE);
        for (int idx = F.tid; idx < 64 * 32; idx += NTHREADS) { const int v = idx >> 5, k = idx & 31; const float inv = __builtin_amdgcn_exp2f(-(float)k * (13.287712379549449f / 32.0f)); const float rev = (float)v * inv * 0.15915494309189535f;
            TB[idx] = __builtin_amdgcn_cosf(rev); TB[2048 + idx] = __builtin_amdgcn_sinf(rev); } }
}

__device__ __forceinline__ void store_mod_row(const f32x4* v, const float* m0, const float* m1, bf16_t* orow, int lane) {
#pragma unroll
    for (int j = 0; j < 4; ++j) { const f32x4 a = *(const f32x4*)(m0 + 4 * lane + 256 * j), s = *(const f32x4*)(m1 + 4 * lane + 256 * j); const f32x4 u = v[j] * (s + 1.0f) + a;
        u32x2 w; w.x = pk2(u.x, u.y); w.y = pk2(u.z, u.w); *(u32x2*)(orow + 4 * lane + 256 * j) = w; }
}
__device__ __forceinline__ void store_mod_row8(const f32x4* v, const float* m0, const float* m1, unsigned char* orow, int lane) {
#pragma unroll
    for (int j = 0; j < 4; ++j) { const f32x4 a = *(const f32x4*)(m0 + 4 * lane + 256 * j), sc = *(const f32x4*)(m1 + 4 * lane + 256 * j); const f32x4 u = v[j] * (sc + 1.0f) + a;
        *(unsigned*)(orow + 4 * lane + 256 * j) = pk4_fp8(u.x, u.y, u.z, u.w); }
}
__device__ __forceinline__ int row_bsel(int row) { return row < T_LAT ? (row >> 12) : 4; }
__device__ __forceinline__ void p0b_rows(const Frame& F) {
    bf16_t* XF = wsp<bf16_t>(F, WS_XF); bf16_t* U = wsp<bf16_t>(F, WS_U); const float* MOD = wsp<float>(F, WS_MOD);
    f32x4 nv[4];
    if (F.gw < T_ALL) { const int row = F.gw; const float* src = row < T_LAT ? inptr(I_X) + (size_t)row * DM : inptr(I_CTX) + (size_t)(row - T_LAT) * DM;
#pragma unroll
        for (int j = 0; j < 4; ++j) nv[j] = *(const f32x4*)(src + 4 * F.lane + 256 * j); }
    for (int row = F.gw; row < T_ALL; row += F.NGW) {
        f32x4 v[4];
#pragma unroll
        for (int j = 0; j < 4; ++j) v[j] = nv[j];
        if (row + F.NGW < T_ALL) { const int r2 = row + F.NGW; const float* src = r2 < T_LAT ? inptr(I_X) + (size_t)r2 * DM : inptr(I_CTX) + (size_t)(r2 - T_LAT) * DM;
#pragma unroll
            for (int j = 0; j < 4; ++j) nv[j] = *(const f32x4*)(src + 4 * F.lane + 256 * j); }
#pragma unroll
        for (int j = 0; j < 4; ++j) *(u32x2*)(XF + (size_t)row * DM + 4 * F.lane + 256 * j) = f32_bf4(v[j]);
        const float* m = MOD + (size_t)row_bsel(row) * 6144;
        store_mod_row(v, m, m + 1024, U + (size_t)row * DM, F.lane);
        store_mod_row8(v, m, m + 1024, wsp<unsigned char>(F, WS_U8M) + (size_t)row * DM, F.lane);
    }
}
__device__ __forceinline__ void ln_row(f32x4* v, const float* g, const float* b, int lane) {
    float s = 0.f;
#pragma unroll
    for (int j = 0; j < 4; ++j) s += (v[j].x + v[j].y) + (v[j].z + v[j].w);
    const float mean = wave_sum(s, lane) * (1.f / DM); float s2 = 0.f;
#pragma unroll
    for (int j = 0; j < 4; ++j) { v[j] = v[j] - mean; s2 += (v[j].x * v[j].x + v[j].y * v[j].y) + (v[j].z * v[j].z + v[j].w * v[j].w); }
    const float rstd = rsqrtf(wave_sum(s2, lane) * (1.f / DM) + LN_EPS);
#pragma unroll
    for (int j = 0; j < 4; ++j) { const f32x4 gg = *(const f32x4*)(g + 4 * lane + 256 * j), bb = *(const f32x4*)(b + 4 * lane + 256 * j); v[j] = v[j] * rstd * gg + bb; }
}

__device__ __forceinline__ u32x4 ldg8(const bf16_t* p) { return *(const u32x4*)p; }
struct TokRaw { u32x4 bg, c0, x0, cm, xm, cp, xp, q, kv; float cs[8], sn[8]; };
__device__ __forceinline__ void tok_load(const bf16_t* ZG, const float* TBC, const float* TBS, int tok, bool need_ctx, int c8, int axis, int kf0, TokRaw& r) {
    const bool isctx = tok >= T_LAT; const int t = isctx ? (tok - T_LAT) & 255 : tok & 4095, Ls = isctx ? NCTX : SEQ;
    const bf16_t* zr = ZG + (size_t)tok * ZGW; const u32x4 z4 = {0u, 0u, 0u, 0u};
    if (!isctx || need_ctx) {
        r.bg = ldg8(zr + c8); r.c0 = ldg8(zr + 512 + c8); r.x0 = ldg8(zr + 1024 + c8);
        if (t > 0) { r.cm = ldg8(zr - ZGW + 512 + c8); r.xm = ldg8(zr - ZGW + 1024 + c8); } else { r.cm = z4; r.xm = z4; }
        if (t < Ls - 1) { r.cp = ldg8(zr + ZGW + 512 + c8); r.xp = ldg8(zr + ZGW + 1024 + c8); } else { r.cp = z4; r.xp = z4; }
        r.q = ldg8(zr + OFF_D + c8);
    } else { r.bg = z4; r.c0 = z4; r.x0 = z4; r.cm = z4; r.xm = z4; r.cp = z4; r.xp = z4; r.q = z4; }
    r.kv = ldg8(zr + OFF_D + 512 + c8);
    const int v = axis ? (t & 63) : (t >> 6);
#pragma unroll
    for (int e = 0; e < 8; ++e) { r.cs[e] = isctx ? 1.f : TBC[v * 32 + kf0 + e]; r.sn[e] = isctx ? 0.f : TBS[v * 32 + kf0 + e]; }
}
__device__ __forceinline__ void ph2_tokens(const Frame& F, int l, bool need_ctx) {
    const bf16_t* ZG = wsp<bf16_t>(F, WS_ZG); bf16_t* Y = wsp<bf16_t>(F, WS_Y);
    bf16_t* QP = wsp<bf16_t>(F, WS_QP); bf16_t* QC = wsp<bf16_t>(F, WS_QC); bf16_t* KALL = wsp<bf16_t>(F, WS_KALL); bf16_t* VALL = wsp<bf16_t>(F, WS_VALL);
    const float* TBC = wsp<float>(F, WS_ROPE); const float* TBS = TBC + 2048;
    const int lane = F.lane, c8 = 8 * lane, cc = lane & 15;
    float w0[8], w1[8], w2[8], cb[8], gq[8], gk[8];
    { const float* caw = inptr(I_CAW) + (size_t)l * 3 * 512; const float* cab = inptr(I_CAB) + (size_t)l * 512;
#pragma unroll
      for (int e = 0; e < 8; ++e) { w0[e] = caw[c8 + e]; w1[e] = caw[512 + c8 + e]; w2[e] = caw[1024 + c8 + e]; cb[e] = cab[c8 + e];
          gq[e] = inptr(I_QN)[l * 128 + 8 * cc + e]; gk[e] = inptr(I_KN)[l * 128 + 8 * cc + e]; } }
    const int axis = cc >> 3, half = (cc >> 2) & 1, kf0 = 8 * (cc & 3);
    const int tok_b = F.gw < 256 ? F.gw * 6 : 1536 + (F.gw - 256) * 9, tok_e0 = tok_b + (F.gw < 256 ? 6 : 9), tok_e = tok_e0 < T_ALL ? tok_e0 : T_ALL;
    if (tok_b >= tok_e) return;
    TokRaw cur; tok_load(ZG, TBC, TBS, tok_b, need_ctx, c8, axis, kf0, cur);
    for (int tok = tok_b; tok < tok_e; ++tok) {
        TokRaw nxt = cur; if (tok + 1 < tok_e) tok_load(ZG, TBC, TBS, tok + 1, need_ctx, c8, axis, kf0, nxt);
        const bool isctx = tok >= T_LAT; const int b = isctx ? (tok - T_LAT) >> 8 : tok >> 12, t = isctx ? (tok - T_LAT) & 255 : tok & 4095;
        if (!isctx || need_ctx) {
            float bg[8], c0[8], x0[8], cm[8], xm[8], cp[8], xp[8];
            unpack8(cur.bg, bg); unpack8(cur.c0, c0); unpack8(cur.x0, x0); unpack8(cur.cm, cm); unpack8(cur.xm, xm); unpack8(cur.cp, cp); unpack8(cur.xp, xp);
            float y[8];
#pragma unroll
            for (int e = 0; e < 8; ++e) y[e] = bg[e] * (w0[e] * (cm[e] * xm[e]) + w1[e] * (c0[e] * x0[e]) + w2[e] * (cp[e] * xp[e]) + cb[e]);
            *(u32x4*)(Y + (size_t)tok * YW + c8) = pack8(y);
        }
        if (!isctx || need_ctx) {
            float q[8]; unpack8(cur.q, q);
            float ss = 0.f;
#pragma unroll
            for (int e = 0; e < 8; ++e) ss += q[e] * q[e];
            ss += shfl_xor_l(ss, 1, lane); ss += shfl_xor_l(ss, 2, lane); ss += shfl_xor_l(ss, 4, lane); ss += shfl_xor_l(ss, 8, lane);
            const float r = rsqrtf(ss * (1.f / 128.f) + 1e-6f);
            float o[8];
#pragma unroll
            for (int e = 0; e < 8; ++e) { q[e] = q[e] * r * gq[e]; }
#pragma unroll
            for (int e = 0; e < 8; ++e) { const float pr = shfl_xor_l(q[e], 4, lane); o[e] = half ? (q[e] * cur.cs[e] + pr * cur.sn[e]) : (q[e] * cur.cs[e] - pr * cur.sn[e]); }
            const int head = lane >> 4;
            bf16_t* dst = isctx ? QC + ((size_t)(b * 4 + head) * NCTX + t) * 128 + 8 * cc : QP + ((size_t)(b * 4 + head) * SEQ + t) * 128 + 8 * cc;
            *(u32x4*)dst = pack8(o);
        }
        { const u32x4 raw = cur.kv; float k[8]; unpack8(raw, k);
            float ss = 0.f;
#pragma unroll
            for (int e = 0; e < 8; ++e) ss += k[e] * k[e];
            ss += shfl_xor_l(ss, 1, lane); ss += shfl_xor_l(ss, 2, lane); ss += shfl_xor_l(ss, 4, lane); ss += shfl_xor_l(ss, 8, lane);
            const float r = rsqrtf(ss * (1.f / 128.f) + 1e-6f);
            float o[8];
#pragma unroll
            for (int e = 0; e < 8; ++e) k[e] = k[e] * r * gk[e];
#pragma unroll
            for (int e = 0; e < 8; ++e) { const float pr = shfl_xor_l(k[e], 4, lane); o[e] = half ? (k[e] * cur.cs[e] + pr * cur.sn[e]) : (k[e] * cur.cs[e] - pr * cur.sn[e]); }
            const int hh = (lane >> 4) & 1, pos = isctx ? SEQ + t : t; const size_t off = ((size_t)(b * 2 + hh) * 4352 + pos) * 128 + 8 * cc;
            if (lane < 32) *(u32x4*)(KALL + off) = pack8(o); else *(u32x4*)(VALL + off) = raw; }
        cur = nxt;
    }
}
__device__ __forceinline__ void tr64_write(LAS unsigned char* tile, int row, int ck, u32x4 w) { *(LAS u32x4*)(tile + row * 128 + ((ck ^ ((row >> 3) & 7)) << 4)) = w; }
__device__ __forceinline__ u32x4 tr64_read(const LAS unsigned char* tile, int col, int tk) {
    unsigned short e[8];
#pragma unroll
    for (int i = 0; i < 8; ++i) e[i] = *(const LAS unsigned short*)(tile + (8 * tk + i) * 128 + ((((col >> 3) ^ tk) & 7) << 4) + (col & 7) * 2);
    u32x4 w; w.x = e[0] | ((unsigned)e[1] << 16); w.y = e[2] | ((unsigned)e[3] << 16); w.z = e[4] | ((unsigned)e[5] << 16); w.w = e[6] | ((unsigned)e[7] << 16); return w;
}
__device__ __forceinline__ void ph2_htrans(const Frame& F) {
    const bf16_t* ZG = wsp<bf16_t>(F, WS_ZG); bf16_t* ZHT = wsp<bf16_t>(F, WS_ZHT); bf16_t* ZHTC = wsp<bf16_t>(F, WS_ZHTC);
    LAS unsigned char* tile = F.lds + F.wave * 8192;
    const int lane = F.lane, rr = lane >> 3, ck = lane & 7;
    u32x4 nx[8];
    if (F.gw < 272 * 24) { const int tb = F.gw / 24, cbk = F.gw % 24, tok0 = tb * 64;
#pragma unroll
        for (int r = 0; r < 8; ++r) nx[r] = ldg8(ZG + (size_t)(tok0 + rr + 8 * r) * ZGW + OFF_H + cbk * 64 + 8 * ck); }
    for (int it = F.gw; it < 272 * 24; it += F.NGW) {
        const int tb = it / 24, cbk = it % 24, tok0 = tb * 64;
#pragma unroll
        for (int r = 0; r < 8; ++r) { const int row = rr + 8 * r; tr64_write(tile, row, ck, nx[r]); }
        if (it + F.NGW < 272 * 24) { const int it2 = it + F.NGW, tb2 = it2 / 24, cbk2 = it2 % 24, tok2 = tb2 * 64;
#pragma unroll
            for (int r = 0; r < 8; ++r) nx[r] = ldg8(ZG + (size_t)(tok2 + rr + 8 * r) * ZGW + OFF_H + cbk2 * 64 + 8 * ck); }
        LDS_WAIT();
        const bool isctx = tok0 >= T_LAT; const int b = isctx ? (tok0 - T_LAT) >> 8 : tok0 >> 12, t0 = isctx ? (tok0 - T_LAT) & 255 : tok0 & 4095;
#pragma unroll
        for (int r = 0; r < 8; ++r) { const int ch = rr + 8 * r; const u32x4 w = tr64_read(tile, ch, ck);
            bf16_t* dst = isctx ? ZHTC + ((size_t)(b * 1536 + cbk * 64 + ch) * NCTX + t0 + 8 * ck) : ZHT + ((size_t)(b * 1536 + cbk * 64 + ch) * SEQ + t0 + 8 * ck);
            *(u32x4*)dst = w; }
        LDS_WAIT();
    }
}
__device__ __forceinline__ void ph3b_ytrans(const Frame& F, bool need_ctx) {
    bf16_t* Y = wsp<bf16_t>(F, WS_Y); const bf16_t* YHT = wsp<bf16_t>(F, WS_YHT); const bf16_t* YHTC = wsp<bf16_t>(F, WS_YHTC);
    LAS unsigned char* tile = F.lds + F.wave * 8192;
    const int lane = F.lane, rr = lane >> 3, ck = lane & 7;
    const int ntb = need_ctx ? 272 : 256;
    const int skip = need_ctx ? 32 : 0; if (F.bid < skip) return;
    const int it0 = F.gw - skip * NWAVES, step = F.NGW - skip * NWAVES;
#define YT_LOAD(itx) do { const int tb_ = (itx) / 8, cbk_ = (itx) % 8, tok_ = tb_ * 64; const bool ic_ = tok_ >= T_LAT; const int b_ = ic_ ? (tok_ - T_LAT) >> 8 : tok_ >> 12, t_ = ic_ ? (tok_ - T_LAT) & 255 : tok_ & 4095; \
        _Pragma("unroll") for (int r = 0; r < 8; ++r) { const int ch = rr + 8 * r; \
            nx[r] = ldg8(ic_ ? YHTC + ((size_t)(b_ * 512 + cbk_ * 64 + ch) * NCTX + t_ + 8 * ck) : YHT + ((size_t)(b_ * 512 + cbk_ * 64 + ch) * SEQ + t_ + 8 * ck)); } } while (0)
    u32x4 nx[8];
    if (it0 < ntb * 8) YT_LOAD(it0);
    for (int it = it0; it < ntb * 8; it += step) {
        const int tb = it / 8, cbk = it % 8, tok0 = tb * 64;
#pragma unroll
        for (int r = 0; r < 8; ++r) tr64_write(tile, rr + 8 * r, ck, nx[r]);
        if (it + step < ntb * 8) YT_LOAD(it + step);
        LDS_WAIT();
#pragma unroll
        for (int r = 0; r < 8; ++r) { const int row = rr + 8 * r; *(u32x4*)(Y + (size_t)(tok0 + row) * YW + 1024 + cbk * 64 + 8 * ck) = tr64_read(tile, row, ck); }
        LDS_WAIT();
    }
#undef YT_LOAD
}

constexpr int RLD = 136;
constexpr int RREG = 128 * RLD * 2;
__device__ __forceinline__ void mma_nt128(f32x16& acc, const LAS bf16_t* A, int m0, const LAS bf16_t* Bt, int n0, int r32, int hi) {
    const LAS bf16_t* ap = A + (m0 + r32) * RLD + 8 * hi; const LAS bf16_t* bp = Bt + (n0 + r32) * RLD + 8 * hi;
#pragma unroll
    for (int k0 = 0; k0 < 128; k0 += 16) { const bf16x8 a = *(const LAS bf16x8*)(ap + k0); const bf16x8 b = *(const LAS bf16x8*)(bp + k0);
        acc = __builtin_amdgcn_mfma_f32_32x32x16_bf16(a, b, acc, 0, 0, 0); }
}
__device__ __forceinline__ void mma_nt128x2(f32x16& c0, f32x16& c1, const LAS bf16_t* A, int m0, const LAS bf16_t* Bt, int n0, int r32, int hi) {
    const LAS bf16_t* ap = A + (m0 + r32) * RLD + 8 * hi; const LAS bf16_t* bp = Bt + (n0 + r32) * RLD + 8 * hi;
#pragma unroll 2
    for (int k0 = 0; k0 < 128; k0 += 16) { const bf16x8 a = *(const LAS bf16x8*)(ap + k0); const bf16x8 b0 = *(const LAS bf16x8*)(bp + k0); const bf16x8 b1 = *(const LAS bf16x8*)(bp + 32 * RLD + k0);
        c0 = __builtin_amdgcn_mfma_f32_32x32x16_bf16(a, b0, c0, 0, 0, 0); c1 = __builtin_amdgcn_mfma_f32_32x32x16_bf16(a, b1, c1, 0, 0, 0); }
}
__device__ __forceinline__ int ret_tok0(int b, int n) { return n < 2 ? T_LAT + b * NCTX + n * 128 : b * SEQ + (n - 2) * 128; }
__device__ __forceinline__ void ph2_retkv(const Frame& F, int l) {
    bf16_t* ZG = wsp<bf16_t>(F, WS_ZG); float* KVS = wsp<float>(F, WS_KVS);
    const float* TBC = wsp<float>(F, WS_ROPE); const float* TBS = TBC + 2048;
    LAS bf16_t* VT = (LAS bf16_t*)(F.lds); LAS bf16_t* KF = (LAS bf16_t*)(F.lds + RREG); LAS bf16_t* KB = (LAS bf16_t*)(F.lds + 2 * RREG);
    const int tid = F.tid, lane = F.lane, r32 = lane & 31, hi = lane >> 5, w = F.wave;
    u32x4 raw[2][6];
#define RKV_LOAD(itx) do { const int b_ = (itx) / (4 * NCH), h_ = ((itx) / NCH) & 3, n_ = (itx) % NCH, tk_ = ret_tok0(b_, n_); \
        _Pragma("unroll") for (int r = 0; r < 2; ++r) { const int idx = tid + 512 * r, j = idx & 127, pp = idx >> 7, cc = (pp & 3) + 8 * (pp >> 2); \
            const bf16_t* zr = ZG + (size_t)(tk_ + j) * ZGW + OFF_R + h_ * 128 + 8 * cc; \
            raw[r][0] = ldg8(zr); raw[r][1] = ldg8(zr + 32); raw[r][2] = ldg8(zr + 512); raw[r][3] = ldg8(zr + 512 + 32); raw[r][4] = ldg8(zr + 1024); raw[r][5] = ldg8(zr + 1024 + 32); } } while (0)
    if (F.bid < NBATCH * 4 * NCH) RKV_LOAD(F.bid);
    for (int it = F.bid; it < NBATCH * 4 * NCH; it += F.G) {
        const int b = it / (4 * NCH), h = (it / NCH) & 3, n = it % NCH, tok0 = ret_tok0(b, n); const bool lat = n >= 2;
        const float lgf = -__expf(inptr(I_RDEC)[l * 8 + h]), lgb = -__expf(inptr(I_RDEC)[l * 8 + 4 + h]);
#pragma unroll 2
        for (int r = 0; r < 2; ++r) {
            const int idx = tid + 512 * r, j = idx & 127, pp = idx >> 7, cc = (pp & 3) + 8 * (pp >> 2);
            bf16_t* zr = ZG + (size_t)(tok0 + j) * ZGW + OFF_R + h * 128 + 8 * cc;
            float q1[8], q2[8], k1[8], k2[8]; unpack8(raw[r][0], q1); unpack8(raw[r][1], q2); unpack8(raw[r][2], k1); unpack8(raw[r][3], k2);
            const u32x4 v1raw = raw[r][4], v2raw = raw[r][5];
            const int axis = cc >> 3, kf0 = 8 * (cc & 3), p = lat ? (n - 2) * 128 + j : 0, v = axis ? (p & 63) : (p >> 6);
            float qo1[8], qo2[8], ko1[8], ko2[8];
#pragma unroll
            for (int e = 0; e < 8; ++e) { const float cs = lat ? TBC[v * 32 + kf0 + e] : 1.f, sn = lat ? TBS[v * 32 + kf0 + e] : 0.f;
                qo1[e] = q1[e] * cs - q2[e] * sn; qo2[e] = q2[e] * cs + q1[e] * sn;
                ko1[e] = (k1[e] * cs - k2[e] * sn) * 0.08838834764831845f; ko2[e] = (k2[e] * cs + k1[e] * sn) * 0.08838834764831845f; }
            if (lat) { *(u32x4*)zr = pack8(qo1); *(u32x4*)(zr + 32) = pack8(qo2); }
            const u32x4 kp1 = pack8(ko1), kp2 = pack8(ko2); *(u32x4*)(zr + 512) = kp1; *(u32x4*)(zr + 512 + 32) = kp2;
            float kr1[8], kr2[8]; unpack8(kp1, kr1); unpack8(kp2, kr2);
            const float df = __expf(lgf * (float)(127 - j)), db = __expf(lgb * (float)j);
            const bf16_t va[8] = {(bf16_t)(v1raw.x & 0xffff), (bf16_t)(v1raw.x >> 16), (bf16_t)(v1raw.y & 0xffff), (bf16_t)(v1raw.y >> 16), (bf16_t)(v1raw.z & 0xffff), (bf16_t)(v1raw.z >> 16), (bf16_t)(v1raw.w & 0xffff), (bf16_t)(v1raw.w >> 16)};
            const bf16_t vb[8] = {(bf16_t)(v2raw.x & 0xffff), (bf16_t)(v2raw.x >> 16), (bf16_t)(v2raw.y & 0xffff), (bf16_t)(v2raw.y >> 16), (bf16_t)(v2raw.z & 0xffff), (bf16_t)(v2raw.z >> 16), (bf16_t)(v2raw.w & 0xffff), (bf16_t)(v2raw.w >> 16)};
#pragma unroll
            for (int e = 0; e < 8; ++e) { const int d1 = 8 * cc + e, d2 = d1 + 32;
                VT[d1 * RLD + j] = va[e]; KF[d1 * RLD + j] = f2bf(kr1[e] * df); KB[d1 * RLD + j] = f2bf(kr1[e] * db);
                VT[d2 * RLD + j] = vb[e]; KF[d2 * RLD + j] = f2bf(kr2[e] * df); KB[d2 * RLD + j] = f2bf(kr2[e] * db); }
        }
        if (it + F.G < NBATCH * 4 * NCH) RKV_LOAD(it + F.G);
        __syncthreads();
        { const int dir = w >> 2, mt = w & 3; const LAS bf16_t* KX = dir ? KB : KF;
            f32x16 acc[4] = {};
#pragma unroll
            for (int nt = 0; nt < 4; ++nt) mma_nt128(acc[nt], VT, 32 * mt, KX, 32 * nt, r32, hi);
            float* dst = KVS + (((size_t)(b * 4 + h) * 2 + dir) * NCH + n) * 16384;
#pragma unroll
            for (int nt = 0; nt < 4; ++nt)
#pragma unroll
                for (int r = 0; r < 16; ++r) dst[(32 * mt + crow(r, hi)) * 128 + 32 * nt + r32] = acc[nt][r]; }
        __syncthreads();
    }
#undef RKV_LOAD
}
__device__ __forceinline__ void ret_scan_item(const Frame& F, int l, int item) {
    float* KVS = wsp<float>(F, WS_KVS);
    const int combo = item >> 3, part = item & 7, dir = combo & 1, h = (combo >> 1) & 3;
    const float lg = -__expf(inptr(I_RDEC)[l * 8 + dir * 4 + h]); const float cd = __expf(lg * 128.f);
    float* base = KVS + (size_t)combo * NCH * 16384 + part * 2048 + F.tid * 4;
    bf16_t* baseb = wsp<bf16_t>(F, WS_U) + (size_t)combo * NCH * 16384 + part * 2048 + F.tid * 4;
    float z0 = 0.f; asm volatile("" : "+v"(z0));
    f32x4 s = {z0, z0, z0, z0};
    f32x4 kv[34];
#pragma unroll
    for (int t = 0; t < 34; ++t) { const int n = dir ? (t < 2 ? 1 - t : 35 - t) : t; kv[t] = *(const f32x4*)(base + (size_t)n * 16384); }
#pragma unroll
    for (int t = 0; t < 34; ++t) { const int n = dir ? (t < 2 ? 1 - t : 35 - t) : t; { u32x2 o; o.x = pk2(s.x, s.y); o.y = pk2(s.z, s.w); *(u32x2*)(baseb + (size_t)n * 16384) = o; } s = s * cd + kv[t]; }
}
struct RetPre { u32x4 q[4], k[4], v[4]; };
__device__ __forceinline__ void ret_out_load(const Frame& F, int it, RetPre& p) {
    const bf16_t* ZG = wsp<bf16_t>(F, WS_ZG); const int tid = F.tid;
    const int b = it / (4 * NCH), h = (it / NCH) & 3, n = it % NCH, tok0 = ret_tok0(b, n);
#pragma unroll
    for (int r = 0; r < 4; ++r) { const int cidx = tid + 512 * r, j = cidx >> 4, cc = cidx & 15;
        const bf16_t* zr = ZG + (size_t)(tok0 + j) * ZGW + OFF_R + h * 128 + 8 * cc; p.q[r] = ldg8(zr); p.k[r] = ldg8(zr + 512);
        const int j2 = cidx & 127, c2 = cidx >> 7; p.v[r] = ldg8(ZG + (size_t)(tok0 + j2) * ZGW + OFF_R + 1024 + h * 128 + 8 * c2); }
}
__device__ __forceinline__ void ret_out_item(const Frame& F, int l, int it, RetPre& pre, int it_next) {
    const bf16_t* ZG = wsp<bf16_t>(F, WS_ZG); const bf16_t* KVB = wsp<bf16_t>(F, WS_U); bf16_t* Y = wsp<bf16_t>(F, WS_Y);
    LAS bf16_t* RQ = (LAS bf16_t*)(F.lds); LAS bf16_t* RK = (LAS bf16_t*)(F.lds + RREG); LAS bf16_t* RV = (LAS bf16_t*)(F.lds + 2 * RREG); LAS bf16_t* RP = (LAS bf16_t*)(F.lds + 3 * RREG);
    LAS float* OF = (LAS float*)(F.lds);
    int lane_i = F.lane; asm volatile("" : "+v"(lane_i));
    const int tid = F.tid, lane = lane_i, r32 = lane & 31, hi = lane >> 5, w = F.wave;
    const int b = it / (4 * NCH), h = (it / NCH) & 3, n = it % NCH, tok0 = ret_tok0(b, n);
    const float lgf = -__expf(inptr(I_RDEC)[l * 8 + h]), lgb = -__expf(inptr(I_RDEC)[l * 8 + 4 + h]);
#pragma unroll
    for (int r = 0; r < 4; ++r) {
        const int cidx = tid + 512 * r, j = cidx >> 4, cc = cidx & 15;
        *(LAS u32x4*)(RQ + j * RLD + 8 * cc) = pre.q[r]; *(LAS u32x4*)(RK + j * RLD + 8 * cc) = pre.k[r];
        const int j2 = cidx & 127, c2 = cidx >> 7;
        const u32x4 vraw = pre.v[r];
        const bf16_t vv[8] = {(bf16_t)(vraw.x & 0xffff), (bf16_t)(vraw.x >> 16), (bf16_t)(vraw.y & 0xffff), (bf16_t)(vraw.y >> 16), (bf16_t)(vraw.z & 0xffff), (bf16_t)(vraw.z >> 16), (bf16_t)(vraw.w & 0xffff), (bf16_t)(vraw.w >> 16)};
#pragma unroll
        for (int e = 0; e < 8; ++e) RV[(8 * c2 + e) * RLD + j2] = vv[e];
    }
    const bf16_t* SF = KVB + (((size_t)(b * 4 + h) * 2 + 0) * NCH + n) * 16384; const bf16_t* SB = KVB + (((size_t)(b * 4 + h) * 2 + 1) * NCH + n) * 16384;
    u32x4 sfr[4];
#pragma unroll
    for (int r = 0; r < 4; ++r) sfr[r] = ldg8(SF + (size_t)(tid + 512 * r) * 8);
    __syncthreads();
    const int mt = w >> 1, ntb = 2 * (w & 1);
    {   f32x16 s0 = {}, s1 = {};
        mma_nt128x2(s0, s1, RQ, 32 * mt, RK, 32 * ntb, r32, hi);
#pragma unroll
        for (int r = 0; r < 16; ++r) { const int i = 32 * mt + crow(r, hi);
#pragma unroll
            for (int t = 0; t < 2; ++t) { const int j = 32 * (ntb + t) + r32;
                const float d = (i > j) ? __expf(lgf * (float)(i - j)) : ((i < j) ? __expf(lgb * (float)(j - i)) : 2.f);
                RP[i * RLD + j] = f2bf((t ? s1[r] : s0[r]) * d); } }
    }
    __syncthreads();
#pragma unroll
    for (int r = 0; r < 4; ++r) { const int cidx = tid + 512 * r, row = cidx >> 4, cc = cidx & 15; *(LAS u32x4*)(RK + row * RLD + 8 * cc) = sfr[r]; }
#pragma unroll
    for (int r = 0; r < 4; ++r) sfr[r] = ldg8(SB + (size_t)(tid + 512 * r) * 8);
    __syncthreads();
    f32x16 ao0 = {}, ao1 = {};
    mma_nt128x2(ao0, ao1, RQ, 32 * mt, RK, 32 * ntb, r32, hi);
#pragma unroll
    for (int r = 0; r < 16; ++r) { const float sc = __expf(lgf * (float)(32 * mt + crow(r, hi) + 1)); ao0[r] *= sc; ao1[r] *= sc; }
    mma_nt128x2(ao0, ao1, RP, 32 * mt, RV, 32 * ntb, r32, hi);
    __syncthreads();
    {
        u32x4 gt[4];
#pragma unroll
        for (int r = 0; r < 4; ++r) { const int cidx = tid + 512 * r, j = cidx >> 4, cc = cidx & 15; gt[r] = ldg8(ZG + (size_t)(tok0 + j) * ZGW + OFF_R + 1536 + h * 128 + 8 * cc); }
#pragma unroll
        for (int r = 0; r < 4; ++r) { const int cidx = tid + 512 * r, row = cidx >> 4, cc = cidx & 15; *(LAS u32x4*)(RV + row * RLD + 8 * cc) = sfr[r]; }
#pragma unroll
        for (int r = 0; r < 4; ++r) { const int cidx = tid + 512 * r, j = cidx >> 4, cc = cidx & 15; *(LAS u32x4*)(RP + j * RLD + 8 * cc) = gt[r]; }
    }
    __syncthreads();
    f32x16 ab0 = {}, ab1 = {};
    mma_nt128x2(ab0, ab1, RQ, 32 * mt, RV, 32 * ntb, r32, hi);
    __syncthreads();
#pragma unroll
    for (int r = 0; r < 16; ++r) { const int i = 32 * mt + crow(r, hi); const float sc = __expf(lgb * (float)(128 - i));
        OF[i * 132 + 32 * ntb + r32] = ao0[r] + sc * ab0[r]; OF[i * 132 + 32 * (ntb + 1) + r32] = ao1[r] + sc * ab1[r]; }
    if (it_next >= 0) ret_out_load(F, it_next, pre);
    __syncthreads();
#pragma unroll 4
    for (int rr = 0; rr < 16; ++rr) { const int i = 16 * w + rr; const float v0 = OF[i * 132 + lane], v1 = OF[i * 132 + 64 + lane];
        const float mean = wave_sum(v0 + v1, lane) * (1.f / 128.f); const float d0 = v0 - mean, d1 = v1 - mean; const float rstd = rsqrtf(wave_sum(d0 * d0 + d1 * d1, lane) * (1.f / 128.f) + 1e-6f);
        const size_t tok = (size_t)(tok0 + i);
        const float g0 = bf1(RP[i * RLD + lane]), g1 = bf1(RP[i * RLD + 64 + lane]);
        bf16_t* yp = Y + tok * YW + 512 + h * 128; yp[lane] = f2bf(siluf_(g0) * d0 * rstd); yp[64 + lane] = f2bf(siluf_(g1) * d1 * rstd); }
    __syncthreads();
}

constexpr int HY_GCS = 16960;
constexpr int HY_URS = 13376;
constexpr int HY_PAD = 1024;
constexpr int HY_NSH = 160;
constexpr int HY_GC_OFF = 0, HY_UR_OFF = 4 * HY_GCS, HY_GT_OFF = HY_UR_OFF + 4 * HY_URS, HY_END = HY_GT_OFF + 4 * 8192;
static_assert(HY_END <= LDS_REGION, "hyena LDS");
__device__ __forceinline__ int hy_uphys(int idx) { const int L = 2 * idx; return L + ((L >> 8) << 4); }
__device__ __forceinline__ void dwconv8(const bf16_t* row, int n0, int len, float w0, float w1, float w2, float bias, float* out) {
    float z[10]; unpack8(ldg8(row + n0), z + 1);
    z[0] = n0 > 0 ? bf1(row[n0 - 1]) : 0.f; z[9] = (n0 + 8 < len) ? bf1(row[n0 + 8]) : 0.f;
#pragma unroll
    for (int e = 0; e < 8; ++e) out[e] = w0 * z[e] + w1 * z[e + 1] + w2 * z[e + 2] + bias;
}
struct HyRaw { u32x4 v[4]; bf16_t lo[4], hi[4]; };
__device__ __forceinline__ void hy_raw_load(HyRaw& R, const bf16_t* ZHT, int col, int tid) {
#pragma unroll
    for (int r = 0; r < 4; ++r) { const int gidx = tid + 512 * r, b = gidx >> 9, n0 = (gidx & 511) * 8; const bf16_t* row = ZHT + (size_t)(b * 1536 + col) * SEQ;
        R.v[r] = ldg8(row + n0); R.lo[r] = n0 > 0 ? row[n0 - 1] : (bf16_t)0; R.hi[r] = (n0 + 8 < SEQ) ? row[n0 + 8] : (bf16_t)0; }
}
__device__ __forceinline__ void hy_dw(const HyRaw& R, int r, float w0, float w1, float w2, float bias, float* out) {
    float z[10]; unpack8(R.v[r], z + 1); z[0] = bf1(R.lo[r]); z[9] = bf1(R.hi[r]);
#pragma unroll
    for (int e = 0; e < 8; ++e) out[e] = w0 * z[e] + w1 * z[e + 1] + w2 * z[e + 2] + bias;
}
__device__ __forceinline__ void hyena_item(const Frame& F, int l, int c, bool need_ctx) {
    const bf16_t* ZHT = wsp<bf16_t>(F, WS_ZHT); const bf16_t* ZHTC = wsp<bf16_t>(F, WS_ZHTC); bf16_t* YHT = wsp<bf16_t>(F, WS_YHT); bf16_t* YHTC = wsp<bf16_t>(F, WS_YHTC);
    const bf16_t* GF = wsp<bf16_t>(F, WS_GF); const float* GC = wsp<float>(F, WS_GC);
    const float* hcw = inptr(I_HCW) + (size_t)l * 3 * 1536; const float* hcb = inptr(I_HCB) + (size_t)l * 1536; const float* hsk = inptr(I_HSKIP) + (size_t)l * 2 * 512;
    LAS unsigned char* lds = F.lds; const int tid = F.tid, lane = F.lane, nt = F.wave & 3, kh = F.wave >> 2;
    LAS bf16_t* GT = (LAS bf16_t*)(lds + HY_GT_OFF);
    HyRaw rv, rg; u32x4 gr[2]; u32x2 gx[2];
    hy_raw_load(rv, ZHT, c, tid); hy_raw_load(rg, ZHT, 512 + c, tid);
#define HY_GLOAD(ord, tt) do { const bf16_t* grow = GF + (((size_t)l * 2 + (ord)) * 512 + c) * 8192; gr[0] = ldg8(grow + (tt) * 8); gr[1] = ldg8(grow + ((tt) + 512) * 8); \
        gx[0] = *(const u32x2*)(grow + (tt) * 8 + 8); gx[1] = ((tt) < 511) ? *(const u32x2*)(grow + ((tt) + 512) * 8 + 8) : (u32x2){0u, 0u}; } while (0)
    HY_GLOAD(0, tid);
    __builtin_amdgcn_sched_barrier(0);
    { unsigned z0 = 0u; asm volatile("" : "+v"(z0)); const u32x4 zz = {z0, z0, z0, z0};
      for (int i = tid; i < 4 * HY_URS / 16; i += NTHREADS) *(LAS u32x4*)(lds + HY_UR_OFF + 16 * i) = zz; }
    __syncthreads();
    { const float w0 = hcw[c], w1 = hcw[1536 + c], w2 = hcw[3072 + c], bb = hcb[c];
#pragma unroll
      for (int r = 0; r < 4; ++r) { const int gidx = tid + 512 * r, b = gidx >> 9, n0 = (gidx & 511) * 8; float y[8]; hy_dw(rv, r, w0, w1, w2, bb, y);
          LAS unsigned char* ub = lds + HY_UR_OFF + b * HY_URS;
#pragma unroll
          for (int e = 0; e < 8; ++e) *(LAS bf16_t*)(ub + hy_uphys(4096 - (n0 + e) + HY_PAD)) = f2bf(y[e]);
          __builtin_amdgcn_sched_barrier(0); } }
#pragma unroll 1
    for (int o = 0; o < 2; ++o) {
        int tid_o = tid; asm volatile("" : "+v"(tid_o));
        {
#pragma unroll
          for (int r = 0; r < 2; ++r) { const int i0 = (tid_o + 512 * r) * 8; const u32x4 w = gr[r]; const u32x2 x = gx[r];
              LAS unsigned char* cb = lds + HY_GC_OFF + i0 * 2;
              *(LAS u32x4*)(cb) = w;
              { u32x4 v; v.x = __builtin_amdgcn_alignbit(w.y, w.x, 16); v.y = __builtin_amdgcn_alignbit(w.z, w.y, 16); v.z = __builtin_amdgcn_alignbit(w.w, w.z, 16); v.w = __builtin_amdgcn_alignbit(x.x, w.w, 16); *(LAS u32x4*)(cb + HY_GCS) = v; }
              { u32x4 v; v.x = w.y; v.y = w.z; v.z = w.w; v.w = x.x; *(LAS u32x4*)(cb + 2 * HY_GCS) = v; }
              { u32x4 v; v.x = __builtin_amdgcn_alignbit(w.z, w.y, 16); v.y = __builtin_amdgcn_alignbit(w.w, w.z, 16); v.z = __builtin_amdgcn_alignbit(x.x, w.w, 16); v.w = __builtin_amdgcn_alignbit(x.y, x.x, 16); *(LAS u32x4*)(cb + 3 * HY_GCS) = v; } }
          for (int i = tid_o; i < 4 * 292; i += NTHREADS) { const int s = i / 292, k = i % 292; const int x = 8192 - s + k; if (x < 8480) ((LAS bf16_t*)(lds + HY_GC_OFF + s * HY_GCS))[x] = 0; }
          const int col = 512 * (o + 1) + c; const float w0 = hcw[col], w1 = hcw[1536 + col], w2 = hcw[3072 + col], bb = hcb[col];
#pragma unroll
          for (int r = 0; r < 4; ++r) { const int gidx = tid_o + 512 * r, b = gidx >> 9, n0 = (gidx & 511) * 8; float y[8]; hy_dw(rg, r, w0, w1, w2, bb, y);
              *(LAS u32x4*)(GT + b * 4096 + n0) = pack8(y); __builtin_amdgcn_sched_barrier(0); } }
        if (o == 0) { hy_raw_load(rg, ZHT, 1024 + c, tid_o); HY_GLOAD(1, tid_o); }
        __builtin_amdgcn_sched_barrier(0);
        __syncthreads();
        int lane_o = lane; asm volatile("" : "+v"(lane_o)); const int r32 = lane_o & 31, hi = lane_o >> 5;
        const int il = r32 >> 2, bb_ = r32 & 3;
        const LAS unsigned char* ap = lds + HY_GC_OFF + (r32 & 3) * HY_GCS + ((r32 & ~3) + 1024 * nt + 8 * hi + 16 * HY_NSH * kh) * 2;
        const LAS unsigned char* bbase = lds + HY_UR_OFF + bb_ * HY_URS; const int bL0 = 2 * (HY_PAD - 128 * il + 8 * hi + 16 * HY_NSH * kh);
#define HY_LDA(s) ({ const s16x4 _lo = *(const LAS s16x4*)(ap + 32 * (s)), _hi = *(const LAS s16x4*)(ap + 32 * (s) + 8); (bf16x8){_lo[0], _lo[1], _lo[2], _lo[3], _hi[0], _hi[1], _hi[2], _hi[3]}; })
#define HY_LDB(s) ({ const int _L = bL0 + 32 * (s); *(const LAS bf16x8*)(bbase + _L + ((_L >> 8) << 4)); })
#define HY_STEP(x0, x1, x2, x3, bcur, gnew, bnext, sn) do { __builtin_amdgcn_sched_barrier(0); acc0 = __builtin_amdgcn_mfma_f32_32x32x16_bf16(x0, bcur, acc0, 0, 0, 0); __builtin_amdgcn_sched_barrier(0); \
        gnew = HY_LDA((sn) + 7); bnext = HY_LDB((sn) + 1); __builtin_amdgcn_sched_barrier(0); \
        acc1 = __builtin_amdgcn_mfma_f32_32x32x16_bf16(x1, bcur, acc1, 0, 0, 0); acc2 = __builtin_amdgcn_mfma_f32_32x32x16_bf16(x2, bcur, acc2, 0, 0, 0); acc3 = __builtin_amdgcn_mfma_f32_32x32x16_bf16(x3, bcur, acc3, 0, 0, 0); \
        __builtin_amdgcn_sched_barrier(0); } while (0)
        f32x16 acc0 = {}, acc1 = {}, acc2 = {}, acc3 = {};
        bf16x8 g0 = HY_LDA(0), g1 = HY_LDA(1), g2 = HY_LDA(2), g3 = HY_LDA(3), g4 = HY_LDA(4), g5 = HY_LDA(5), g6 = HY_LDA(6), g7, b0 = HY_LDB(0), b1;
#pragma unroll 1
        for (int s = 0; s < HY_NSH; s += 8) {
            HY_STEP(g0, g2, g4, g6, b0, g7, b1, s);
            HY_STEP(g1, g3, g5, g7, b1, g0, b0, s + 1);
            HY_STEP(g2, g4, g6, g0, b0, g1, b1, s + 2);
            HY_STEP(g3, g5, g7, g1, b1, g2, b0, s + 3);
            HY_STEP(g4, g6, g0, g2, b0, g3, b1, s + 4);
            HY_STEP(g5, g7, g1, g3, b1, g4, b0, s + 5);
            HY_STEP(g6, g0, g2, g4, b0, g5, b1, s + 6);
            HY_STEP(g7, g1, g3, g5, b1, g6, b0, s + 7);
        }
#undef HY_LDA
#undef HY_LDB
#undef HY_STEP
        __syncthreads();
        LAS float* XCH = (LAS float*)(lds + HY_GC_OFF);
        { const f32x16 s0 = kh ? acc0 : acc2, s1 = kh ? acc1 : acc3; LAS float* xp = XCH + (size_t)(F.wave * 2) * 16 * 64 + lane_o;
#pragma unroll
          for (int r = 0; r < 16; ++r) { xp[r * 64] = s0[r]; xp[(16 + r) * 64] = s1[r]; } }
        __syncthreads();
        f32x16 o0 = kh ? acc2 : acc0, o1 = kh ? acc3 : acc1;
        { const LAS float* xp = XCH + (size_t)((F.wave ^ 4) * 2) * 16 * 64 + lane_o;
#pragma unroll
          for (int r = 0; r < 16; ++r) { o0[r] += xp[r * 64]; o1[r] += xp[(16 + r) * 64]; } }
        { const float sk = hsk[o * 512 + c]; const int nb0 = 128 * (8 * nt + il) + 64 * kh;
          LAS unsigned char* ub = lds + HY_UR_OFF + bb_ * HY_URS;
#pragma unroll
          for (int t = 0; t < 2; ++t)
#pragma unroll
              for (int g = 0; g < 4; ++g) { float yv[4];
#pragma unroll
                  for (int q = 0; q < 4; ++q) { const int n = nb0 + 32 * t + 8 * g + 4 * hi + q; const float cv = t ? o1[4 * g + q] : o0[4 * g + q];
                      const float ycur = bf1(*(const LAS bf16_t*)(ub + hy_uphys(4096 - n + HY_PAD))); const float gt = bf1(GT[bb_ * 4096 + n]); yv[q] = gt * (cv + sk * ycur); }
                  const int n4 = nb0 + 32 * t + 8 * g + 4 * hi;
                  if (o == 0) {
#pragma unroll
                      for (int q = 0; q < 4; ++q) *(LAS bf16_t*)(ub + hy_uphys(4096 - (n4 + q) + HY_PAD)) = f2bf(yv[q]); }
                  else { u32x2 pk; pk.x = pk2(yv[0], yv[1]); pk.y = pk2(yv[2], yv[3]); *(u32x2*)(YHT + (size_t)(bb_ * 512 + c) * SEQ + n4) = pk; } } }
        __syncthreads();
    }
    if (need_ctx) {
        LAS float* uc4 = (LAS float*)(lds);
        LAS float* gc = uc4 + 1024;
        LAS float* gt4 = gc + 512;
        LAS float* red4 = gt4 + 1024;
        { const float w0 = hcw[c], w1 = hcw[1536 + c], w2 = hcw[3072 + c], bb = hcb[c];
          if (tid < 128) { const int b = tid >> 5, n0 = (tid & 31) * 8; float y[8]; dwconv8(ZHTC + (size_t)(b * 1536 + c) * NCTX, n0, NCTX, w0, w1, w2, bb, y);
#pragma unroll
              for (int e = 0; e < 8; ++e) uc4[(n0 + e) * 4 + b] = y[e]; } }
#pragma unroll 1
        for (int o = 0; o < 2; ++o) {
            gc[tid] = GC[(((size_t)l * 2 + o) * 512 + c) * 512 + tid];
            { const int col = 512 * (o + 1) + c; const float w0 = hcw[col], w1 = hcw[1536 + col], w2 = hcw[3072 + col], bb = hcb[col];
              if (tid < 128) { const int b = tid >> 5, n0 = (tid & 31) * 8; float y[8]; dwconv8(ZHTC + (size_t)(b * 1536 + col) * NCTX, n0, NCTX, w0, w1, w2, bb, y);
#pragma unroll
                  for (int e = 0; e < 8; ++e) gt4[(n0 + e) * 4 + b] = y[e]; } }
            __syncthreads();
            const float sk = hsk[o * 512 + c]; const int n = tid & 255, mh = tid >> 8;
            { f32x4 acc = {0.f, 0.f, 0.f, 0.f};
#pragma unroll 8
              for (int m = 128 * mh; m < 128 * mh + 128; ++m) acc += *(const LAS f32x4*)(uc4 + 4 * m) * gc[256 + n - m];
              *(LAS f32x4*)(red4 + 4 * tid) = acc; }
            __syncthreads();
            f32x4 res = {0.f, 0.f, 0.f, 0.f};
            if (tid < 256) { const f32x4 s4 = *(const LAS f32x4*)(red4 + 4 * tid) + *(const LAS f32x4*)(red4 + 4 * (tid + 256)); const f32x4 u4 = *(const LAS f32x4*)(uc4 + 4 * n);
                res = *(const LAS f32x4*)(gt4 + 4 * n) * (s4 + u4 * sk); }
            __syncthreads();
            if (tid < 256) { *(LAS f32x4*)(uc4 + 4 * n) = res;
                if (o == 1) {
#pragma unroll
                    for (int b = 0; b < 4; ++b) YHTC[(size_t)(b * 512 + c) * NCTX + n] = f2bf(res[b]); } }
            __syncthreads();
        }
    }
}

__device__ __forceinline__ void ph4b_sum(const Frame& F, int nrows) {
    const bf16_t* ZG = wsp<bf16_t>(F, WS_ZG); bf16_t* MS = wsp<bf16_t>(F, WS_ZHT);
    u32x4 nx[2][4];
    if (F.gw < nrows) { const bf16_t* gp = ZG + (size_t)F.gw * ZGW + OFF_G;
#pragma unroll
        for (int j = 0; j < 2; ++j)
#pragma unroll
            for (int i = 0; i < 4; ++i) nx[j][i] = ldg8(gp + i * 1024 + 8 * F.lane + 512 * j); }
    for (int row = F.gw; row < nrows; row += F.NGW) {
        u32x4 cur[2][4];
#pragma unroll
        for (int j = 0; j < 2; ++j)
#pragma unroll
            for (int i = 0; i < 4; ++i) cur[j][i] = nx[j][i];
        if (row + F.NGW < nrows) { const bf16_t* gp = ZG + (size_t)(row + F.NGW) * ZGW + OFF_G;
#pragma unroll
            for (int j = 0; j < 2; ++j)
#pragma unroll
                for (int i = 0; i < 4; ++i) nx[j][i] = ldg8(gp + i * 1024 + 8 * F.lane + 512 * j); }
#pragma unroll
        for (int j = 0; j < 2; ++j) { const int col = 8 * F.lane + 512 * j; float a[8], t[8];
            unpack8(cur[j][0], a);
#pragma unroll
            for (int i = 1; i < 4; ++i) { unpack8(cur[j][i], t);
#pragma unroll
                for (int e = 0; e < 8; ++e) a[e] += t[e]; }
            *(u32x4*)(MS + (size_t)row * DM + col) = pack8(a); }
    }
}
__device__ __forceinline__ void ph6_ln1(const Frame& F, int l, int nrows, bool dry = false) {
    bf16_t* XF = wsp<bf16_t>(F, WS_XF); unsigned char* U8 = wsp<unsigned char>(F, WS_U); bf16_t* XFo = dry ? wsp<bf16_t>(F, WS_ZG) : XF; if (dry) U8 = wsp<unsigned char>(F, WS_ZG + (size_t)T_ALL * DM * 4); const float* MODl = wsp<float>(F, WS_MOD) + (size_t)l * 5 * 6144;
    const float* g = inptr(I_LNG) + (size_t)(l * 2 + 0) * DM; const float* bta = inptr(I_LNB) + (size_t)(l * 2 + 0) * DM;
    const bool moe = ((l & 1) != 0) && !dry; const int rpb = nrows / F.G, lane = F.lane; const bf16_t* MIX = wsp<bf16_t>(F, WS_Y);
    LAS float* RT = (LAS float*)(F.lds);
    LAS int* cnt = (LAS int*)(F.lds + 32768);
    LAS unsigned* rec = (LAS unsigned*)(F.lds + 32768 + 64);
    if (moe) { const float* rw = inptr(I_ROUTER) + (size_t)(l >> 1) * DM * NEXP;
        for (int i = F.tid; i < DM * NEXP; i += NTHREADS) RT[i] = rw[i];
        if (F.tid < 16) cnt[F.tid] = 0;
        __syncthreads(); }
    u32x2 nx[4]; u32x2 ny[4];
    { const int row = F.bid * rpb + F.wave;
#pragma unroll
      for (int j = 0; j < 4; ++j) { nx[j] = *(const u32x2*)(XF + (size_t)row * DM + 4 * lane + 256 * j); ny[j] = *(const u32x2*)(MIX + (size_t)row * DM + 4 * lane + 256 * j); } }
    for (int k = F.wave; k < rpb; k += NWAVES) {
        const int row = F.bid * rpb + k; bf16_t* xo = XFo + (size_t)row * DM;
        const float* m = MODl + (size_t)row_bsel(row) * 6144;
        f32x4 v[4]; u32x2 yy[4];
#pragma unroll
        for (int j = 0; j < 4; ++j) { v[j] = bf4_f32(nx[j]); yy[j] = ny[j]; }
        if (k + NWAVES < rpb) { const int rown = row + NWAVES;
#pragma unroll
            for (int j = 0; j < 4; ++j) { nx[j] = *(const u32x2*)(XF + (size_t)rown * DM + 4 * lane + 256 * j); ny[j] = *(const u32x2*)(MIX + (size_t)rown * DM + 4 * lane + 256 * j); } }
#pragma unroll
        for (int j = 0; j < 4; ++j) { const u32x2 y = yy[j]; const f32x4 mm = *(const f32x4*)(m + 2 * 1024 + 4 * lane + 256 * j);
            f32x4 f; f.x = bflo(y.x); f.y = bfhi(y.x); f.z = bflo(y.y); f.w = bfhi(y.y);
            v[j] = v[j] * ALPHA + mm * f; }
        ln_row(v, g, bta, lane);
#pragma unroll
        for (int j = 0; j < 4; ++j) *(u32x2*)(xo + 4 * lane + 256 * j) = f32_bf4(v[j]);
        store_mod_row8(v, m + 3 * 1024, m + 4 * 1024, U8 + (size_t)row * DM, lane);
        if (moe) {
            float lg[8] = {0.f, 0.f, 0.f, 0.f, 0.f, 0.f, 0.f, 0.f};
#pragma unroll
            for (int j = 0; j < 4; ++j) { const f32x4 a = *(const f32x4*)(m + 3 * 1024 + 4 * lane + 256 * j), s = *(const f32x4*)(m + 4 * 1024 + 4 * lane + 256 * j); const f32x4 u = v[j] * (s + 1.0f) + a;
#pragma unroll
                for (int c = 0; c < 4; ++c) { const LAS float* rp = RT + (size_t)(4 * lane + 256 * j + c) * 8; const f32x4 r0 = *(const LAS f32x4*)rp, r1 = *(const LAS f32x4*)(rp + 4); const float uu = u[c];
                    lg[0] += uu * r0.x; lg[1] += uu * r0.y; lg[2] += uu * r0.z; lg[3] += uu * r0.w; lg[4] += uu * r1.x; lg[5] += uu * r1.y; lg[6] += uu * r1.z; lg[7] += uu * r1.w; } }
#pragma unroll
            for (int e = 0; e < 8; ++e) lg[e] = wave_sum(lg[e], lane);
            float v0 = lg[0]; int i0 = 0;
#pragma unroll
            for (int e = 1; e < 8; ++e) if (lg[e] > v0) { v0 = lg[e]; i0 = e; }
            float v1 = -3.0e38f; int i1 = 0;
#pragma unroll
            for (int e = 0; e < 8; ++e) if (e != i0 && lg[e] > v1) { v1 = lg[e]; i1 = e; }
            const float w0 = __builtin_amdgcn_rcpf(1.f + __expf(v1 - v0)), w1 = 1.f - w0;
            if (lane == 0) { const int r0 = __hip_atomic_fetch_add(&cnt[i0], 1, __ATOMIC_RELAXED, __HIP_MEMORY_SCOPE_WORKGROUP), r1 = __hip_atomic_fetch_add(&cnt[i1], 1, __ATOMIC_RELAXED, __HIP_MEMORY_SCOPE_WORKGROUP);
                LAS unsigned* rc = rec + k * 8; rc[0] = (unsigned)i0; rc[1] = (unsigned)r0; rc[2] = (unsigned)i1; rc[3] = (unsigned)r1; rc[4] = __float_as_uint(w0); rc[5] = __float_as_uint(w1); }
        }
    }
    if (moe) {
        __syncthreads();
        if (F.tid < 8) cnt[8 + F.tid] = (int)__hip_atomic_fetch_add(F.ctl + CW_MOE + (l * 8 + F.tid) * 64, (unsigned)cnt[F.tid], __ATOMIC_RELAXED, __HIP_MEMORY_SCOPE_AGENT);
        __syncthreads();
        unsigned* PAIR = wsp<unsigned>(F, WS_PAIR);
        for (int k = F.tid; k < rpb; k += NTHREADS) { const int row = F.bid * rpb + k; const LAS unsigned* rc = rec + k * 8;
            u32x4 a; a.x = rc[0]; a.y = rc[1] + (unsigned)cnt[8 + rc[0]]; a.z = rc[2]; a.w = rc[3] + (unsigned)cnt[8 + rc[2]];
            *(u32x4*)(PAIR + (size_t)row * 8) = a; PAIR[(size_t)row * 8 + 4] = rc[4]; PAIR[(size_t)row * 8 + 5] = rc[5]; }
        __syncthreads();
    }
}
__device__ __forceinline__ void moe_tiles(const Frame& F, int l, bool moe, int nMr, int* ts  , int& ntiles) {
    int acc = 0;
#pragma unroll
    for (int e = 0; e < NEXP; ++e) { ts[e] = moe ? acc : (e ? 0x3fffffff : 0);
        const unsigned c = moe ? __hip_atomic_load(F.ctl + CW_MOE + (l * 8 + e) * 64, __ATOMIC_RELAXED, __HIP_MEMORY_SCOPE_AGENT) : 0u; acc += __builtin_amdgcn_readfirstlane((int)((c + 255u) >> 8)); }
    ntiles = moe ? acc : nMr;
}
__device__ __forceinline__ void ph7_gather(const Frame& F, int l, int nrows) {
    int ts[NEXP], ntiles; moe_tiles(F, l, true, 0, ts, ntiles);
    unsigned* PAIR = wsp<unsigned>(F, WS_PAIR); const unsigned char* U8 = wsp<unsigned char>(F, WS_U); unsigned char* XG = wsp<unsigned char>(F, WS_XG);
    u32x4 na = {0u, 0u, 0u, 0u}, nxr = {0u, 0u, 0u, 0u};
    if (F.gw < nrows) { na = *(const u32x4*)(PAIR + (size_t)F.gw * 8); nxr = ((const u32x4*)(U8 + (size_t)F.gw * DM))[F.lane]; }
    for (int tok = F.gw; tok < nrows; tok += F.NGW) {
        const u32x4 a = na, x0 = nxr;
        if (tok + F.NGW < nrows) { na = *(const u32x4*)(PAIR + (size_t)(tok + F.NGW) * 8); nxr = ((const u32x4*)(U8 + (size_t)(tok + F.NGW) * DM))[F.lane]; }
        int b0 = 0, b1 = 0;
#pragma unroll
        for (int e = 0; e < NEXP; ++e) { b0 = ((int)a.x == e) ? ts[e] : b0; b1 = ((int)a.z == e) ? ts[e] : b1; }
        const unsigned s0 = (unsigned)b0 * 256u + a.y, s1 = (unsigned)b1 * 256u + a.w;
        if (F.lane == 0) { PAIR[(size_t)tok * 8 + 6] = s0; PAIR[(size_t)tok * 8 + 7] = s1; }
        ((u32x4*)(XG + (size_t)s0 * DM))[F.lane] = x0; ((u32x4*)(XG + (size_t)s1 * DM))[F.lane] = x0;
    }
}
__device__ __forceinline__ void ph10_ln2(const Frame& F, int l, int nrows, bool dry = false) {
    bf16_t* XF = wsp<bf16_t>(F, WS_XF); bf16_t* U = dry ? wsp<bf16_t>(F, WS_ZG + (size_t)T_ALL * DM * 4) : wsp<bf16_t>(F, WS_U); bf16_t* XFo = dry ? wsp<bf16_t>(F, WS_ZG) : XF; float* OUTo = dry ? wsp<float>(F, WS_ZG) : F.out; const float* MOD = wsp<float>(F, WS_MOD);
    const float* g = inptr(I_LNG) + (size_t)(l * 2 + 1) * DM; const float* bta = inptr(I_LNB) + (size_t)(l * 2 + 1) * DM;
    const bool moe = (l & 1) != 0; const int lane = F.lane;
    const unsigned* PAIR = wsp<unsigned>(F, WS_PAIR); const bf16_t* YO = wsp<bf16_t>(F, WS_YO);
    for (int row0 = F.gw; row0 < nrows; row0 += 2 * F.NGW) {
        int rows[2]; rows[0] = row0; rows[1] = (row0 + F.NGW < nrows) ? row0 + F.NGW : row0;
        f32x4 v[2][4]; u32x2 ya[2][4], yb[2][4]; float w0[2], w1[2];
#pragma unroll
        for (int h = 0; h < 2; ++h) { const int row = rows[h]; const bf16_t* xr = XF + (size_t)row * DM;
            unsigned s0 = (unsigned)row, s1 = (unsigned)row; w0[h] = 1.f; w1[h] = 0.f;
            if (moe) { const unsigned* pr = PAIR + (size_t)row * 8; w0[h] = __uint_as_float(pr[4]); w1[h] = __uint_as_float(pr[5]); s0 = pr[6]; s1 = pr[7]; }
#pragma unroll
            for (int j = 0; j < 4; ++j) { v[h][j] = bf4_f32(*(const u32x2*)(xr + 4 * lane + 256 * j));
                ya[h][j] = *(const u32x2*)(YO + (size_t)s0 * DM + 4 * lane + 256 * j); yb[h][j] = *(const u32x2*)(YO + (size_t)s1 * DM + 4 * lane + 256 * j); } }
#pragma unroll
        for (int h = 0; h < 2; ++h) { const int row = rows[h];
            const float* m5 = MOD + ((size_t)l * 5 + row_bsel(row)) * 6144 + 5 * 1024;
#pragma unroll
            for (int j = 0; j < 4; ++j) { const u32x2 y0 = ya[h][j], y1 = yb[h][j]; const f32x4 mm = *(const f32x4*)(m5 + 4 * lane + 256 * j);
                f32x4 f; f.x = w0[h] * bflo(y0.x) + w1[h] * bflo(y1.x); f.y = w0[h] * bfhi(y0.x) + w1[h] * bfhi(y1.x); f.z = w0[h] * bflo(y0.y) + w1[h] * bflo(y1.y); f.w = w0[h] * bfhi(y0.y) + w1[h] * bfhi(y1.y);
                v[h][j] = v[h][j] * ALPHA + mm * f; }
            ln_row(v[h], g, bta, lane); }
#pragma unroll
        for (int h = 0; h < 2; ++h) { const int row = rows[h];
            if (l == DEPTH - 1) {
#pragma unroll
                for (int j = 0; j < 4; ++j) *(f32x4*)(OUTo + (size_t)row * DM + 4 * lane + 256 * j) = v[h][j];
            } else {
#pragma unroll
                for (int j = 0; j < 4; ++j) *(u32x2*)(XFo + (size_t)row * DM + 4 * lane + 256 * j) = f32_bf4(v[h][j]);
                const float* m = MOD + ((size_t)(l + 1) * 5 + row_bsel(row)) * 6144;
                store_mod_row(v[h], m, m + 1024, U + (size_t)row * DM, lane);
                if (!dry) store_mod_row8(v[h], m, m + 1024, wsp<unsigned char>(F, WS_U8M) + (size_t)row * DM, lane);
            } }
    }
}

constexpr int NPHL = 12;
constexpr int NPH = 2 + NPHL * DEPTH;
__device__ __forceinline__ bool in_range(int k, int lo, int hi) { asm volatile("" : "+s"(k)); return lo <= k && k < hi; }
__global__ void __launch_bounds__(NTHREADS, 2) mk_fwd(Args args) {
    extern __shared__ __attribute__((aligned(16))) unsigned char lds_raw[];
    Frame F;
    F.lds = (LAS unsigned char*)lds_raw + LDS_CTL; F.ldsg = lds_raw + LDS_CTL; F.lds0 = (unsigned)(uintptr_t)(LAS unsigned char*)lds_raw;
    F.out = args.out; F.ws = args.ws; F.ws0 = args.ws; F.ctl = (unsigned*)(args.ws + WS_CTL);
    F.tid = threadIdx.x; F.lane = F.tid & 63; F.wave = __builtin_amdgcn_readfirstlane(F.tid >> 6); F.wave0 = F.wave; F.G = gridDim.x; F.bid = blockIdx.x; F.gw = blockIdx.x * NWAVES + F.wave; F.NGW = F.G * NWAVES;
    volatile LAS unsigned* lctl = (volatile LAS unsigned*)((LAS unsigned char*)lds_raw);
    if (F.tid < 16) lctl[F.tid] = 0u;
    __syncthreads();
    const int lo = args.ph_lo, hi = args.ph_hi; const bool one = (hi - lo) > 1;
    XcdBarrier bar = xcd_barrier_post(F.ctl + CW_BAR, lctl);
#ifndef MK_REP
#define MK_REP 0
#endif
#ifndef MK_ONLY
#define MK_ONLY -1
#endif
#define EN(j) (MK_ONLY < 0 || MK_ONLY == (j))
#ifndef MK_SUB
#define MK_SUB -1
#endif
#define EN2(j) (MK_SUB < 0 || MK_SUB == (j))
#define IN(k) in_range((k), lo, hi)
#define SEAM(k) do { if (IN(k) && IN((k) + 1)) { xcd_barrier(bar); if (MK_REP == 12) xcd_barrier(bar); } } while (0)
#define QNEXT(headw, dst) do { if (F.tid == 0) lctl[4] = __hip_atomic_fetch_add((headw), 1u, __ATOMIC_RELAXED, __HIP_MEMORY_SCOPE_AGENT); __syncthreads(); dst = __builtin_amdgcn_readfirstlane((int)lctl[4]); __syncthreads(); } while (0)

    if (IN(0) && EN(0)) { frame_tid(F); cvt_range(F, 0, 0, CVT_NMIX + CVT_NF_D, 0); __syncthreads(); p0_mod(F); p0_filters(F); if (MK_REP == 8) { __syncthreads(); p0_mod(F); } if (MK_REP == 14) { __syncthreads(); p0_filters(F); } }
    SEAM(0);
    if (IN(1) && EN(1)) { frame_tid(F); p0b_rows(F); if (MK_REP == 15) p0b_rows(F); }
    SEAM(1);

#pragma unroll 1
    for (int l = 0; l < DEPTH; ++l) {
        const int pb = 2 + NPHL * l; const bool need_ctx = l < DEPTH - 1; const int nrows = need_ctx ? T_ALL : T_LAT, nMr = nrows / 256; const bool moe = (l & 1) != 0;
        if (IN(pb + 0) && EN(2)) { frame_tid(F); pg8::Gemm g{DM, DM, 64, 128, 32768}; pg8::GSched S; S.init(T_ALL / 256, INW / 256, F.G, F.bid, wsp<bf16_t>(F, WS_U), 256u * DM * 2, wsp<bf16_t>(F, WS_WCAT), 256u * DM * 2);
            pg8::EpiPlain E{(GAS bf16_t*)wsp<bf16_t>(F, WS_ZG), ZGW, 1.0f};
            pg8::gemm_phase(F.lds, g, S, E, F.tid);
            if (MK_REP == 5) { __syncthreads(); pg8::gemm_phase(F.lds, g, S, E, F.tid); }
            if (MK_REP == 16) { __syncthreads(); pg8::gemm_phase(F.lds, g, S, pg8::EpiNull{}, F.tid); }
            if (MK_REP == 18 || MK_REP == 19) { __syncthreads(); pg8::GSched S2; S2.init(64, MK_REP == 18 ? 4 : 8, F.G, F.bid, wsp<bf16_t>(F, WS_U), 256u * DM * 2, wsp<bf16_t>(F, WS_WCAT), 256u * DM * 2); pg8::gemm_phase(F.lds, g, S2, pg8::EpiNull{}, F.tid); }
            if (MK_REP == 20) { __syncthreads(); pg8::Gemm g2{DM, 64, 64, 32768, 32768}; pg8::gemm_phase(F.lds, g2, S, pg8::EpiNull{}, F.tid); }
            if (MK_REP == 21) { __syncthreads(); pg8::GSched S2; S2.init(T_ALL / 256, INW / 256, F.G, F.bid, wsp<bf16_t>(F, WS_U), 0u, wsp<bf16_t>(F, WS_WCAT), 0u); pg8::gemm_phase(F.lds, g, S2, pg8::EpiNull{}, F.tid); }
            if (MK_REP == 22) { __syncthreads(); pg8::Gemm g2{2 * DM, DM, DM}; pg8::gemm_phase(F.lds, g2, S, pg8::EpiNull{}, F.tid); }
            if (MK_REP == 23) { __syncthreads(); pg8::Gemm g2{DM, DM, 64, 128, 32768}; pg8::gemm_phase(F.lds, g2, S, pg8::EpiNull{}, F.tid); }
            if (MK_REP == 24) { __syncthreads(); pg8::Gemm g2{DM, 64, DM, 32768, 128}; pg8::gemm_phase(F.lds, g2, S, pg8::EpiNull{}, F.tid); }
            if (MK_REP == 25) { for (int rr = 0; rr < 3; ++rr) { __syncthreads(); pg8::SameSched S2{S}; pg8::gemm_phase(F.lds, g, S2, pg8::EpiNull{}, F.tid); } }
            if (MK_REP == 26) { for (int rr = 0; rr < 3; ++rr) { __syncthreads(); pg8::gemm_phase(F.lds, g, S, pg8::EpiNull{}, F.tid); } }
            if (MK_REP == 27) { for (int rr = 0; rr < 3; ++rr) { __syncthreads(); pg8::gemm_phase(F.lds, g, S, E, F.tid); } }
            if (MK_REP == 28) { for (int rr = 0; rr < 3; ++rr) { __syncthreads(); pg8::gemm_phase<false, 1>(F.lds, g, S, pg8::EpiNull{}, F.tid); } }
            if (MK_REP == 29) { for (int rr = 0; rr < 3; ++rr) { __syncthreads(); pg8::gemm_phase<false, 2>(F.lds, g, S, pg8::EpiNull{}, F.tid); } }
            if (MK_REP == 30) { for (int rr = 0; rr < 3; ++rr) { __syncthreads(); pg8::gemm_phase<false, 3>(F.lds, g, S, pg8::EpiNull{}, F.tid); } }
            if (MK_REP == 31) { for (int rr = 0; rr < 3; ++rr) { __syncthreads(); pg8::EpiZGNoStore E2{F.tid == 1000 ? 2.0f : 1.0f}; pg8::gemm_phase(F.lds, g, S, E2, F.tid); } }
            if (MK_REP == 32) { for (int rr = 0; rr < 3; ++rr) { __syncthreads(); pg8::EpiContig E2{(GAS unsigned char*)wsp<unsigned char>(F, WS_Y), 1.0f}; pg8::gemm_phase(F.lds, g, S, E2, F.tid); } }
            if (MK_REP == 33) { __syncthreads(); pg8::EpiContig E2{(GAS unsigned char*)wsp<unsigned char>(F, WS_Y), 1.0f}; pg8::gemm_phase(F.lds, g, S, E2, F.tid); __syncthreads(); pg8::gemm_phase(F.lds, g, S, E2, F.tid); }
            if (MK_REP == 34) { __syncthreads(); pg8::gemm_phase(F.lds, g, S, E, F.tid); __syncthreads(); pg8::gemm_phase(F.lds, g, S, E, F.tid); }
            if (MK_REP == 17) { __syncthreads(); pg8::Gemm g2{DM / 2, DM, DM}; pg8::gemm_phase(F.lds, g2, S, pg8::EpiNull{}, F.tid); } }
        if (IN(pb + 0) && EN(2)) { frame_tid(F); cvt_ffn_share<0>(F, l, ((T_ALL / 256) * (INW / 256)) % 256); }
        SEAM(pb + 0);
        if (IN(pb + 1) && EN(3)) { frame_tid(F); ph2_tokens(F, l, need_ctx); ph2_htrans(F); if (MK_REP == 1) { ph2_tokens(F, l, need_ctx); ph2_htrans(F); } __syncthreads(); ph2_retkv(F, l); }
        SEAM(pb + 1);
        if (IN(pb + 2) && EN(4)) { frame_tid(F);
            { pg8::Gemm g{DM / 2, DM / 2, 64, 128, 32768}; pg8::GSched S; S.init(nMr, 16, F.G, F.bid, wsp<unsigned char>(F, WS_U8M), 256u * DM, wsp<unsigned char>(F, WS_WG8), 256u * DM);
              pg8::EpiShift E{pg8::EpiZG{(GAS bf16_t*)wsp<bf16_t>(F, WS_ZG), (const GAS float*)(inptr(I_BGATE) + (size_t)l * 4096), 1.0f / F8_WSCALE}};
              pg8::gemm_phase<true>(F.lds, g, S, E, F.tid); }
            frame_tid(F);
            const int xcd_ = F.bid & 7, j_ = F.bid >> 3, au_ = (xcd_ >> 1) * 64 + (2 * (xcd_ & 1) + (j_ >> 4)) * 16 + (j_ & 15);
            for (int k = 0; k < 2; ++k) { const int it = k == 0 ? au_ : ((need_ctx && F.bid >= 64 && F.bid < 80) ? 256 + (F.bid - 64) : -1); if (it < 0) break;
                const bf16_t *Q, *K, *V; bf16_t* O; int seq;
                if (it < 256) { const int b = it >> 6, h = (it >> 4) & 3, qb = it & 15;
                    Q = wsp<bf16_t>(F, WS_QP) + ((size_t)(b * 4 + h) * SEQ + qb * 256) * 128; K = wsp<bf16_t>(F, WS_KALL) + (size_t)(b * 2 + (h >> 1)) * 4352 * 128; V = wsp<bf16_t>(F, WS_VALL) + (size_t)(b * 2 + (h >> 1)) * 4352 * 128;
                    O = wsp<bf16_t>(F, WS_Y) + (size_t)(b * SEQ + qb * 256) * YW + 1536 + h * 128; seq = 4352; }
                else { const int r = it - 256, b = r >> 2, h = r & 3;
                    Q = wsp<bf16_t>(F, WS_QC) + (size_t)(b * 4 + h) * NCTX * 128; K = wsp<bf16_t>(F, WS_KALL) + ((size_t)(b * 2 + (h >> 1)) * 4352 + SEQ) * 128; V = wsp<bf16_t>(F, WS_VALL) + ((size_t)(b * 2 + (h >> 1)) * 4352 + SEQ) * 128;
                    O = wsp<bf16_t>(F, WS_Y) + (size_t)(T_LAT + b * NCTX) * YW + 1536 + h * 128; seq = 256; }
                attn::attn_dense_body(Q, K, V, O, YW, seq, (char*)F.ldsg, F.tid); }
            frame_tid(F);
            for (int k = 0; k < 2; ++k) hyena_item(F, l, F.bid + 256 * k, need_ctx);
            frame_tid(F);
            for (int k = 0; k < 2; ++k) { const int it = k == 0 ? (F.bid >= 64 ? F.bid - 64 : -1) : ((F.bid >= 80 && F.bid < 144) ? 192 + (F.bid - 80) : -1); if (it < 0) break; ret_scan_item(F, l, it); }
        }
        SEAM(pb + 2);
        if (IN(pb + 3) && EN(5)) { frame_tid(F);
            for (int rep = 0; rep < (MK_REP == 4 ? 2 : 1); ++rep) {
            ph3b_ytrans(F, need_ctx); __syncthreads();
            { int it = F.bid; while (it < NBATCH * 4 * NCH && !need_ctx && (it % NCH) < 2) it += F.G;
              if (it < NBATCH * 4 * NCH) { RetPre pre; ret_out_load(F, it, pre);
                for (;;) { int nx = it + F.G; while (nx < NBATCH * 4 * NCH && !need_ctx && (nx % NCH) < 2) nx += F.G; if (nx >= NBATCH * 4 * NCH) nx = -1;
                    ret_out_item(F, l, it, pre, nx); if (nx < 0) break; it = nx; } } } }
        }
        SEAM(pb + 3);
        if (IN(pb + 4) && EN(6)) { frame_tid(F); pg8::Gemm g{512, YW, 64, 128, 32768}; pg8::GSched S; S.init(nMr, 16, F.G, F.bid, wsp<bf16_t>(F, WS_Y), 256u * YW * 2, wsp<bf16_t>(F, WS_WB), 256u * 512 * 2, 2, 512u * 2);
            pg8::EpiGate E{(GAS bf16_t*)wsp<bf16_t>(F, WS_ZG)};
            pg8::gemm_phase(F.lds, g, S, E, F.tid); }
        if (IN(pb + 4) && EN(6)) { frame_tid(F); cvt_ffn_share<1>(F, l, need_ctx ? 64 : 0); }
        SEAM(pb + 4);
        if (IN(pb + 5) && EN(13)) { frame_tid(F); ph4b_sum(F, nrows); if (MK_REP == 13) ph4b_sum(F, nrows); }
        SEAM(pb + 5);
        if (IN(pb + 6) && EN(7)) { frame_tid(F); pg8::Gemm g{DM, DM, 64, 128, 32768}; pg8::GSched S; S.init(nMr, 4, F.G, F.bid, wsp<bf16_t>(F, WS_ZHT), 256u * DM * 2, wsp<bf16_t>(F, WS_WO4), 256u * DM * 2);
            pg8::EpiPlain E{(GAS bf16_t*)wsp<bf16_t>(F, WS_Y), DM, 1.0f};
            pg8::gemm_phase(F.lds, g, S, E, F.tid);
            cvt_ffn_share<2>(F, l, need_ctx ? 16 : 0);
            if (MK_REP == 9) { __syncthreads(); pg8::gemm_phase(F.lds, g, S, E, F.tid); } }
        SEAM(pb + 6);
        if (IN(pb + 7) && EN(8)) { frame_tid(F); if (MK_REP == 16) ph6_ln1(F, l, nrows, true); ph6_ln1(F, l, nrows); }
        SEAM(pb + 7);
        if (IN(pb + 8) && EN(9)) { frame_tid(F); if (moe) { ph7_gather(F, l, nrows); if (MK_REP == 11) ph7_gather(F, l, nrows); } }
        if (moe) SEAM(pb + 8);
        if (IN(pb + 9) && EN(10)) { frame_tid(F);
            const int FF = moe ? FFE : FFD;
            pg8::Gemm g{DM / 2, DM / 2, 64, 128, 32768}; pg8::MoeSched S; S.G = F.G; S.c = F.bid; S.nN = 2 * FF / 256; moe_tiles(F, l, moe, nMr, S.ts, S.ntiles);
            S.A = (const char*)(moe ? wsp<unsigned char>(F, WS_XG) : wsp<unsigned char>(F, WS_U)); S.B = (const char*)wsp<unsigned char>(F, moe ? WS_W13 : WS_W13D); S.a_tile = 256u * DM; S.b_tile = 256u * DM;
            pg8::EpiSwiglu E{(GAS unsigned char*)wsp<unsigned char>(F, WS_HID), FF, 1.0f / F8_WSCALE};
            pg8::gemm_phase<true>(F.lds, g, S, E, F.tid);
            if (MK_REP == 6) { __syncthreads(); pg8::gemm_phase<true>(F.lds, g, S, E, F.tid); }
        }
        SEAM(pb + 9);
        if (IN(pb + 10) && EN(11)) { frame_tid(F);
            const int FF = moe ? FFE : FFD;
            pg8::Gemm g{FF / 2, FF / 2, 64, 128, 32768}; pg8::MoeSched S; S.G = F.G; S.c = F.bid; S.nN = 4; moe_tiles(F, l, moe, nMr, S.ts, S.ntiles);
            S.A = (const char*)wsp<unsigned char>(F, WS_HID); S.B = (const char*)wsp<unsigned char>(F, moe ? WS_W2 : WS_W2D); S.a_tile = 256u * (unsigned)FF; S.b_tile = 256u * (unsigned)FF;
            pg8::EpiPlain E{(GAS bf16_t*)wsp<bf16_t>(F, WS_YO), DM, 1.0f / F8_WSCALE};
            pg8::gemm_phase<true>(F.lds, g, S, E, F.tid);
            if (MK_REP == 10) { __syncthreads(); pg8::gemm_phase<true>(F.lds, g, S, E, F.tid); }
        }
        if (IN(pb + 10) && EN(11) && l + 1 < DEPTH) { frame_tid(F); int ts_[NEXP], nt_; moe_tiles(F, l, moe, nMr, ts_, nt_);
            cvt_range(F, l + 1, 0, CVT_NMIX + cvt_e1(l + 1), (nt_ * 4) & 255); }
        SEAM(pb + 10);
        if (IN(pb + 11) && EN(12)) { frame_tid(F); if (MK_REP == 17) ph10_ln2(F, l, nrows, true); ph10_ln2(F, l, nrows); }
        if (l + 1 < DEPTH) SEAM(pb + 11);
    }
#undef IN
#undef SEAM
#undef QNEXT
}

#ifndef MK_PER_PHASE
#define MK_PER_PHASE 0
#endif
extern "C" void kernel_launch(void* const* d_in, const int* in_sizes, int n_in, void* d_out, int out_size, void* d_ws, size_t ws_size, hipStream_t stream) {
    static int grid = 0;
    if (grid == 0) {
        if (n_in != N_IN || out_size != T_LAT * DM || ws_size < WS_END) { fprintf(stderr, "kernel_launch: unexpected shapes: n_in %d out %d ws %zu (need %zu)\n", n_in, out_size, ws_size, (size_t)WS_END); grid = -1; return; }
        int dev = 0, cus = 0, per_cu = 0;
        if (hipGetDevice(&dev) != hipSuccess || hipDeviceGetAttribute(&cus, hipDeviceAttributeMultiprocessorCount, dev) != hipSuccess) { grid = -1; return; }
        if (hipFuncSetAttribute((const void*)mk_fwd, hipFuncAttributeMaxDynamicSharedMemorySize, LDS_BYTES) != hipSuccess) { fprintf(stderr, "kernel_launch: hipFuncSetAttribute failed\n"); grid = -1; return; }
        if (hipOccupancyMaxActiveBlocksPerMultiprocessor(&per_cu, (const void*)mk_fwd, NTHREADS, LDS_BYTES) != hipSuccess || per_cu < 1) { fprintf(stderr, "kernel_launch: occupancy query says %d\n", per_cu); }
        (void)hipGetLastError();
        grid = cus;
        if (grid != 256) { fprintf(stderr, "kernel_launch: built for 256 CUs, got %d\n", grid); grid = -1; return; }
    }
    if (grid < 0) return;
    (void)hipMemsetAsync((char*)d_ws + WS_CTL, 0, CTL_BYTES, stream);
    Args a{};
    for (int i = 0; i < N_IN; ++i) a.in[i] = (const float*)d_in[i];
    a.out = (float*)d_out; a.ws = (unsigned char*)d_ws;
#if MK_PER_PHASE
    for (int p = 0; p < NPH; ++p) { a.ph_lo = p; a.ph_hi = p + 1; hipLaunchKernelGGL(mk_fwd, dim3(grid), dim3(NTHREADS), LDS_BYTES, stream, a); }
#else
    a.ph_lo = 0; a.ph_hi = NPH; hipLaunchKernelGGL(mk_fwd, dim3(grid), dim3(NTHREADS), LDS_BYTES, stream, a);
#endif
    const hipError_t le = hipPeekAtLastError();
    if (le != hipSuccess) fprintf(stderr, "kernel_launch: launch failed: %s\n", hipGetErrorName(le));
}
```

```cpp
#include <hip/hip_runtime.h>
#include <cstdio>
#include <cstdint>

#define LAS __attribute__((address_space(3)))
#define GAS __attribute__((address_space(1)))
typedef unsigned short bf16_t;
typedef short bf16x8 __attribute__((ext_vector_type(8)));
typedef short s16x4 __attribute__((ext_vector_type(4)));
typedef float f32x2 __attribute__((ext_vector_type(2)));
typedef float f32x4 __attribute__((ext_vector_type(4)));
typedef float f32x8 __attribute__((ext_vector_type(8)));
typedef float f32x16 __attribute__((ext_vector_type(16)));
typedef unsigned u32x2 __attribute__((ext_vector_type(2)));
typedef unsigned u32x4 __attribute__((ext_vector_type(4)));
typedef int i32x4 __attribute__((ext_vector_type(4)));
typedef int i32x8 __attribute__((ext_vector_type(8)));

constexpr int DM = 1024, NBATCH = 4, SEQ = 4096, DEPTH = 4, NCTX = 256;
constexpr int T_LAT = NBATCH * SEQ, T_CTX = NBATCH * NCTX, T_ALL = T_LAT + T_CTX;
constexpr int INW = 6144, ZGW = 10240, FFD = 2816, FFE = 3584, NEXP = 8;
constexpr int OFF_R = 1536, OFF_H = 3584, OFF_D = 5120, OFF_G = 6144;
constexpr int YW = 2048;
constexpr int NCH = 34;
constexpr int SLOT_MAX = 144 * 256;
constexpr float ALPHA = 1.681792830507429f;
constexpr float LN_EPS = 1e-6f;
constexpr int NTHREADS = 512, NWAVES = 8;

enum { I_X = 0, I_C, I_CTX, I_CCTX, I_WMOD, I_BMOD, I_WIN, I_CAW, I_CAB, I_RDEC, I_HCW, I_HCB, I_HW1, I_HB1, I_HW2, I_HB2, I_HW3, I_HFREQ, I_HSKIP,
       I_QN, I_KN, I_WGATE, I_BGATE, I_WBR, I_WO, I_LNG, I_LNB, I_FW1, I_FW3, I_FW2, I_ROUTER, I_MW1, I_MW3, I_MW2, N_IN };

constexpr size_t al256(size_t x) { return (x + 255) / 256 * 256; }
constexpr size_t WS_CTL   = 0;
constexpr size_t CTL_BYTES = 128 * 1024;
constexpr size_t WS_MOD   = WS_CTL + CTL_BYTES;
constexpr size_t WS_ROPE  = al256(WS_MOD + (size_t)DEPTH * 5 * 6144 * 4);
constexpr size_t WS_GF    = al256(WS_ROPE + 2 * 64 * 32 * 4);
constexpr size_t WS_GC    = al256(WS_GF + (size_t)DEPTH * 2 * 512 * 8192 * 2);
constexpr size_t WS_WCAT  = al256(WS_GC + (size_t)DEPTH * 2 * 512 * 512 * 4);
constexpr size_t WS_WB    = al256(WS_WCAT + (size_t)ZGW * DM * 2);
constexpr size_t WS_WO4   = al256(WS_WB + (size_t)4096 * 512 * 2);
constexpr size_t WS_W13   = al256(WS_WO4 + (size_t)1024 * 4096 * 2);
constexpr size_t WS_W13D  = WS_W13 + (size_t)NEXP * 2 * FFE * DM;
constexpr size_t WS_W2D   = WS_W13D + (size_t)2 * FFD * DM;
static_assert(WS_W2D + (size_t)DM * FFD <= WS_W13 + (size_t)NEXP * 2 * FFE * DM * 2, "dense FFN weights must fit in the W13 region");
constexpr size_t WS_W2    = al256(WS_W13 + (size_t)NEXP * 2 * FFE * DM * 2);
constexpr size_t WS_XF    = al256(WS_W2 + (size_t)NEXP * DM * FFE * 2);
constexpr size_t WS_U     = al256(WS_XF + (size_t)T_ALL * DM * 4);
constexpr size_t WS_ZG    = al256(WS_U + (size_t)T_ALL * DM * 2);
constexpr size_t WS_HID   = WS_ZG;
constexpr size_t WS_XG    = al256(WS_HID + (size_t)SLOT_MAX * FFE * 2);
constexpr size_t WS_Y     = al256(WS_ZG + (size_t)T_ALL * ZGW * 2);
constexpr size_t WS_YO    = WS_Y;
constexpr size_t WS_ZHT   = al256(WS_Y + (size_t)T_ALL * YW * 2);
constexpr size_t WS_ZHTC  = al256(WS_ZHT + (size_t)NBATCH * 1536 * SEQ * 2);
constexpr size_t WS_YHT   = al256(WS_ZHTC + (size_t)NBATCH * 1536 * NCTX * 2);
constexpr size_t WS_YHTC  = al256(WS_YHT + (size_t)NBATCH * 512 * SEQ * 2);
constexpr size_t WS_QP    = al256(WS_YHTC + (size_t)NBATCH * 512 * NCTX * 2);
constexpr size_t WS_QC    = al256(WS_QP + (size_t)NBATCH * 4 * SEQ * 128 * 2);
constexpr size_t WS_KALL  = al256(WS_QC + (size_t)NBATCH * 4 * NCTX * 128 * 2);
constexpr size_t WS_VALL  = al256(WS_KALL + (size_t)NBATCH * 2 * 4352 * 128 * 2);
constexpr size_t WS_KVS   = al256(WS_VALL + (size_t)NBATCH * 2 * 4352 * 128 * 2);
constexpr size_t WS_PAIR  = al256(WS_KVS + (size_t)NBATCH * 4 * 2 * NCH * 16384 * 4);
constexpr size_t WS_U8M   = al256(WS_PAIR + (size_t)T_ALL * 32);
constexpr size_t WS_WG8   = al256(WS_U8M + (size_t)T_ALL * DM);
constexpr size_t WS_END   = al256(WS_WG8 + (size_t)4096 * DM);
static_assert(WS_XG + (size_t)SLOT_MAX * DM * 2 <= WS_Y, "H + XG must fit inside the ZG region");
static_assert(WS_YO + (size_t)SLOT_MAX * DM * 2 <= WS_ZHTC, "YO must fit inside Y + ZHT");

constexpr int CW_BAR = 0;
constexpr int CW_QHEAD = 4096;
constexpr int CW_MOE = 8192;

__device__ __forceinline__ unsigned pk2(float lo, float hi) { unsigned r; asm("v_cvt_pk_bf16_f32 %0, %1, %2" : "=v"(r) : "v"(lo), "v"(hi)); return r; }
__device__ __forceinline__ bf16_t f2bf(float f) { return (bf16_t)(pk2(f, 0.f) & 0xffffu); }
__device__ __forceinline__ float bflo(unsigned w) { return __uint_as_float(w << 16); }
__device__ __forceinline__ float bfhi(unsigned w) { return __uint_as_float(w & 0xffff0000u); }
__device__ __forceinline__ f32x4 bf4_f32(u32x2 w) { f32x4 f; f.x = bflo(w.x); f.y = bfhi(w.x); f.z = bflo(w.y); f.w = bfhi(w.y); return f; }
__device__ __forceinline__ u32x2 f32_bf4(f32x4 v) { u32x2 w; w.x = pk2(v.x, v.y); w.y = pk2(v.z, v.w); return w; }
__device__ __forceinline__ float bf1(bf16_t h) { return __uint_as_float(((unsigned)h) << 16); }
__device__ __forceinline__ void unpack8(u32x4 w, float* f) { f[0] = bflo(w.x); f[1] = bfhi(w.x); f[2] = bflo(w.y); f[3] = bfhi(w.y); f[4] = bflo(w.z); f[5] = bfhi(w.z); f[6] = bflo(w.w); f[7] = bfhi(w.w); }
__device__ __forceinline__ u32x4 pack8(const float* f) { u32x4 w; w.x = pk2(f[0], f[1]); w.y = pk2(f[2], f[3]); w.z = pk2(f[4], f[5]); w.w = pk2(f[6], f[7]); return w; }
__device__ __forceinline__ float shfl_xor_l(float v, int o, int lane) { return __int_as_float(__builtin_amdgcn_ds_bpermute((lane ^ o) << 2, __float_as_int(v))); }
__device__ __forceinline__ float wave_sum(float v, int lane) {
#pragma unroll
    for (int o = 1; o < 64; o <<= 1) v += shfl_xor_l(v, o, lane);
    return v;
}
__device__ __forceinline__ float sigmoidf_(float x) { return __builtin_amdgcn_rcpf(1.f + __expf(-x)); }
__device__ __forceinline__ float siluf_(float x) { return x * sigmoidf_(x); }
__device__ __forceinline__ int crow(int r, int hi) { return (r & 3) + 8 * (r >> 2) + 4 * hi; }
#define LDS_WAIT() asm volatile("s_waitcnt lgkmcnt(0)" ::: "memory")
constexpr float F8_WSCALE = 64.0f;
__device__ __forceinline__ float clamp448(float x) { return __builtin_amdgcn_fmed3f(x, -448.f, 448.f); }
__device__ __forceinline__ unsigned pk4_fp8(float a, float b, float c, float d) {
    int w = __builtin_amdgcn_cvt_pk_fp8_f32(clamp448(a), clamp448(b), 0, false); w = __builtin_amdgcn_cvt_pk_fp8_f32(clamp448(c), clamp448(d), w, true); return (unsigned)w; }

#define XB_TMO      128
#define XB_XCNT(j)  (256  + 64 * (j))
#define XB_XSUB(j)  (1280 + 64 * (j))
#define XB_XGEN(j)  (2304 + 64 * (j))
#define XB_TOP      3328
#define XB_TOPGEN   3392
#define XCD_BAR_WORDS 3456
#define XB_SPIN_CAP (1u << 22)

__device__ __forceinline__ unsigned xb_ld(unsigned* p)              { return __hip_atomic_load(p, __ATOMIC_RELAXED, __HIP_MEMORY_SCOPE_AGENT); }
__device__ __forceinline__ unsigned xb_add(unsigned* p, unsigned v) { return __hip_atomic_fetch_add(p, v, __ATOMIC_RELAXED, __HIP_MEMORY_SCOPE_AGENT); }
__device__ __forceinline__ unsigned xb_xcc_id() { return (unsigned)__builtin_amdgcn_s_getreg((3 << 11) | 20) & 0xFu; }
#define XB_SPIN(cond, bar) do { unsigned _sp = 0; while (cond) { __builtin_amdgcn_s_sleep(1); \
    if ((++_sp & 255u) == 0u) { if (xb_ld(&(bar)[XB_TMO])) break; if (_sp > XB_SPIN_CAP) { atomicAdd(&(bar)[XB_TMO], 1u); break; } } } } while (0)

struct XcdBarrier { unsigned* bar; unsigned x; volatile LAS unsigned* st; };

__device__ __forceinline__ XcdBarrier xcd_barrier_post(unsigned* bar, volatile LAS unsigned* st) {
    XcdBarrier b; b.bar = bar; b.x = xb_xcc_id(); b.st = st;
    if (threadIdx.x == 0) (void)xb_add(&bar[XB_XCNT(b.x)], 1u);
    return b;
}
__device__ __forceinline__ void xcd_barrier_complete(unsigned* bar, unsigned x, unsigned& nloc, unsigned& nx) {
    const unsigned G = gridDim.x * gridDim.y * gridDim.z;
    unsigned sum, cnt, mine, sp = 0u;
    for (;;) {
        sum = 0u; cnt = 0u; mine = 0u;
#pragma unroll
        for (unsigned j = 0; j < 16; ++j) { const unsigned c = xb_ld(&bar[XB_XCNT(j)]); sum += c; cnt += (c > 0u) ? 1u : 0u; mine = (j == x) ? c : mine; }
        if (sum == G) break;
        __builtin_amdgcn_s_sleep(1);
        if ((++sp & 255u) == 0u) { if (xb_ld(&bar[XB_TMO])) break; if (sp > XB_SPIN_CAP) { atomicAdd(&bar[XB_TMO], 1u); break; } }
    }
    nloc = mine > 0u ? mine : 1u; nx = cnt > 0u ? cnt : 1u;
}
__device__ __forceinline__ void xcd_barrier(const XcdBarrier& b) {
    asm volatile("s_waitcnt vmcnt(0)" ::: "memory");
    __syncthreads();
    int t0_ = threadIdx.x; asm volatile("" : "+v"(t0_));
    if (t0_ == 0) {
        unsigned* bar = b.bar; unsigned bx = b.x;
        asm volatile("" : "+s"(bar), "+s"(bx));
        __builtin_amdgcn_s_waitcnt(0);
        unsigned nloc = b.st[0], nx = b.st[1];
        if (nloc == 0u) { xcd_barrier_complete(bar, bx, nloc, nx); b.st[0] = nloc; b.st[1] = nx; }
        const unsigned old = xb_add(&bar[XB_XSUB(bx)], 1u);
        const unsigned gen = old / nloc;
        if (old + 1u == (gen + 1u) * nloc) {
            __builtin_amdgcn_fence(__ATOMIC_RELEASE, "agent");
            asm volatile("s_waitcnt vmcnt(0)" ::: "memory");
            const unsigned og = xb_add(&bar[XB_TOP], 1u);
            const unsigned tg = og / nx;
            if (og + 1u == (tg + 1u) * nx) xb_add(&bar[XB_TOPGEN], 1u);
            else XB_SPIN(xb_ld(&bar[XB_TOPGEN]) == tg, bar);
            __builtin_amdgcn_fence(__ATOMIC_ACQUIRE, "agent");
            xb_add(&bar[XB_XGEN(bx)], 1u);
            asm volatile("s_waitcnt vmcnt(0)" ::: "memory");
        } else {
            XB_SPIN(xb_ld(&bar[XB_XGEN(bx)]) == gen, bar);
            __builtin_amdgcn_fence(__ATOMIC_ACQUIRE, "agent");
            asm volatile("s_waitcnt vmcnt(0)" ::: "memory");
        }
    }
    __syncthreads();
}

namespace pg8 {
constexpr int BM = 256, BK = 64, HALF = 128, HTB = HALF * BK * 2, STAGE_BYTES = 8 * HTB, NXCD = 8, WGM = 8;
__device__ __forceinline__ int lds_byte(int r, int c) { const int st = (r >> 4) * 2 + (c >> 5), rr = r & 15, cc = c & 31, ob = rr * 64 + cc * 2; return st * 1024 + (ob ^ (((ob >> 9) & 1) << 5)); }
__device__ __forceinline__ void stage_rc(int b, int& R, int& C) { const int st = b / 1024, sb = b % 1024, swz = sb ^ (((sb >> 9) & 1) << 5); R = (st >> 1) * 16 + swz / 64; C = (st & 1) * 32 + (swz % 64) / 2; }
__device__ __forceinline__ int perm32(int rho) { const int n = rho >> 4, i = rho & 15; return 8 * (i >> 2) + 4 * n + (i & 3); }

struct Unit { const char* A; const char* B; int pm, pn, e, pad; };
struct Gemm { int K, lda, ldb; int kstep = BK * 2, kstepb = BK * 2; };

struct GSched {
    int nM, nN, nwg, G, c;
    const char* A; const char* B; unsigned a_tile, b_tile, a_col; int a_sh;
    __device__ void init(int nM_, int nN_, int G_, int c_, const void* A_, unsigned a_tile_, const void* B_, unsigned b_tile_, int a_sh_ = 30, unsigned a_col_ = 0) {
        nM = nM_; nN = nN_; nwg = nM * nN; G = G_; c = c_; A = (const char*)A_; B = (const char*)B_; a_tile = a_tile_; b_tile = b_tile_; a_sh = a_sh_; a_col = a_col_; }
    __device__ __forceinline__ bool next(int i, Unit& u) const {
        const int L = i * G + c; if (L >= nwg) return false;
        int wgid = L; { const int q = nwg / NXCD, r = nwg % NXCD, xcd = wgid % NXCD, off = wgid / NXCD; wgid = (xcd < r ? xcd * (q + 1) : r * (q + 1) + (xcd - r) * q) + off; }
        const int nig = WGM * nN, gid = wgid / nig, fm = gid * WGM, gsz = (nM - fm) < WGM ? (nM - fm) : WGM;
        u.pm = fm + ((wgid % nig) % gsz); u.pn = (wgid % nig) / gsz; u.e = 0; u.pad = 0;
        u.A = A + (size_t)((unsigned)u.pm * a_tile + (unsigned)(u.pn >> a_sh) * a_col); u.B = B + (size_t)((unsigned)u.pn * b_tile); return true;
    }
};
struct SameSched { GSched s; __device__ __forceinline__ bool next(int i, Unit& u) const { Unit t; if (!s.next(i, t)) return false; s.next(0, u); return true; } };
struct MoeSched {
    int G, c, nN, ntiles; int ts[NEXP];
    const char* A; const char* B; unsigned a_tile, b_tile;
    __device__ __forceinline__ bool next(int i, Unit& u) const {
        const int L = i * G + c; if (L >= ntiles * nN) return false;
        const int rt = L / nN, pn = L % nN; int e = 0;
#pragma unroll
        for (int k = 1; k < NEXP; ++k) e += (rt >= ts[k]) ? 1 : 0;
        u.pm = rt; u.pn = pn; u.e = e; u.pad = 0; u.A = A + (size_t)((unsigned)rt * a_tile); u.B = B + (size_t)((unsigned)(e * nN + pn) * b_tile); return true;
    }
};

__device__ __forceinline__ unsigned cvt_pk_bf16(float lo, float hi) { return pk2(lo, hi); }

template <bool F8 = false, int PROBE = 0, class Epi, class Sched>
__device__ __forceinline__ void gemm_phase(LAS unsigned char* lds, const Gemm g, const Sched& S, const Epi& E, const int tid) {
    const int wid = __builtin_amdgcn_readfirstlane(tid >> 6), lane = tid & 63, wr = wid >> 2, wc = wid & 3, fr = lane & 15, fq = lane >> 4;
    const int K = g.K, nt = K / BK;
    unsigned voffA[2], voffB[2];
#pragma unroll
    for (int i = 0; i < 2; ++i) { int R, C; stage_rc(tid * 16 + i * 8192, R, C); const int Rb = Epi::PERM ? ((R & ~31) + perm32(R & 31)) : R;
        voffA[i] = (unsigned)(R * g.lda + C) * 2u; voffB[i] = (unsigned)(Rb * g.ldb + C) * 2u; }
    const size_t kstep = (size_t)g.kstep, kstepb = (size_t)g.kstepb;
    const size_t hstepA = (size_t)HALF * g.lda * 2, hstepB = (size_t)HALF * g.ldb * 2;
    const unsigned ldsw = (unsigned)wid * 1024u;
    const int aoff = lds_byte(wr * 64 + fr, fq * 8), boff = lds_byte(wc * 32 + fr, fq * 8);
#define PG8_SA(b, h) (((b) * 2 + (h)) * HTB)
#define PG8_SB(b, h) ((4 + (b) * 2 + (h)) * HTB)
#define PG8_STAGE(bufoff, gbase, voff) do { if constexpr (PROBE == 1 || PROBE == 3) break; _Pragma("unroll") for (int _i = 0; _i < 2; ++_i) { unsigned _vo = (voff)[_i]; if constexpr (F8) asm volatile("" : "+v"(_vo));     \
        __builtin_amdgcn_global_load_lds((const unsigned*)((const char*)(gbase) + _vo), (LAS unsigned*)(lds + (bufoff) + ldsw + _i * 8192), 16, 0, 0); } } while (0)
#define PG8_CAT(x0, x1) __builtin_shufflevector(__builtin_bit_cast(i32x4, x0), __builtin_bit_cast(i32x4, x1), 0, 1, 2, 3, 4, 5, 6, 7)
#define PG8_LDA(dst, b, h) do { if constexpr (PROBE == 3) { _Pragma("unroll") for (int m = 0; m < 4; ++m) asm volatile("" : "+v"(dst[m][0]), "+v"(dst[m][1])); break; } _Pragma("unroll") for (int m = 0; m < 4; ++m) { const bf16x8 _x0 = *(const LAS bf16x8*)(lds + PG8_SA(b, h) + aoff + m * 2048), _x1 = *(const LAS bf16x8*)(lds + PG8_SA(b, h) + aoff + m * 2048 + 1024); \
        if constexpr (F8) dst##8[m] = PG8_CAT(_x0, _x1); else { dst[m][0] = _x0; dst[m][1] = _x1; } } } while (0)
#define PG8_LDB(dst, b, h) do { if constexpr (PROBE == 3) { _Pragma("unroll") for (int n = 0; n < 2; ++n) asm volatile("" : "+v"(dst[n][0]), "+v"(dst[n][1])); break; } _Pragma("unroll") for (int n = 0; n < 2; ++n) { const bf16x8 _x0 = *(const LAS bf16x8*)(lds + PG8_SB(b, h) + boff + n * 2048), _x1 = *(const LAS bf16x8*)(lds + PG8_SB(b, h) + boff + n * 2048 + 1024); \
        if constexpr (F8) dst##8[n] = PG8_CAT(_x0, _x1); else { dst[n][0] = _x0; dst[n][1] = _x1; } } } while (0)
#define PG8_MMA(ai, bj, At, Bt) do { if constexpr (PROBE == 2) { _Pragma("unroll") for (int m = 0; m < 4; ++m) asm volatile("" :: "v"(At[m][0]), "v"(At[m][1])); _Pragma("unroll") for (int n = 0; n < 2; ++n) asm volatile("" :: "v"(Bt[n][0]), "v"(Bt[n][1])); break; } __builtin_amdgcn_s_setprio(1); _Pragma("unroll") for (int m = 0; m < 4; ++m) _Pragma("unroll") for (int n = 0; n < 2; ++n) { \
        if constexpr (F8) asm volatile("v_mfma_f32_16x16x128_f8f6f4 %0, %1, %2, %0" : "+v"(acc[ai][bj][m][n]) : "v"(Bt##8[n]), "v"(At##8[m]));     \
        else { _Pragma("unroll") for (int k = 0; k < 2; ++k) acc[ai][bj][m][n] = __builtin_amdgcn_mfma_f32_16x16x32_bf16(Bt[n][k], At[m][k], acc[ai][bj][m][n], 0, 0, 0); } } __builtin_amdgcn_s_setprio(0); } while (0)
#define PG8_WAIT_V(n) asm volatile("s_waitcnt vmcnt(" #n ")" ::: "memory")
#define PG8_WAIT_L(n) asm volatile("s_waitcnt lgkmcnt(" #n ")" ::: "memory")
#define PG8_BAR __builtin_amdgcn_s_barrier()
#define PG8_SCHED __builtin_amdgcn_sched_barrier(0)
    Unit cur, nxt; int ui = 0;
    if (!S.next(0, cur)) return;
    f32x4 acc[2][2][4][2];
    float zero_ = 0.f; asm volatile("" : "+v"(zero_));
#pragma unroll
    for (int a = 0; a < 2; ++a)
#pragma unroll
        for (int b = 0; b < 2; ++b)
#pragma unroll
            for (int m = 0; m < 4; ++m)
#pragma unroll
                for (int n = 0; n < 2; ++n) acc[a][b][m][n] = (f32x4){zero_, zero_, zero_, zero_};
    bf16x8 At[4][2], B0[2][2], B1[2][2]; i32x8 At8[4], B08[2], B18[2];
    if constexpr (PROBE == 3) { _Pragma("unroll") for (int m = 0; m < 4; ++m) { At[m][0] = (bf16x8)0; At[m][1] = (bf16x8)0; } _Pragma("unroll") for (int n = 0; n < 2; ++n) { B0[n][0] = (bf16x8)0; B0[n][1] = (bf16x8)0; B1[n][0] = (bf16x8)0; B1[n][1] = (bf16x8)0; } }
    const char* cA = cur.A; const char* cB = cur.B;
    PG8_STAGE(PG8_SB(0, 0), cB, voffB); PG8_STAGE(PG8_SA(0, 0), cA, voffA); PG8_STAGE(PG8_SB(0, 1), cB + hstepB, voffB); PG8_STAGE(PG8_SA(0, 1), cA + hstepA, voffA);
    if (wr == 1) PG8_BAR;
    PG8_WAIT_V(4); PG8_BAR;
    PG8_STAGE(PG8_SB(1, 0), cB + kstepb, voffB); PG8_STAGE(PG8_SA(1, 0), cA + kstep, voffA); PG8_STAGE(PG8_SB(1, 1), cB + hstepB + kstepb, voffB); PG8_STAGE(PG8_SA(1, 1), cA + hstepA + kstep, voffA);
    PG8_WAIT_V(8); PG8_BAR;
    for (;;) {
        const bool has_next = S.next(ui + 1, nxt);
        const char* nA = has_next ? nxt.A : cA; const char* nB = has_next ? nxt.B : cB;
#pragma clang loop unroll(disable)
        for (int t = 0; t < nt; t += 2) {
            const bool last = (t == nt - 2), first = (t == 0);
            const char* a1 = cA + (size_t)(t + 1) * kstep;
            const char* a2 = last ? nA : cA + (size_t)(t + 2) * kstep; const char* b2 = last ? nB : cB + (size_t)(t + 2) * kstepb;
            const char* a3 = a2 + kstep; const char* b3 = b2 + kstepb;
            PG8_LDB(B0, 0, 0); PG8_SCHED; PG8_LDA(At, 0, 0); if (!first) PG8_STAGE(PG8_SA(1, 1), a1 + hstepA, voffA);
            PG8_WAIT_L(8); PG8_BAR; PG8_WAIT_L(0); PG8_MMA(0, 0, At, B0); PG8_BAR; PG8_SCHED;
            PG8_LDB(B1, 0, 1); PG8_STAGE(PG8_SB(0, 0), b2, voffB);
            PG8_BAR; PG8_WAIT_L(0); PG8_MMA(0, 1, At, B1); PG8_BAR;
            PG8_LDA(At, 0, 1); PG8_STAGE(PG8_SA(0, 0), a2, voffA);
            PG8_BAR; PG8_WAIT_L(0); PG8_MMA(1, 0, At, B0); PG8_BAR; PG8_SCHED;
            PG8_STAGE(PG8_SB(0, 1), b2 + hstepB, voffB);
            if (first && ui > 0) { if constexpr (Epi::NST == 16) PG8_WAIT_V(22); else if constexpr (Epi::NST == 8) PG8_WAIT_V(14); else PG8_WAIT_V(6); }
            else PG8_WAIT_V(6);
            PG8_BAR; PG8_MMA(1, 1, At, B1); PG8_BAR;
            PG8_LDB(B0, 1, 0); PG8_SCHED; PG8_LDA(At, 1, 0); PG8_STAGE(PG8_SA(0, 1), a2 + hstepA, voffA);
            PG8_WAIT_L(8); PG8_BAR; PG8_WAIT_L(0); PG8_MMA(0, 0, At, B0); PG8_BAR; PG8_SCHED;
            PG8_LDB(B1, 1, 1); PG8_STAGE(PG8_SB(1, 0), b3, voffB);
            PG8_BAR; PG8_WAIT_L(0); PG8_MMA(0, 1, At, B1); PG8_BAR;
            PG8_LDA(At, 1, 1); PG8_STAGE(PG8_SA(1, 0), a3, voffA);
            PG8_BAR; PG8_WAIT_L(0); PG8_MMA(1, 0, At, B0); PG8_BAR; PG8_SCHED;
            PG8_STAGE(PG8_SB(1, 1), b3 + hstepB, voffB);
            PG8_WAIT_V(6); PG8_BAR; PG8_MMA(1, 1, At, B1); PG8_BAR;
        }
        const auto epre = E.pre(cur, wr, wc, fr, fq); asm volatile("" ::: "memory");
        PG8_STAGE(PG8_SA(1, 1), nA + kstep + hstepA, voffA); asm volatile("" ::: "memory");
        if constexpr (F8) asm volatile("s_nop 15\n\ts_nop 15" ::: "memory");
        E(acc, cur, wr, wc, fr, fq, epre);
        if (!has_next) break;
        asm volatile("" : "+v"(zero_));
#pragma unroll
        for (int a = 0; a < 2; ++a)
#pragma unroll
            for (int b = 0; b < 2; ++b)
#pragma unroll
                for (int m = 0; m < 4; ++m)
#pragma unroll
                    for (int n = 0; n < 2; ++n) acc[a][b][m][n] = (f32x4){zero_, zero_, zero_, zero_};
        cur = nxt; cA = nA; cB = nB; ++ui;
    }
    PG8_WAIT_V(0);
    if (wr == 0) PG8_BAR;
    PG8_BAR;
#undef PG8_SA
#undef PG8_SB
#undef PG8_STAGE
#undef PG8_LDA
#undef PG8_LDB
#undef PG8_MMA
#undef PG8_CAT
#undef PG8_WAIT_V
#undef PG8_WAIT_L
#undef PG8_BAR
#undef PG8_SCHED
}

typedef f32x4 Acc[2][2][4][2];

struct EpiPreNone {};
struct EpiZG { static constexpr bool PERM = true; static constexpr int NST = 16;
    GAS bf16_t* ZG; const GAS float* bgate; float sc;
    struct Pre { f32x4 bv[2][2]; };
    __device__ __forceinline__ Pre pre(const Unit& u, int wr, int wc, int fr, int fq) const {
        const int col0 = u.pn * BM + wc * 32 + 8 * fq; const bool gate = (u.pn >= 24); Pre p;
#pragma unroll
        for (int bj = 0; bj < 2; ++bj)
#pragma unroll
            for (int n = 0; n < 2; ++n) p.bv[bj][n] = gate ? *(const GAS f32x4*)(bgate + (col0 - OFF_G) + bj * HALF + 4 * n) : (f32x4){0.f, 0.f, 0.f, 0.f};
        return p; }
    __device__ __forceinline__ void operator()(const Acc& acc, const Unit& u, int wr, int wc, int fr, int fq, const Pre& p) const {
        const int row0 = u.pm * BM + wr * 64 + fr, col0 = u.pn * BM + wc * 32 + 8 * fq; const bool gate = (u.pn >= 24);
#pragma unroll
        for (int ai = 0; ai < 2; ++ai)
#pragma unroll
            for (int m = 0; m < 4; ++m) { GAS bf16_t* rowp = ZG + (size_t)(row0 + ai * HALF + m * 16) * ZGW + col0;
#pragma unroll
                for (int bj = 0; bj < 2; ++bj) { f32x4 v0 = acc[ai][bj][m][0] * sc + p.bv[bj][0], v1 = acc[ai][bj][m][1] * sc + p.bv[bj][1];
                    if (gate) {
#pragma unroll
                        for (int j = 0; j < 4; ++j) { v0[j] = sigmoidf_(v0[j]); v1[j] = sigmoidf_(v1[j]); } }
                    u32x4 w; w.x = pk2(v0[0], v0[1]); w.y = pk2(v0[2], v0[3]); w.z = pk2(v1[0], v1[1]); w.w = pk2(v1[2], v1[3]);
                    *(GAS u32x4*)(rowp + bj * HALF) = w; } }
    }
};
struct EpiShift { static constexpr bool PERM = true; static constexpr int NST = 16; EpiZG e;
    typedef EpiZG::Pre Pre;
    __device__ __forceinline__ Pre pre(const Unit& u, int wr, int wc, int fr, int fq) const { Unit u2 = u; u2.pn += 24; return e.pre(u2, wr, wc, fr, fq); }
    __device__ __forceinline__ void operator()(const Acc& acc, const Unit& u, int wr, int wc, int fr, int fq, const Pre& p) const { Unit u2 = u; u2.pn += 24; e(acc, u2, wr, wc, fr, fq, p); } };
struct EpiGate { static constexpr bool PERM = true; static constexpr int NST = 16;
    GAS bf16_t* ZG;
    struct Pre { u32x4 gw[2][4][2]; };
    __device__ __forceinline__ Pre pre(const Unit& u, int wr, int wc, int fr, int fq) const {
        const int row0 = u.pm * BM + wr * 64 + fr, col0 = OFF_G + u.pn * BM + wc * 32 + 8 * fq;
        GAS bf16_t* base = ZG + (size_t)row0 * ZGW + col0; Pre p;
#pragma unroll
        for (int ai = 0; ai < 2; ++ai)
#pragma unroll
            for (int m = 0; m < 4; ++m)
#pragma unroll
                for (int bj = 0; bj < 2; ++bj) p.gw[ai][m][bj] = *(const GAS u32x4*)(base + (size_t)(ai * HALF + m * 16) * ZGW + bj * HALF);
        return p; }
    __device__ __forceinline__ void operator()(const Acc& acc, const Unit& u, int wr, int wc, int fr, int fq, const Pre& p) const {
        const int row0 = u.pm * BM + wr * 64 + fr, col0 = OFF_G + u.pn * BM + wc * 32 + 8 * fq;
        GAS bf16_t* base = ZG + (size_t)row0 * ZGW + col0;
#pragma unroll
        for (int ai = 0; ai < 2; ++ai)
#pragma unroll
            for (int m = 0; m < 4; ++m)
#pragma unroll
                for (int bj = 0; bj < 2; ++bj) { float gf[8]; unpack8(p.gw[ai][m][bj], gf);
                    const f32x4 v0 = acc[ai][bj][m][0], v1 = acc[ai][bj][m][1];
                    u32x4 w; w.x = pk2(v0[0] * gf[0], v0[1] * gf[1]); w.y = pk2(v0[2] * gf[2], v0[3] * gf[3]); w.z = pk2(v1[0] * gf[4], v1[1] * gf[5]); w.w = pk2(v1[2] * gf[6], v1[3] * gf[7]);
                    *(GAS u32x4*)(base + (size_t)(ai * HALF + m * 16) * ZGW + bj * HALF) = w; }
    }
};
struct EpiSwiglu { static constexpr bool PERM = true; static constexpr int NST = 8;
    GAS unsigned char* H; int ldh; float sc;
    typedef EpiPreNone Pre; __device__ __forceinline__ Pre pre(const Unit&, int, int, int, int) const { return Pre{}; }
    __device__ __forceinline__ void operator()(const Acc& acc, const Unit& u, int wr, int wc, int fr, int fq, const Pre&) const {
        const int row0 = u.pm * BM + wr * 64 + fr, col0 = u.pn * HALF + wc * 32 + 8 * fq;
#pragma unroll
        for (int ai = 0; ai < 2; ++ai)
#pragma unroll
            for (int m = 0; m < 4; ++m) { GAS unsigned char* rowp = H + (size_t)(row0 + ai * HALF + m * 16) * ldh + col0;
                const f32x4 a0 = acc[ai][0][m][0] * sc, a1 = acc[ai][0][m][1] * sc, b0 = acc[ai][1][m][0] * sc, b1 = acc[ai][1][m][1] * sc;
                float h[8];
#pragma unroll
                for (int j = 0; j < 4; ++j) { h[j] = siluf_(a0[j]) * b0[j]; h[4 + j] = siluf_(a1[j]) * b1[j]; }
                u32x2 w; w.x = pk4_fp8(h[0], h[1], h[2], h[3]); w.y = pk4_fp8(h[4], h[5], h[6], h[7]); *(GAS u32x2*)rowp = w; }
    }
};
struct EpiPlain { static constexpr bool PERM = true; static constexpr int NST = 16;
    GAS bf16_t* O; int ldo; float sc;
    typedef EpiPreNone Pre; __device__ __forceinline__ Pre pre(const Unit&, int, int, int, int) const { return Pre{}; }
    __device__ __forceinline__ void operator()(const Acc& acc, const Unit& u, int wr, int wc, int fr, int fq, const Pre&) const {
        const int row0 = u.pm * BM + wr * 64 + fr, col0 = u.pn * BM + wc * 32 + 8 * fq;
#pragma unroll
        for (int ai = 0; ai < 2; ++ai)
#pragma unroll
            for (int m = 0; m < 4; ++m) { GAS bf16_t* rowp = O + (size_t)(row0 + ai * HALF + m * 16) * ldo + col0;
#pragma unroll
                for (int bj = 0; bj < 2; ++bj) { const f32x4 v0 = acc[ai][bj][m][0] * sc, v1 = acc[ai][bj][m][1] * sc;
                    u32x4 w; w.x = pk2(v0[0], v0[1]); w.y = pk2(v0[2], v0[3]); w.z = pk2(v1[0], v1[1]); w.w = pk2(v1[2], v1[3]);
                    *(GAS u32x4*)(rowp + bj * HALF) = w; } }
    }
};
struct EpiZGNoStore { static constexpr bool PERM = true; static constexpr int NST = 0; float sc;
    typedef EpiPreNone Pre; __device__ __forceinline__ Pre pre(const Unit&, int, int, int, int) const { return Pre{}; }
    __device__ __forceinline__ void operator()(const Acc& acc, const Unit& u, int wr, int wc, int fr, int fq, const Pre&) const {
#pragma unroll
        for (int ai = 0; ai < 2; ++ai)
#pragma unroll
            for (int m = 0; m < 4; ++m)
#pragma unroll
                for (int bj = 0; bj < 2; ++bj) { f32x4 v0 = acc[ai][bj][m][0] * sc, v1 = acc[ai][bj][m][1] * sc;
                    u32x4 w; w.x = pk2(v0[0], v0[1]); w.y = pk2(v0[2], v0[3]); w.z = pk2(v1[0], v1[1]); w.w = pk2(v1[2], v1[3]);
                    asm volatile("" :: "v"(w)); }
    }
};
struct EpiContig { static constexpr bool PERM = true; static constexpr int NST = 16; GAS unsigned char* O; float sc;
    typedef EpiPreNone Pre; __device__ __forceinline__ Pre pre(const Unit&, int, int, int, int) const { return Pre{}; }
    __device__ __forceinline__ void operator()(const Acc& acc, const Unit& u, int wr, int wc, int fr, int fq, const Pre&) const {
        GAS unsigned char* base = O + (size_t)((u.pm * 24 + u.pn) & 511) * 131072u + (size_t)((wr * 4 + wc) * 1024 + (fq * 16 + fr) * 16);
#pragma unroll
        for (int ai = 0; ai < 2; ++ai)
#pragma unroll
            for (int m = 0; m < 4; ++m)
#pragma unroll
                for (int bj = 0; bj < 2; ++bj) { f32x4 v0 = acc[ai][bj][m][0] * sc, v1 = acc[ai][bj][m][1] * sc;
                    u32x4 w; w.x = pk2(v0[0], v0[1]); w.y = pk2(v0[2], v0[3]); w.z = pk2(v1[0], v1[1]); w.w = pk2(v1[2], v1[3]);
                    *(GAS u32x4*)(base + ((ai * 4 + m) * 2 + bj) * 8192) = w; }
    }
};
struct EpiNull { static constexpr bool PERM = true; static constexpr int NST = 0;
    typedef EpiPreNone Pre; __device__ __forceinline__ Pre pre(const Unit&, int, int, int, int) const { return Pre{}; }
    __device__ __forceinline__ void operator()(const Acc& acc, const Unit& u, int wr, int wc, int fr, int fq, const Pre&) const {
#pragma unroll
        for (int ai = 0; ai < 2; ++ai)
#pragma unroll
            for (int bj = 0; bj < 2; ++bj)
#pragma unroll
                for (int m = 0; m < 4; ++m)
#pragma unroll
                    for (int n = 0; n < 2; ++n) asm volatile("" :: "v"(acc[ai][bj][m][n]));
    }
};
}

namespace attn {
constexpr int D = 128, NW = 8, QBLK = 32, KVBLK = 64;
constexpr float SCALE = 0.088388347648318440f;
constexpr float THR = 8.f;
constexpr int LDQ = 128, LDK = 128;
constexpr size_t SHM_V = KVBLK * D * 2, SHM_K = KVBLK * D * 2, SHM_ATTN = 2 * SHM_V + 2 * SHM_K + NW * 64 * 4;
#define KSWZ(row, colB) ((row) * 256 + ((colB) ^ (((row) & 7) << 4)))
#define SBAR() __builtin_amdgcn_sched_barrier(0)
__device__ __forceinline__ unsigned cvtpk(float lo, float hi) { unsigned r; asm volatile("v_cvt_pk_bf16_f32 %0, %1, %2" : "=v"(r) : "v"(lo), "v"(hi)); return r; }
__device__ __forceinline__ bf16x8 ld8(const bf16_t* p) { return *reinterpret_cast<const bf16x8*>(p); }

__device__ __forceinline__ void partialSM(f32x16& p0, f32x16& p1, float& m_reg, float& mn, float& alpha) {
  constexpr float C = SCALE * 1.4426950408889634f;
  float pmax = p0[0]; for (int r = 1; r < 16; ++r) pmax = fmaxf(pmax, p0[r]); for (int r = 0; r < 16; ++r) pmax = fmaxf(pmax, p1[r]);
  { auto rr = __builtin_amdgcn_permlane32_swap(__float_as_uint(pmax), __float_as_uint(pmax), false, false);
    pmax = fmaxf(__uint_as_float(rr[0]), __uint_as_float(rr[1])); }
  if (__builtin_expect(__all(pmax - m_reg <= THR / SCALE), 1)) { mn = m_reg; alpha = 1.f; }
  else { mn = fmaxf(m_reg, pmax); alpha = __builtin_amdgcn_exp2f((m_reg - mn) * C); m_reg = mn; }
  float mnC = -mn * C;
  for (int r = 0; r < 16; ++r) p0[r] = fmaf(p0[r], C, mnC); for (int r = 0; r < 16; ++r) p1[r] = fmaf(p1[r], C, mnC);
  for (int r = 0; r < 16; ++r) p0[r] = __builtin_amdgcn_exp2f(p0[r]);
}
__device__ __forceinline__ void finishSM(f32x16& p0, f32x16& p1, float alpha, float& l_reg, bf16x8& pa0, bf16x8& pa1, bf16x8& pa2, bf16x8& pa3) {
  for (int r = 0; r < 16; ++r) p1[r] = __builtin_amdgcn_exp2f(p1[r]);
  float ps = 0; for (int r = 0; r < 16; ++r) ps += p0[r]; for (int r = 0; r < 16; ++r) ps += p1[r];
  { auto rr = __builtin_amdgcn_permlane32_swap(__float_as_uint(ps), __float_as_uint(ps), false, false);
    ps = __uint_as_float(rr[0]) + __uint_as_float(rr[1]); }
  l_reg = l_reg * alpha + ps;
#define PK4(P, BASE, OUT) do { unsigned a0 = cvtpk(P[BASE + 0], P[BASE + 1]), a1 = cvtpk(P[BASE + 2], P[BASE + 3]);   \
    unsigned b0 = cvtpk(P[BASE + 4], P[BASE + 5]), b1 = cvtpk(P[BASE + 6], P[BASE + 7]);                              \
    auto r0 = __builtin_amdgcn_permlane32_swap(a0, b0, false, false); auto r1 = __builtin_amdgcn_permlane32_swap(a1, b1, false, false); \
    u32x4 w = {r0[0], r1[0], r0[1], r1[1]}; OUT = *reinterpret_cast<bf16x8*>(&w); } while (0)
  PK4(p0, 0, pa0); PK4(p0, 8, pa1); PK4(p1, 0, pa2); PK4(p1, 8, pa3);
#undef PK4
}
__device__ __forceinline__ void qkt(f32x16& p0, f32x16& p1, const bf16_t* Ks, const bf16x8* qr, int r32, int hi) {
  p0 = f32x16{}; p1 = f32x16{};
  for (int d0 = 0; d0 < 8; ++d0) { int cb = (d0 * 16 + hi * 8) * 2;
    bf16x8 b0 = *reinterpret_cast<const bf16x8*>((const char*)Ks + KSWZ(r32, cb));
    bf16x8 b1 = *reinterpret_cast<const bf16x8*>((const char*)Ks + KSWZ(32 + r32, cb));
    p0 = __builtin_amdgcn_mfma_f32_32x32x16_bf16(b0, qr[d0], p0, 0, 0, 0);
    p1 = __builtin_amdgcn_mfma_f32_32x32x16_bf16(b1, qr[d0], p1, 0, 0, 0); }
}
__device__ __forceinline__ int v_st(int k, int c) { const int kk = (k & ~0xC) | ((k & 4) << 1) | ((k & 8) >> 1); return ((kk >> 3) * 4 + (c >> 5)) * 512 + ((kk & 7) * 32 + (c & 31)) * 2; }
__device__ __forceinline__ int v_rd_base(int lane) { return ((lane & 3) << 3) | (((lane >> 2) & 3) << 6) | (((lane >> 4) & 1) << 5) | (((lane >> 5) & 1) << 8); }
constexpr int v_rd_off(int d0, int ks, int half) { return d0 * 512 + ks * 4096 + half * 2048; }
template <int OFF> __device__ __forceinline__ s16x4 tr_read(int vb) {
  s16x4 r; asm volatile("ds_read_b64_tr_b16 %0, %1 offset:%2" : "=&v"(r) : "v"(vb), "i"(OFF) : "memory"); return r;
}
template <int D0> __device__ __forceinline__ void pv_one(f32x16& od, int vb, bf16x8 pa0, bf16x8 pa1, bf16x8 pa2, bf16x8 pa3) {
  const s16x4 l0 = tr_read<v_rd_off(D0, 0, 0)>(vb), h0 = tr_read<v_rd_off(D0, 0, 1)>(vb), l1 = tr_read<v_rd_off(D0, 1, 0)>(vb), h1 = tr_read<v_rd_off(D0, 1, 1)>(vb);
  const s16x4 l2 = tr_read<v_rd_off(D0, 2, 0)>(vb), h2 = tr_read<v_rd_off(D0, 2, 1)>(vb), l3 = tr_read<v_rd_off(D0, 3, 0)>(vb), h3 = tr_read<v_rd_off(D0, 3, 1)>(vb);
  asm volatile("s_waitcnt lgkmcnt(0)" ::: "memory"); SBAR();
#define PK(L, H) (bf16x8){L[0], L[1], L[2], L[3], H[0], H[1], H[2], H[3]}
  od = __builtin_amdgcn_mfma_f32_32x32x16_bf16(pa0, PK(l0, h0), od, 0, 0, 0);
  od = __builtin_amdgcn_mfma_f32_32x32x16_bf16(pa1, PK(l1, h1), od, 0, 0, 0);
  od = __builtin_amdgcn_mfma_f32_32x32x16_bf16(pa2, PK(l2, h2), od, 0, 0, 0);
  od = __builtin_amdgcn_mfma_f32_32x32x16_bf16(pa3, PK(l3, h3), od, 0, 0, 0);
#undef PK
}
__device__ __forceinline__ void pv_d0(f32x16* o, int vb, bf16x8 pa0, bf16x8 pa1, bf16x8 pa2, bf16x8 pa3) {
  pv_one<0>(o[0], vb, pa0, pa1, pa2, pa3); pv_one<1>(o[1], vb, pa0, pa1, pa2, pa3); pv_one<2>(o[2], vb, pa0, pa1, pa2, pa3); pv_one<3>(o[3], vb, pa0, pa1, pa2, pa3);
}
__device__ __forceinline__ void attn_dense_body(const bf16_t* __restrict__ Qb, const bf16_t* __restrict__ Kh, const bf16_t* __restrict__ Vh,
                                                bf16_t* __restrict__ Ob, int ldo, int seq, char* lds, const int tid) {
  const int wid = tid >> 6, lane = tid & 63, r32 = lane & 31, hi = lane >> 5;
  bf16_t* V_lds = (bf16_t*)lds; bf16_t* K_lds = (bf16_t*)(lds + 2 * SHM_V);
  float* ws = (float*)(lds + 2 * SHM_V + 2 * SHM_K) + wid * 64; float* li_l = ws; float* al_l = ws + 32;
  float m_reg = -1e30f, l_reg = 0; f32x16 o[4] = {}; bf16x8 qr[8];
  const bf16_t* Qw = Qb + (long)(wid * QBLK + r32) * LDQ + hi * 8;
#pragma unroll
  for (int d0 = 0; d0 < 8; ++d0) qr[d0] = ld8(Qw + d0 * 16);
  const int sr = tid >> 4, sc = (tid & 15) * 8, vst0 = v_st(sr, sc), vst1 = v_st(32 + sr, sc);
  const int vb0 = (int)(uintptr_t)V_lds + v_rd_base(lane);
  struct { bf16x8 vs0, vs1, ks0, ks1; } sr_[2];
#define SLOAD(i, k0) do { sr_[i].vs0 = ld8(&Vh[(long)((k0) + sr) * LDK + sc]); sr_[i].vs1 = ld8(&Vh[(long)((k0) + 32 + sr) * LDK + sc]); \
    sr_[i].ks0 = ld8(&Kh[(long)((k0) + sr) * LDK + sc]); sr_[i].ks1 = ld8(&Kh[(long)((k0) + 32 + sr) * LDK + sc]); } while (0)
#define SWRITE(b, i) do { *(bf16x8*)((char*)V_lds + (b) * SHM_V + vst0) = sr_[i].vs0;          \
    *(bf16x8*)((char*)V_lds + (b) * SHM_V + vst1) = sr_[i].vs1; int kc = sc * 2;               \
    *(bf16x8*)((char*)K_lds + (b) * SHM_K + KSWZ(sr, kc)) = sr_[i].ks0;                       \
    *(bf16x8*)((char*)K_lds + (b) * SHM_K + KSWZ(32 + sr, kc)) = sr_[i].ks1; } while (0)
#define SWAIT() asm volatile("s_waitcnt vmcnt(4)" ::: "memory")
#define RESC(a) do { if (__any((a) < 1.f)) { if (hi == 0) al_l[r32] = (a); asm volatile("s_waitcnt lgkmcnt(0)" ::: "memory"); \
    for (int d = 0; d < 4; ++d) for (int r = 0; r < 16; ++r) o[d][r] *= al_l[crow(r, hi)]; } } while (0)
  f32x16 pA0, pA1, pB0, pB1; float mnA, mnB, alA, alB; bf16x8 pa0, pa1, pa2, pa3; const int NT = seq / KVBLK;
  constexpr int SE = 0, SO = 1;
  SLOAD(SE, 0); asm volatile("s_waitcnt vmcnt(0)" ::: "memory"); SWRITE(0, SE); __syncthreads();
  qkt(pA0, pA1, K_lds, qr, r32, hi); partialSM(pA0, pA1, m_reg, mnA, alA);
  SLOAD(SO, KVBLK); if (2 < NT) SLOAD(SE, 2 * KVBLK);
  SWAIT(); SWRITE(1, SO); __syncthreads();
  for (int j = 1; j + 1 < NT; j += 2) {
    SBAR(); qkt(pB0, pB1, (bf16_t*)((char*)K_lds + SHM_K), qr, r32, hi);
    finishSM(pA0, pA1, alA, l_reg, pa0, pa1, pa2, pa3); SBAR();
    SLOAD(SO, (j + 2) * KVBLK); SBAR();
    pv_d0(o, vb0, pa0, pa1, pa2, pa3); partialSM(pB0, pB1, m_reg, mnB, alB);
    __syncthreads(); SWAIT(); SWRITE(0, SE);
    RESC(alB); __syncthreads();
    SBAR(); qkt(pA0, pA1, K_lds, qr, r32, hi);
    finishSM(pB0, pB1, alB, l_reg, pa0, pa1, pa2, pa3); SBAR();
    if (j + 3 < NT) SLOAD(SE, (j + 3) * KVBLK); SBAR();
    pv_d0(o, vb0 + (int)SHM_V, pa0, pa1, pa2, pa3); partialSM(pA0, pA1, m_reg, mnA, alA);
    __syncthreads(); SWAIT(); SWRITE(1, SO);
    RESC(alA); __syncthreads();
  }
  SBAR(); qkt(pB0, pB1, (bf16_t*)((char*)K_lds + SHM_K), qr, r32, hi);
  finishSM(pA0, pA1, alA, l_reg, pa0, pa1, pa2, pa3); SBAR();
  pv_d0(o, vb0, pa0, pa1, pa2, pa3); partialSM(pB0, pB1, m_reg, mnB, alB);
  __syncthreads(); RESC(alB);
  finishSM(pB0, pB1, alB, l_reg, pa0, pa1, pa2, pa3); SBAR();
  pv_d0(o, vb0 + (int)SHM_V, pa0, pa1, pa2, pa3);
  if (hi == 0) li_l[r32] = l_reg; asm volatile("s_waitcnt lgkmcnt(0)" ::: "memory");
  float rli[16];
#pragma unroll
  for (int r = 0; r < 16; ++r) rli[r] = __builtin_amdgcn_rcpf(li_l[crow(r, hi)]);
  int wid_o = __builtin_amdgcn_readfirstlane(wid); asm volatile("" : "+s"(wid_o));
  bf16_t* Ow = Ob + (long)(wid_o * QBLK) * ldo;
  int lane_o = lane; asm volatile("" : "+v"(lane_o)); const int r32o = lane_o & 31, hio = lane_o >> 5;
#pragma unroll
  for (int r = 0; r < 16; ++r) { int orow = crow(r, hio);
    for (int d0 = 0; d0 < 4; ++d0) Ow[(long)orow * ldo + d0 * 32 + r32o] = f2bf(o[d0][r] * rli[r]); }
  __syncthreads();
#undef SLOAD
#undef SWRITE
#undef SWAIT
#undef RESC
}
}

struct Args { const float* in[N_IN]; float* out; unsigned char* ws; int ph_lo, ph_hi; };
struct Frame {
    LAS unsigned char* lds;
    unsigned char* ldsg;
    float* out; unsigned char* ws; unsigned* ctl;
    unsigned char* ws0; unsigned lds0;
    int tid, lane, wave, G, gw, NGW, bid;
    int wave0;
};
#define CAS __attribute__((address_space(4)))
__device__ __forceinline__ const float* inptr(int i) { const CAS char* k = (const CAS char*)__builtin_amdgcn_kernarg_segment_ptr(); return *(const float* const volatile CAS*)(k + 8 * i); }
constexpr int LDS_CTL = 64;
constexpr int LDS_REGION = 156 * 1024;
constexpr int LDS_BYTES = LDS_CTL + LDS_REGION;

__device__ __forceinline__ void frame_tid(Frame& F) { int t = F.wave0 * 64 + (int)__builtin_amdgcn_mbcnt_hi(~0u, __builtin_amdgcn_mbcnt_lo(~0u, 0u)); asm volatile("" : "+v"(t)); F.tid = t; F.lane = t & 63; F.wave = __builtin_amdgcn_readfirstlane(t >> 6);
    int bid = blockIdx.x; asm volatile("" : "+s"(bid)); F.bid = bid; F.gw = bid * NWAVES + F.wave;
    unsigned char* w = F.ws0; unsigned lb = F.lds0; asm volatile("" : "+s"(w), "+s"(lb));
    F.ws = w; F.ctl = (unsigned*)(w + WS_CTL); F.lds = (LAS unsigned char*)(uintptr_t)lb + LDS_CTL; F.ldsg = (unsigned char*)F.lds; }
template <typename T> __device__ __forceinline__ T* wsp(const Frame& F, size_t off) { return (T*)(F.ws + off); }

struct CvtItem { const float* src; unsigned ld_src; int f8; unsigned char* dst; };
__device__ __forceinline__ size_t wtile_off(int n, int kbyte, int kb) { return (size_t)(n >> 8) * 256u * (size_t)kb + (size_t)(kbyte >> 7) * 32768u + (size_t)(n & 255) * 128u + (size_t)(kbyte & 127); }
__device__ __forceinline__ void cvt_load(const CvtItem& c, f32x4* v, int lane) {
    const int r4 = lane >> 4, c4 = (lane & 15) * 4;
#pragma unroll
    for (int i = 0; i < 16; ++i) v[i] = __builtin_nontemporal_load((const f32x4*)(c.src + (size_t)(4 * i + r4) * c.ld_src + c4));
}
__device__ __forceinline__ void cvt_store(const CvtItem& c, const f32x4* v, LAS float* scr, int lane) {
    const int r4 = lane >> 4, c4 = (lane & 15) * 4;
#pragma unroll
    for (int i = 0; i < 16; ++i) { LAS float* q = scr + (4 * i + r4) * 65 + c4; q[0] = v[i].x; q[1] = v[i].y; q[2] = v[i].z; q[3] = v[i].w; }
    LDS_WAIT();
    const int cc = lane & 7;
    if (c.f8) {
#pragma unroll
        for (int j = 0; j < 8; ++j) { const int n = (lane >> 3) + 8 * j; const LAS float* t = scr + (8 * cc) * 65 + n;
            u32x2 o; o.x = pk4_fp8(t[0 * 65] * F8_WSCALE, t[1 * 65] * F8_WSCALE, t[2 * 65] * F8_WSCALE, t[3 * 65] * F8_WSCALE); o.y = pk4_fp8(t[4 * 65] * F8_WSCALE, t[5 * 65] * F8_WSCALE, t[6 * 65] * F8_WSCALE, t[7 * 65] * F8_WSCALE);
            *(u32x2*)(c.dst + (size_t)n * 128 + 8 * cc) = o; }
    } else {
#pragma unroll
        for (int j = 0; j < 8; ++j) { const int n = (lane >> 3) + 8 * j; const LAS float* t = scr + (8 * cc) * 65 + n;
            u32x4 o; o.x = pk2(t[0 * 65], t[1 * 65]); o.y = pk2(t[2 * 65], t[3 * 65]); o.z = pk2(t[4 * 65], t[5 * 65]); o.w = pk2(t[6 * 65], t[7 * 65]);
            *(u32x4*)(c.dst + (size_t)n * 128 + 16 * cc) = o; }
    }
    LDS_WAIT();
}
constexpr int TR_SCR = 64 * 65;
constexpr int CVT_NMIX = 16 * 96 + 4 * 16 * 16 + 4 * 8 * 16 + 16 * 16;
__device__ __forceinline__ int cvt_count(int l) { return CVT_NMIX + (((l & 1) == 0) ? (2 * 16 * 44 + 44 * 16) : NEXP * (2 * 16 * 56 + 56 * 16)); }
__device__ __forceinline__ CvtItem cvt_item(const Frame& F, int l, int r) {
    CvtItem c; constexpr int N1 = 16 * 96, N2 = 4 * 16 * 16, N3 = 4 * 8 * 16, N4 = 16 * 16;
    if (r < N1) { const int kb = r / 96, nb = r % 96; c.src = inptr(I_WIN) + (size_t)l * DM * INW + (size_t)(64 * kb) * INW + 64 * nb; c.ld_src = INW; c.f8 = 0; c.dst = wsp<unsigned char>(F, WS_WCAT) + wtile_off(64 * nb, 128 * kb, 2 * DM); return c; } r -= N1;
    if (r < N2) { const int i = r / 256, r2 = r % 256, kb = r2 / 16, nb = r2 % 16; c.src = inptr(I_WGATE) + (size_t)l * 4 * DM * DM + (size_t)i * DM * DM + (size_t)(64 * kb) * DM + 64 * nb; c.ld_src = DM; c.f8 = 1;
        c.dst = wsp<unsigned char>(F, WS_WG8) + wtile_off(i * 1024 + 64 * nb, 64 * kb, DM); return c; } r -= N2;
    if (r < N3) { const int i = r / 128, r2 = r % 128, kb = r2 / 16, nb = r2 % 16; c.src = inptr(I_WBR) + (size_t)l * 4 * 512 * DM + (size_t)i * 512 * DM + (size_t)(64 * kb) * DM + 64 * nb; c.ld_src = DM; c.f8 = 0;
        c.dst = wsp<unsigned char>(F, WS_WB) + wtile_off(i * 1024 + 64 * nb, 128 * kb, 1024); return c; } r -= N3;
    if (r < N4) { const int kb = r / 16, nb = r % 16; c.src = inptr(I_WO) + (size_t)l * DM * DM + (size_t)(64 * kb) * DM + 64 * nb; c.ld_src = DM; c.f8 = 0; c.dst = wsp<unsigned char>(F, WS_WO4) + wtile_off(64 * nb, 128 * kb, 2 * DM); return c; } r -= N4;
    unsigned char* W13 = wsp<unsigned char>(F, (l & 1) ? WS_W13 : WS_W13D); unsigned char* W2 = wsp<unsigned char>(F, (l & 1) ? WS_W2 : WS_W2D);
    const int i = l >> 1; c.f8 = 1;
    if ((l & 1) == 0) { constexpr int NA = 16 * 44;
        if (r < 2 * NA) { const int which = r / NA; r %= NA; const int kb = r / 44, nb = r % 44, n0 = 64 * nb, drow = (n0 >> 7) * 256 + (n0 & 127) + which * 128;
            c.src = inptr(which ? I_FW3 : I_FW1) + (size_t)i * DM * FFD + (size_t)(64 * kb) * FFD + n0; c.ld_src = FFD; c.dst = W13 + wtile_off(drow, 64 * kb, DM); return c; } r -= 2 * NA;
        { const int kb = r / 16, nb = r % 16; c.src = inptr(I_FW2) + (size_t)i * FFD * DM + (size_t)(64 * kb) * DM + 64 * nb; c.ld_src = DM; c.dst = W2 + wtile_off(64 * nb, 64 * kb, FFD); return c; }
    } else { constexpr int NA = 16 * 56, NC = 56 * 16;
        if (r < NEXP * 2 * NA) { const int e = r / (2 * NA); r %= 2 * NA; const int which = r / NA; r %= NA; const int kb = r / 56, nb = r % 56, n0 = 64 * nb, drow = e * 2 * FFE + (n0 >> 7) * 256 + (n0 & 127) + which * 128;
            c.src = inptr(which ? I_MW3 : I_MW1) + (size_t)(i * NEXP + e) * DM * FFE + (size_t)(64 * kb) * FFE + n0; c.ld_src = FFE; c.dst = W13 + wtile_off(drow, 64 * kb, DM); return c; } r -= NEXP * 2 * NA;
        { const int e = r / NC; r %= NC; const int kb = r / 16, nb = r % 16; c.src = inptr(I_MW2) + (size_t)(i * NEXP + e) * FFE * DM + (size_t)(64 * kb) * DM + 64 * nb; c.ld_src = DM; c.dst = W2 + wtile_off(e * DM + 64 * nb, 64 * kb, FFE); return c; }
    }
}
__device__ __forceinline__ void cvt_range(const Frame& F, int l, int i0, int i1, int b0) {
    if (F.bid < b0) return;
    LAS float* scr = (LAS float*)(F.lds) + F.wave * TR_SCR;
    const int stride = (256 - b0) * NWAVES; int it = i0 + (F.bid - b0) * NWAVES + F.wave; if (it >= i1) return;
    CvtItem cur = cvt_item(F, l, it); f32x4 v[16]; cvt_load(cur, v, F.lane);
    for (;;) {
        const int nx = it + stride; const bool has = nx < i1; CvtItem nxt = cur; f32x4 vn[16];
        if (has) { nxt = cvt_item(F, l, nx); cvt_load(nxt, vn, F.lane); }
        cvt_store(cur, v, scr, F.lane);
        if (!has) break;
        cur = nxt; it = nx;
#pragma unroll
        for (int i = 0; i < 16; ++i) v[i] = vn[i];
    }
}
constexpr int CVT_NF_D = 2 * 16 * 44 + 44 * 16, CVT_NF_M = NEXP * (2 * 16 * 56 + 56 * 16), CVT_D1 = 5000, CVT_A1 = 11000, CVT_B1 = 14800;
template <int K> __device__ __forceinline__ void cvt_ffn_share(const Frame& F, int l, int b0) {
    if ((l & 1) || l + 1 >= DEPTH) return;
    const int lo = K == 0 ? CVT_D1 : (K == 1 ? CVT_A1 : CVT_B1), hi = K == 0 ? CVT_A1 : (K == 1 ? CVT_B1 : CVT_NF_M);
    cvt_range(F, l + 1, CVT_NMIX + lo, CVT_NMIX + hi, b0);
}
__device__ __forceinline__ int cvt_e1(int l) { return (l & 1) ? CVT_D1 : CVT_NF_D; }

__device__ __forceinline__ void p0_mod(const Frame& F) {
    LAS float* act = (LAS float*)(F.lds);
    LAS float* red = act + 5 * 1024;
    const float* c = inptr(I_C); const float* cc = inptr(I_CCTX);
    for (int i = F.tid; i < 5 * 1024; i += NTHREADS) { const float v = (i < 4096) ? c[i] : cc[i - 4096]; act[i] = siluf_(v); }
    __syncthreads();
    float* MOD = wsp<float>(F, WS_MOD);
    for (int u = F.bid; u < DEPTH * 96; u += F.G) {
        const int l = u / 96, cg = u % 96, cl = F.tid & 63, ks = F.tid >> 6, col = cg * 64 + cl;
        const float* w = inptr(I_WMOD) + (size_t)l * DM * 6144 + col;
        float a0 = 0.f, a1 = 0.f, a2 = 0.f, a3 = 0.f, a4 = 0.f;
#pragma unroll 16
        for (int k = ks * 128; k < ks * 128 + 128; ++k) { const float wv = w[(size_t)k * 6144];
            a0 += act[k] * wv; a1 += act[1024 + k] * wv; a2 += act[2048 + k] * wv; a3 += act[3072 + k] * wv; a4 += act[4096 + k] * wv; }
        red[(ks * 5 + 0) * 64 + cl] = a0; red[(ks * 5 + 1) * 64 + cl] = a1; red[(ks * 5 + 2) * 64 + cl] = a2; red[(ks * 5 + 3) * 64 + cl] = a3; red[(ks * 5 + 4) * 64 + cl] = a4;
        __syncthreads();
        if (F.tid < 320) { const int j = F.tid >> 6, c2 = F.tid & 63; float s = inptr(I_BMOD)[(size_t)l * 6144 + cg * 64 + c2];
#pragma unroll
            for (int k2 = 0; k2 < 8; ++k2) s += red[(k2 * 5 + j) * 64 + c2];
            MOD[((size_t)l * 5 + j) * 6144 + cg * 64 + c2] = s; }
        __syncthreads();
    }
}

__device__ __forceinline__ void p0_filters(const Frame& F) {
    constexpr int NR = 96, HLD = 72;
    LAS float* FT = (LAS float*)(F.lds);
    LAS float* H1 = FT + NR * 33;
    LAS bf16_t* H2 = (LAS bf16_t*)(H1 + NR * 64);
    LAS float* W1 = (LAS float*)(H2 + 98 * HLD);
    LAS float* W2 = W1 + 33 * 64;
    LAS bf16_t* W3T = (LAS bf16_t*)(W2 + 64 * 64);
    bf16_t* GF = wsp<bf16_t>(F, WS_GF); float* GC = wsp<float>(F, WS_GC);
    const float min_decay = -3.0701134573253944f, max_decay = -15.350567286626972f;
    const int lane = F.lane, r32 = lane & 31, hi = lane >> 5;
    for (int u = F.bid; u < DEPTH * 64; u += F.G) {
        const int l = u / 64, q = u % 64; const bool hasctx = q < 16;
        const float* w1 = inptr(I_HW1) + (size_t)l * 33 * 64; const float* b1 = inptr(I_HB1) + l * 64; const float* w2 = inptr(I_HW2) + (size_t)l * 64 * 64; const float* b2 = inptr(I_HB2) + l * 64;
        const float* w3 = inptr(I_HW3) + (size_t)l * 64 * 2048; const float* fr0 = inptr(I_HFREQ) + l * 128; const float* fr1 = fr0 + 64;
        for (int i = F.tid; i < 33 * 64; i += NTHREADS) W1[i] = w1[i];
        for (int i = F.tid; i < 64 * 64; i += NTHREADS) W2[i] = w2[i];
        for (int idx = F.tid; idx < NR * 33; idx += NTHREADS) { const int R = idx / 33, f = idx % 33; const bool isctx = R >= 68;
            const int L = isctx ? NCTX : SEQ, p = isctx ? 16 * q + R - 68 : 64 * q + R;
            const float t = (float)p / (float)(L - 1); float v;
            if (f == 0) v = t; else { const int k = (f - 1) & 15; const float fk = 1e-4f + (float)k * ((15.0f - 1e-4f) / 15.0f); float qq = (float)p * fk / (float)L; qq -= floorf(qq);
                v = (f <= 16) ? __builtin_amdgcn_cosf(qq) : -__builtin_amdgcn_sinf(qq); }
            FT[idx] = v; }
        __syncthreads();
        for (int idx = F.tid; idx < NR * 64; idx += NTHREADS) { const int R = idx >> 6, jj = idx & 63; float sacc = b1[jj];
#pragma unroll 11
            for (int f = 0; f < 33; ++f) sacc += FT[R * 33 + f] * W1[f * 64 + jj];
            H1[idx] = __builtin_amdgcn_sinf(fr0[jj] * sacc * 0.15915494309189535f); }
        __syncthreads();
        for (int idx = F.tid; idx < NR * 64; idx += NTHREADS) { const int R = idx >> 6, jj = idx & 63; float sacc = b2[jj];
#pragma unroll 16
            for (int k = 0; k < 64; ++k) sacc += H1[R * 64 + k] * W2[k * 64 + jj];
            H2[R * HLD + jj] = f2bf(__builtin_amdgcn_sinf(fr1[jj] * sacc * 0.15915494309189535f)); }
        if (F.tid < 64) H2[NR * HLD + F.tid] = 0;
        __syncthreads();
#pragma unroll 1
        for (int r = 0; r < 4; ++r) {
            const int o = r >> 1, dir = r & 1;
            { const int j = F.tid + 512 * r; float wc[64];
#pragma unroll
              for (int k = 0; k < 64; ++k) wc[k] = w3[(size_t)k * 2048 + j];
#pragma unroll
              for (int k = 0; k < 64; k += 8) *(LAS u32x4*)(W3T + F.tid * HLD + k) = pack8(wc + k); }
            __syncthreads();
#pragma unroll 1
            for (int t2 = 0; t2 < 2; ++t2) {
                const int n0 = 32 * (2 * F.wave + t2), ch = n0 + r32, j = ch + 512 * r;
                f32x16 acc[3] = {};
                const LAS bf16_t* ap = H2 + (r32 + dir) * HLD + 8 * hi; const LAS bf16_t* bp = W3T + (n0 + r32) * HLD + 8 * hi;
#pragma unroll
                for (int k0 = 0; k0 < 64; k0 += 16) { const bf16x8 bv = *(const LAS bf16x8*)(bp + k0);
#pragma unroll
                    for (int mt = 0; mt < 3; ++mt) acc[mt] = __builtin_amdgcn_mfma_f32_32x32x16_bf16(*(const LAS bf16x8*)(ap + mt * 32 * HLD + k0), bv, acc[mt], 0, 0, 0); }
                const float adelta = fabsf(min_decay + (float)j * ((max_decay - min_decay) / 2047.0f));
                bf16_t* grow = GF + (((size_t)l * 2 + o) * 512 + ch) * 8192; float* crow_ = GC + (((size_t)l * 2 + o) * 512 + ch) * 512;
#pragma unroll
                for (int mt = 0; mt < 2; ++mt)
#pragma unroll
                    for (int g = 0; g < 4; ++g) { const int X = 64 * q + 32 * mt + 8 * g + 4 * hi; float v[4];
#pragma unroll
                        for (int e = 0; e < 4; ++e) { const int p = X + dir + e; v[e] = (p < SEQ) ? acc[mt][4 * g + e] * __expf(-(float)p * (1.f / (float)(SEQ - 1)) * adelta) : 0.f; }
                        u32x2 w; if (dir == 0) { w.x = pk2(v[0], v[1]); w.y = pk2(v[2], v[3]); *(u32x2*)(grow + 4096 + X) = w; }
                        else { w.x = pk2(v[3], v[2]); w.y = pk2(v[1], v[0]); *(u32x2*)(grow + 4092 - X) = w; } }
                if (hasctx) {
#pragma unroll
                    for (int g = 0; g < 3; ++g) { const int rr = 8 * g + 4 * hi; if (rr >= 4 && rr < 20) {
#pragma unroll
                        for (int e = 0; e < 4; ++e) { const int p = 16 * q + (rr - 4) + dir + e; const float val = (p < NCTX) ? acc[2][4 * g + e] * __expf(-(float)p * (1.f / (float)(NCTX - 1)) * adelta) : 0.f;
                            if (dir == 0) crow_[256 + p] = val; else crow_[256 - p] = val; } } } }
            }
            __syncthreads();
        }
    }
    if (F.bid == 0) { float* TB = wsp<float>(F, WS_ROPE);
        for (int idx = F.tid; idx < 64 * 32; idx += NTHREADS) { const int v = idx >> 5, k = idx & 31; const float inv = __builtin_amdgcn_exp2f(-(float)k * (13.287712379549449f / 32.0f)); const float rev = (float)v * inv * 0.15915494309189535f;
            TB[idx] = __builtin_amdgcn_cosf(rev); TB[2048 + idx] = __builtin_amdgcn_sinf(rev); } }
}

__device__ __forceinline__ void store_mod_row(const f32x4* v, const float* m0, const float* m1, bf16_t* orow, int lane) {
#pragma unroll
    for (int j = 0; j < 4; ++j) { const f32x4 a = *(const f32x4*)(m0 + 4 * lane + 256 * j), s = *(const f32x4*)(m1 + 4 * lane + 256 * j); const f32x4 u = v[j] * (s + 1.0f) + a;
        u32x2 w; w.x = pk2(u.x, u.y); w.y = pk2(u.z, u.w); *(u32x2*)(orow + 4 * lane + 256 * j) = w; }
}
__device__ __forceinline__ void store_mod_row8(const f32x4* v, const float* m0, const float* m1, unsigned char* orow, int lane) {
#pragma unroll
    for (int j = 0; j < 4; ++j) { const f32x4 a = *(const f32x4*)(m0 + 4 * lane + 256 * j), sc = *(const f32x4*)(m1 + 4 * lane + 256 * j); const f32x4 u = v[j] * (sc + 1.0f) + a;
        *(unsigned*)(orow + 4 * lane + 256 * j) = pk4_fp8(u.x, u.y, u.z, u.w); }
}
__device__ __forceinline__ int row_bsel(int row) { return row < T_LAT ? (row >> 12) : 4; }
__device__ __forceinline__ void p0b_rows(const Frame& F) {
    bf16_t* XF = wsp<bf16_t>(F, WS_XF); bf16_t* U = wsp<bf16_t>(F, WS_U); const float* MOD = wsp<float>(F, WS_MOD);
    f32x4 nv[4];
    if (F.gw < T_ALL) { const int row = F.gw; const float* src = row < T_LAT ? inptr(I_X) + (size_t)row * DM : inptr(I_CTX) + (size_t)(row - T_LAT) * DM;
#pragma unroll
        for (int j = 0; j < 4; ++j) nv[j] = *(const f32x4*)(src + 4 * F.lane + 256 * j); }
    for (int row = F.gw; row < T_ALL; row += F.NGW) {
        f32x4 v[4];
#pragma unroll
        for (int j = 0; j < 4; ++j) v[j] = nv[j];
        if (row + F.NGW < T_ALL) { const int r2 = row + F.NGW; const float* src = r2 < T_LAT ? inptr(I_X) + (size_t)r2 * DM : inptr(I_CTX) + (size_t)(r2 - T_LAT) * DM;
#pragma unroll
            for (int j = 0; j < 4; ++j) nv[j] = *(const f32x4*)(src + 4 * F.lane + 256 * j); }
#pragma unroll
        for (int j = 0; j < 4; ++j) *(u32x2*)(XF + (size_t)row * DM + 4 * F.lane + 256 * j) = f32_bf4(v[j]);
        const float* m = MOD + (size_t)row_bsel(row) * 6144;
        store_mod_row(v, m, m + 1024, U + (size_t)row * DM, F.lane);
        store_mod_row8(v, m, m + 1024, wsp<unsigned char>(F, WS_U8M) + (size_t)row * DM, F.lane);
    }
}
__device__ __forceinline__ void ln_row(f32x4* v, const float* g, const float* b, int lane) {
    float s = 0.f;
#pragma unroll
    for (int j = 0; j < 4; ++j) s += (v[j].x + v[j].y) + (v[j].z + v[j].w);
    const float mean = wave_sum(s, lane) * (1.f / DM); float s2 = 0.f;
#pragma unroll
    for (int j = 0; j < 4; ++j) { v[j] = v[j] - mean; s2 += (v[j].x * v[j].x + v[j].y * v[j].y) + (v[j].z * v[j].z + v[j].w * v[j].w); }
    const float rstd = rsqrtf(wave_sum(s2, lane) * (1.f / DM) + LN_EPS);
#pragma unroll
    for (int j = 0; j < 4; ++j) { const f32x4 gg = *(const f32x4*)(g + 4 * lane + 256 * j), bb = *(const f32x4*)(b + 4 * lane + 256 * j); v[j] = v[j] * rstd * gg + bb; }
}

__device__ __forceinline__ u32x4 ldg8(const bf16_t* p) { return *(const u32x4*)p; }
struct TokRaw { u32x4 bg, c0, x0, cm, xm, cp, xp, q, kv; float cs[8], sn[8]; };
__device__ __forceinline__ void tok_load(const bf16_t* ZG, const float* TBC, const float* TBS, int tok, bool need_ctx, int c8, int axis, int kf0, TokRaw& r) {
    const bool isctx = tok >= T_LAT; const int t = isctx ? (tok - T_LAT) & 255 : tok & 4095, Ls = isctx ? NCTX : SEQ;
    const bf16_t* zr = ZG + (size_t)tok * ZGW; const u32x4 z4 = {0u, 0u, 0u, 0u};
    if (!isctx || need_ctx) {
        r.bg = ldg8(zr + c8); r.c0 = ldg8(zr + 512 + c8); r.x0 = ldg8(zr + 1024 + c8);
        if (t > 0) { r.cm = ldg8(zr - ZGW + 512 + c8); r.xm = ldg8(zr - ZGW + 1024 + c8); } else { r.cm = z4; r.xm = z4; }
        if (t < Ls - 1) { r.cp = ldg8(zr + ZGW + 512 + c8); r.xp = ldg8(zr + ZGW + 1024 + c8); } else { r.cp = z4; r.xp = z4; }
        r.q = ldg8(zr + OFF_D + c8);
    } else { r.bg = z4; r.c0 = z4; r.x0 = z4; r.cm = z4; r.xm = z4; r.cp = z4; r.xp = z4; r.q = z4; }
    r.kv = ldg8(zr + OFF_D + 512 + c8);
    const int v = axis ? (t & 63) : (t >> 6);
#pragma unroll
    for (int e = 0; e < 8; ++e) { r.cs[e] = isctx ? 1.f : TBC[v * 32 + kf0 + e]; r.sn[e] = isctx ? 0.f : TBS[v * 32 + kf0 + e]; }
}
__device__ __forceinline__ void ph2_tokens(const Frame& F, int l, bool need_ctx) {
    const bf16_t* ZG = wsp<bf16_t>(F, WS_ZG); bf16_t* Y = wsp<bf16_t>(F, WS_Y);
    bf16_t* QP = wsp<bf16_t>(F, WS_QP); bf16_t* QC = wsp<bf16_t>(F, WS_QC); bf16_t* KALL = wsp<bf16_t>(F, WS_KALL); bf16_t* VALL = wsp<bf16_t>(F, WS_VALL);
    const float* TBC = wsp<float>(F, WS_ROPE); const float* TBS = TBC + 2048;
    const int lane = F.lane, c8 = 8 * lane, cc = lane & 15;
    float w0[8], w1[8], w2[8], cb[8], gq[8], gk[8];
    { const float* caw = inptr(I_CAW) + (size_t)l * 3 * 512; const float* cab = inptr(I_CAB) + (size_t)l * 512;
#pragma unroll
      for (int e = 0; e < 8; ++e) { w0[e] = caw[c8 + e]; w1[e] = caw[512 + c8 + e]; w2[e] = caw[1024 + c8 + e]; cb[e] = cab[c8 + e];
          gq[e] = inptr(I_QN)[l * 128 + 8 * cc + e]; gk[e] = inptr(I_KN)[l * 128 + 8 * cc + e]; } }
    const int axis = cc >> 3, half = (cc >> 2) & 1, kf0 = 8 * (cc & 3);
    const int tok_b = F.gw < 256 ? F.gw * 6 : 1536 + (F.gw - 256) * 9, tok_e0 = tok_b + (F.gw < 256 ? 6 : 9), tok_e = tok_e0 < T_ALL ? tok_e0 : T_ALL;
    if (tok_b >= tok_e) return;
    TokRaw cur; tok_load(ZG, TBC, TBS, tok_b, need_ctx, c8, axis, kf0, cur);
    for (int tok = tok_b; tok < tok_e; ++tok) {
        TokRaw nxt = cur; if (tok + 1 < tok_e) tok_load(ZG, TBC, TBS, tok + 1, need_ctx, c8, axis, kf0, nxt);
        const bool isctx = tok >= T_LAT; const int b = isctx ? (tok - T_LAT) >> 8 : tok >> 12, t = isctx ? (tok - T_LAT) & 255 : tok & 4095;
        if (!isctx || need_ctx) {
            float bg[8], c0[8], x0[8], cm[8], xm[8], cp[8], xp[8];
            unpack8(cur.bg, bg); unpack8(cur.c0, c0); unpack8(cur.x0, x0); unpack8(cur.cm, cm); unpack8(cur.xm, xm); unpack8(cur.cp, cp); unpack8(cur.xp, xp);
            float y[8];
#pragma unroll
            for (int e = 0; e < 8; ++e) y[e] = bg[e] * (w0[e] * (cm[e] * xm[e]) + w1[e] * (c0[e] * x0[e]) + w2[e] * (cp[e] * xp[e]) + cb[e]);
            *(u32x4*)(Y + (size_t)tok * YW + c8) = pack8(y);
        }
        if (!isctx || need_ctx) {
            float q[8]; unpack8(cur.q, q);
            float ss = 0.f;
#pragma unroll
            for (int e = 0; e < 8; ++e) ss += q[e] * q[e];
            ss += shfl_xor_l(ss, 1, lane); ss += shfl_xor_l(ss, 2, lane); ss += shfl_xor_l(ss, 4, lane); ss += shfl_xor_l(ss, 8, lane);
            const float r = rsqrtf(ss * (1.f / 128.f) + 1e-6f);
            float o[8];
#pragma unroll
            for (int e = 0; e < 8; ++e) { q[e] = q[e] * r * gq[e]; }
#pragma unroll
            for (int e = 0; e < 8; ++e) { const float pr = shfl_xor_l(q[e], 4, lane); o[e] = half ? (q[e] * cur.cs[e] + pr * cur.sn[e]) : (q[e] * cur.cs[e] - pr * cur.sn[e]); }
            const int head = lane >> 4;
            bf16_t* dst = isctx ? QC + ((size_t)(b * 4 + head) * NCTX + t) * 128 + 8 * cc : QP + ((size_t)(b * 4 + head) * SEQ + t) * 128 + 8 * cc;
            *(u32x4*)dst = pack8(o);
        }
        { const u32x4 raw = cur.kv; float k[8]; unpack8(raw, k);
            float ss = 0.f;
#pragma unroll
            for (int e = 0; e < 8; ++e) ss += k[e] * k[e];
            ss += shfl_xor_l(ss, 1, lane); ss += shfl_xor_l(ss, 2, lane); ss += shfl_xor_l(ss, 4, lane); ss += shfl_xor_l(ss, 8, lane);
            const float r = rsqrtf(ss * (1.f / 128.f) + 1e-6f);
            float o[8];
#pragma unroll
            for (int e = 0; e < 8; ++e) k[e] = k[e] * r * gk[e];
#pragma unroll
            for (int e = 0; e < 8; ++e) { const float pr = shfl_xor_l(k[e], 4, lane); o[e] = half ? (k[e] * cur.cs[e] + pr * cur.sn[e]) : (k[e] * cur.cs[e] - pr * cur.sn[e]); }
            const int hh = (lane >> 4) & 1, pos = isctx ? SEQ + t : t; const size_t off = ((size_t)(b * 2 + hh) * 4352 + pos) * 128 + 8 * cc;
            if (lane < 32) *(u32x4*)(KALL + off) = pack8(o); else *(u32x4*)(VALL + off) = raw; }
        cur = nxt;
    }
}
__device__ __forceinline__ void tr64_write(LAS unsigned char* tile, int row, int ck, u32x4 w) { *(LAS u32x4*)(tile + row * 128 + ((ck ^ ((row >> 3) & 7)) << 4)) = w; }
__device__ __forceinline__ u32x4 tr64_read(const LAS unsigned char* tile, int col, int tk) {
    unsigned short e[8];
#pragma unroll
    for (int i = 0; i < 8; ++i) e[i] = *(const LAS unsigned short*)(tile + (8 * tk + i) * 128 + ((((col >> 3) ^ tk) & 7) << 4) + (col & 7) * 2);
    u32x4 w; w.x = e[0] | ((unsigned)e[1] << 16); w.y = e[2] | ((unsigned)e[3] << 16); w.z = e[4] | ((unsigned)e[5] << 16); w.w = e[6] | ((unsigned)e[7] << 16); return w;
}
__device__ __forceinline__ void ph2_htrans(const Frame& F) {
    const bf16_t* ZG = wsp<bf16_t>(F, WS_ZG); bf16_t* ZHT = wsp<bf16_t>(F, WS_ZHT); bf16_t* ZHTC = wsp<bf16_t>(F, WS_ZHTC);
    LAS unsigned char* tile = F.lds + F.wave * 8192;
    const int lane = F.lane, rr = lane >> 3, ck = lane & 7;
    u32x4 nx[8];
    if (F.gw < 272 * 24) { const int tb = F.gw / 24, cbk = F.gw % 24, tok0 = tb * 64;
#pragma unroll
        for (int r = 0; r < 8; ++r) nx[r] = ldg8(ZG + (size_t)(tok0 + rr + 8 * r) * ZGW + OFF_H + cbk * 64 + 8 * ck); }
    for (int it = F.gw; it < 272 * 24; it += F.NGW) {
        const int tb = it / 24, cbk = it % 24, tok0 = tb * 64;
#pragma unroll
        for (int r = 0; r < 8; ++r) { const int row = rr + 8 * r; tr64_write(tile, row, ck, nx[r]); }
        if (it + F.NGW < 272 * 24) { const int it2 = it + F.NGW, tb2 = it2 / 24, cbk2 = it2 % 24, tok2 = tb2 * 64;
#pragma unroll
            for (int r = 0; r < 8; ++r) nx[r] = ldg8(ZG + (size_t)(tok2 + rr + 8 * r) * ZGW + OFF_H + cbk2 * 64 + 8 * ck); }
        LDS_WAIT();
        const bool isctx = tok0 >= T_LAT; const int b = isctx ? (tok0 - T_LAT) >> 8 : tok0 >> 12, t0 = isctx ? (tok0 - T_LAT) & 255 : tok0 & 4095;
#pragma unroll
        for (int r = 0; r < 8; ++r) { const int ch = rr + 8 * r; const u32x4 w = tr64_read(tile, ch, ck);
            bf16_t* dst = isctx ? ZHTC + ((size_t)(b * 1536 + cbk * 64 + ch) * NCTX + t0 + 8 * ck) : ZHT + ((size_t)(b * 1536 + cbk * 64 + ch) * SEQ + t0 + 8 * ck);
            *(u32x4*)dst = w; }
        LDS_WAIT();
    }
}
__device__ __forceinline__ void ph3b_ytrans(const Frame& F, bool need_ctx) {
    bf16_t* Y = wsp<bf16_t>(F, WS_Y); const bf16_t* YHT = wsp<bf16_t>(F, WS_YHT); const bf16_t* YHTC = wsp<bf16_t>(F, WS_YHTC);
    LAS unsigned char* tile = F.lds + F.wave * 8192;
    const int lane = F.lane, rr = lane >> 3, ck = lane & 7;
    const int ntb = need_ctx ? 272 : 256;
    const int skip = need_ctx ? 32 : 0; if (F.bid < skip) return;
    const int it0 = F.gw - skip * NWAVES, step = F.NGW - skip * NWAVES;
#define YT_LOAD(itx) do { const int tb_ = (itx) / 8, cbk_ = (itx) % 8, tok_ = tb_ * 64; const bool ic_ = tok_ >= T_LAT; const int b_ = ic_ ? (tok_ - T_LAT) >> 8 : tok_ >> 12, t_ = ic_ ? (tok_ - T_LAT) & 255 : tok_ & 4095; \
        _Pragma("unroll") for (int r = 0; r < 8; ++r) { const int ch = rr + 8 * r; \
            nx[r] = ldg8(ic_ ? YHTC + ((size_t)(b_ * 512 + cbk_ * 64 + ch) * NCTX + t_ + 8 * ck) : YHT + ((size_t)(b_ * 512 + cbk_ * 64 + ch) * SEQ + t_ + 8 * ck)); } } while (0)
    u32x4 nx[8];
    if (it0 < ntb * 8) YT_LOAD(it0);
    for (int it = it0; it < ntb * 8; it += step) {
        const int tb = it / 8, cbk = it % 8, tok0 = tb * 64;
#pragma unroll
        for (int r = 0; r < 8; ++r) tr64_write(tile, rr + 8 * r, ck, nx[r]);
        if (it + step < ntb * 8) YT_LOAD(it + step);
        LDS_WAIT();
#pragma unroll
        for (int r = 0; r < 8; ++r) { const int row = rr + 8 * r; *(u32x4*)(Y + (size_t)(tok0 + row) * YW + 1024 + cbk * 64 + 8 * ck) = tr64_read(tile, row, ck); }
        LDS_WAIT();
    }
#undef YT_LOAD
}

constexpr int RLD = 136;
constexpr int RREG = 128 * RLD * 2;
__device__ __forceinline__ void mma_nt128(f32x16& acc, const LAS bf16_t* A, int m0, const LAS bf16_t* Bt, int n0, int r32, int hi) {
    const LAS bf16_t* ap = A + (m0 + r32) * RLD + 8 * hi; const LAS bf16_t* bp = Bt + (n0 + r32) * RLD + 8 * hi;
#pragma unroll
    for (int k0 = 0; k0 < 128; k0 += 16) { const bf16x8 a = *(const LAS bf16x8*)(ap + k0); const bf16x8 b = *(const LAS bf16x8*)(bp + k0);
        acc = __builtin_amdgcn_mfma_f32_32x32x16_bf16(a, b, acc, 0, 0, 0); }
}
__device__ __forceinline__ void mma_nt128x2(f32x16& c0, f32x16& c1, const LAS bf16_t* A, int m0, const LAS bf16_t* Bt, int n0, int r32, int hi) {
    const LAS bf16_t* ap = A + (m0 + r32) * RLD + 8 * hi; const LAS bf16_t* bp = Bt + (n0 + r32) * RLD + 8 * hi;
#pragma unroll 2
    for (int k0 = 0; k0 < 128; k0 += 16) { const bf16x8 a = *(const LAS bf16x8*)(ap + k0); const bf16x8 b0 = *(const LAS bf16x8*)(bp + k0); const bf16x8 b1 = *(const LAS bf16x8*)(bp + 32 * RLD + k0);
        c0 = __builtin_amdgcn_mfma_f32_32x32x16_bf16(a, b0, c0, 0, 0, 0); c1 = __builtin_amdgcn_mfma_f32_32x32x16_bf16(a, b1, c1, 0, 0, 0); }
}
__device__ __forceinline__ int ret_tok0(int b, int n) { return n < 2 ? T_LAT + b * NCTX + n * 128 : b * SEQ + (n - 2) * 128; }
__device__ __forceinline__ void ph2_retkv(const Frame& F, int l) {
    bf16_t* ZG = wsp<bf16_t>(F, WS_ZG); float* KVS = wsp<float>(F, WS_KVS);
    const float* TBC = wsp<float>(F, WS_ROPE); const float* TBS = TBC + 2048;
    LAS bf16_t* VT = (LAS bf16_t*)(F.lds); LAS bf16_t* KF = (LAS bf16_t*)(F.lds + RREG); LAS bf16_t* KB = (LAS bf16_t*)(F.lds + 2 * RREG);
    const int tid = F.tid, lane = F.lane, r32 = lane & 31, hi = lane >> 5, w = F.wave;
    u32x4 raw[2][6];
#define RKV_LOAD(itx) do { const int b_ = (itx) / (4 * NCH), h_ = ((itx) / NCH) & 3, n_ = (itx) % NCH, tk_ = ret_tok0(b_, n_); \
        _Pragma("unroll") for (int r = 0; r < 2; ++r) { const int idx = tid + 512 * r, j = idx & 127, pp = idx >> 7, cc = (pp & 3) + 8 * (pp >> 2); \
            const bf16_t* zr = ZG + (size_t)(tk_ + j) * ZGW + OFF_R + h_ * 128 + 8 * cc; \
            raw[r][0] = ldg8(zr); raw[r][1] = ldg8(zr + 32); raw[r][2] = ldg8(zr + 512); raw[r][3] = ldg8(zr + 512 + 32); raw[r][4] = ldg8(zr + 1024); raw[r][5] = ldg8(zr + 1024 + 32); } } while (0)
    if (F.bid < NBATCH * 4 * NCH) RKV_LOAD(F.bid);
    for (int it = F.bid; it < NBATCH * 4 * NCH; it += F.G) {
        const int b = it / (4 * NCH), h = (it / NCH) & 3, n = it % NCH, tok0 = ret_tok0(b, n); const bool lat = n >= 2;
        const float lgf = -__expf(inptr(I_RDEC)[l * 8 + h]), lgb = -__expf(inptr(I_RDEC)[l * 8 + 4 + h]);
#pragma unroll 2
        for (int r = 0; r < 2; ++r) {
            const int idx = tid + 512 * r, j = idx & 127, pp = idx >> 7, cc = (pp & 3) + 8 * (pp >> 2);
            bf16_t* zr = ZG + (size_t)(tok0 + j) * ZGW + OFF_R + h * 128 + 8 * cc;
            float q1[8], q2[8], k1[8], k2[8]; unpack8(raw[r][0], q1); unpack8(raw[r][1], q2); unpack8(raw[r][2], k1); unpack8(raw[r][3], k2);
            const u32x4 v1raw = raw[r][4], v2raw = raw[r][5];
            const int axis = cc >> 3, kf0 = 8 * (cc & 3), p = lat ? (n - 2) * 128 + j : 0, v = axis ? (p & 63) : (p >> 6);
            float qo1[8], qo2[8], ko1[8], ko2[8];
#pragma unroll
            for (int e = 0; e < 8; ++e) { const float cs = lat ? TBC[v * 32 + kf0 + e] : 1.f, sn = lat ? TBS[v * 32 + kf0 + e] : 0.f;
                qo1[e] = q1[e] * cs - q2[e] * sn; qo2[e] = q2[e] * cs + q1[e] * sn;
                ko1[e] = (k1[e] * cs - k2[e] * sn) * 0.08838834764831845f; ko2[e] = (k2[e] * cs + k1[e] * sn) * 0.08838834764831845f; }
            if (lat) { *(u32x4*)zr = pack8(qo1); *(u32x4*)(zr + 32) = pack8(qo2); }
            const u32x4 kp1 = pack8(ko1), kp2 = pack8(ko2); *(u32x4*)(zr + 512) = kp1; *(u32x4*)(zr + 512 + 32) = kp2;
            float kr1[8], kr2[8]; unpack8(kp1, kr1); unpack8(kp2, kr2);
            const float df = __expf(lgf * (float)(127 - j)), db = __expf(lgb * (float)j);
            const bf16_t va[8] = {(bf16_t)(v1raw.x & 0xffff), (bf16_t)(v1raw.x >> 16), (bf16_t)(v1raw.y & 0xffff), (bf16_t)(v1raw.y >> 16), (bf16_t)(v1raw.z & 0xffff), (bf16_t)(v1raw.z >> 16), (bf16_t)(v1raw.w & 0xffff), (bf16_t)(v1raw.w >> 16)};
            const bf16_t vb[8] = {(bf16_t)(v2raw.x & 0xffff), (bf16_t)(v2raw.x >> 16), (bf16_t)(v2raw.y & 0xffff), (bf16_t)(v2raw.y >> 16), (bf16_t)(v2raw.z & 0xffff), (bf16_t)(v2raw.z >> 16), (bf16_t)(v2raw.w & 0xffff), (bf16_t)(v2raw.w >> 16)};
#pragma unroll
            for (int e = 0; e < 8; ++e) { const int d1 = 8 * cc + e, d2 = d1 + 32;
                VT[d1 * RLD + j] = va[e]; KF[d1 * RLD + j] = f2bf(kr1[e] * df); KB[d1 * RLD + j] = f2bf(kr1[e] * db);
                VT[d2 * RLD + j] = vb[e]; KF[d2 * RLD + j] = f2bf(kr2[e] * df); KB[d2 * RLD + j] = f2bf(kr2[e] * db); }
        }
        if (it + F.G < NBATCH * 4 * NCH) RKV_LOAD(it + F.G);
        __syncthreads();
        { const int dir = w >> 2, mt = w & 3; const LAS bf16_t* KX = dir ? KB : KF;
            f32x16 acc[4] = {};
#pragma unroll
            for (int nt = 0; nt < 4; ++nt) mma_nt128(acc[nt], VT, 32 * mt, KX, 32 * nt, r32, hi);
            float* dst = KVS + (((size_t)(b * 4 + h) * 2 + dir) * NCH + n) * 16384;
#pragma unroll
            for (int nt = 0; nt < 4; ++nt)
#pragma unroll
                for (int r = 0; r < 16; ++r) dst[(32 * mt + crow(r, hi)) * 128 + 32 * nt + r32] = acc[nt][r]; }
        __syncthreads();
    }
#undef RKV_LOAD
}
__device__ __forceinline__ void ret_scan_item(const Frame& F, int l, int item) {
    float* KVS = wsp<float>(F, WS_KVS);
    const int combo = item >> 3, part = item & 7, dir = combo & 1, h = (combo >> 1) & 3;
    const float lg = -__expf(inptr(I_RDEC)[l * 8 + dir * 4 + h]); const float cd = __expf(lg * 128.f);
    float* base = KVS + (size_t)combo * NCH * 16384 + part * 2048 + F.tid * 4;
    bf16_t* baseb = wsp<bf16_t>(F, WS_U) + (size_t)combo * NCH * 16384 + part * 2048 + F.tid * 4;
    float z0 = 0.f; asm volatile("" : "+v"(z0));
    f32x4 s = {z0, z0, z0, z0};
    f32x4 kv[34];
#pragma unroll
    for (int t = 0; t < 34; ++t) { const int n = dir ? (t < 2 ? 1 - t : 35 - t) : t; kv[t] = *(const f32x4*)(base + (size_t)n * 16384); }
#pragma unroll
    for (int t = 0; t < 34; ++t) { const int n = dir ? (t < 2 ? 1 - t : 35 - t) : t; { u32x2 o; o.x = pk2(s.x, s.y); o.y = pk2(s.z, s.w); *(u32x2*)(baseb + (size_t)n * 16384) = o; } s = s * cd + kv[t]; }
}
struct RetPre { u32x4 q[4], k[4], v[4]; };
__device__ __forceinline__ void ret_out_load(const Frame& F, int it, RetPre& p) {
    const bf16_t* ZG = wsp<bf16_t>(F, WS_ZG); const int tid = F.tid;
    const int b = it / (4 * NCH), h = (it / NCH) & 3, n = it % NCH, tok0 = ret_tok0(b, n);
#pragma unroll
    for (int r = 0; r < 4; ++r) { const int cidx = tid + 512 * r, j = cidx >> 4, cc = cidx & 15;
        const bf16_t* zr = ZG + (size_t)(tok0 + j) * ZGW + OFF_R + h * 128 + 8 * cc; p.q[r] = ldg8(zr); p.k[r] = ldg8(zr + 512);
        const int j2 = cidx & 127, c2 = cidx >> 7; p.v[r] = ldg8(ZG + (size_t)(tok0 + j2) * ZGW + OFF_R + 1024 + h * 128 + 8 * c2); }
}
__device__ __forceinline__ void ret_out_item(const Frame& F, int l, int it, RetPre& pre, int it_next) {
    const bf16_t* ZG = wsp<bf16_t>(F, WS_ZG); const bf16_t* KVB = wsp<bf16_t>(F, WS_U); bf16_t* Y = wsp<bf16_t>(F, WS_Y);
    LAS bf16_t* RQ = (LAS bf16_t*)(F.lds); LAS bf16_t* RK = (LAS bf16_t*)(F.lds + RREG); LAS bf16_t* RV = (LAS bf16_t*)(F.lds + 2 * RREG); LAS bf16_t* RP = (LAS bf16_t*)(F.lds + 3 * RREG);
    LAS float* OF = (LAS float*)(F.lds);
    int lane_i = F.lane; asm volatile("" : "+v"(lane_i));
    const int tid = F.tid, lane = lane_i, r32 = lane & 31, hi = lane >> 5, w = F.wave;
    const int b = it / (4 * NCH), h = (it / NCH) & 3, n = it % NCH, tok0 = ret_tok0(b, n);
    const float lgf = -__expf(inptr(I_RDEC)[l * 8 + h]), lgb = -__expf(inptr(I_RDEC)[l * 8 + 4 + h]);
#pragma unroll
    for (int r = 0; r < 4; ++r) {
        const int cidx = tid + 512 * r, j = cidx >> 4, cc = cidx & 15;
        *(LAS u32x4*)(RQ + j * RLD + 8 * cc) = pre.q[r]; *(LAS u32x4*)(RK + j * RLD + 8 * cc) = pre.k[r];
        const int j2 = cidx & 127, c2 = cidx >> 7;
        const u32x4 vraw = pre.v[r];
        const bf16_t vv[8] = {(bf16_t)(vraw.x & 0xffff), (bf16_t)(vraw.x >> 16), (bf16_t)(vraw.y & 0xffff), (bf16_t)(vraw.y >> 16), (bf16_t)(vraw.z & 0xffff), (bf16_t)(vraw.z >> 16), (bf16_t)(vraw.w & 0xffff), (bf16_t)(vraw.w >> 16)};
#pragma unroll
        for (int e = 0; e < 8; ++e) RV[(8 * c2 + e) * RLD + j2] = vv[e];
    }
    const bf16_t* SF = KVB + (((size_t)(b * 4 + h) * 2 + 0) * NCH + n) * 16384; const bf16_t* SB = KVB + (((size_t)(b * 4 + h) * 2 + 1) * NCH + n) * 16384;
    u32x4 sfr[4];
#pragma unroll
    for (int r = 0; r < 4; ++r) sfr[r] = ldg8(SF + (size_t)(tid + 512 * r) * 8);
    __syncthreads();
    const int mt = w >> 1, ntb = 2 * (w & 1);
    {   f32x16 s0 = {}, s1 = {};
        mma_nt128x2(s0, s1, RQ, 32 * mt, RK, 32 * ntb, r32, hi);
#pragma unroll
        for (int r = 0; r < 16; ++r) { const int i = 32 * mt + crow(r, hi);
#pragma unroll
            for (int t = 0; t < 2; ++t) { const int j = 32 * (ntb + t) + r32;
                const float d = (i > j) ? __expf(lgf * (float)(i - j)) : ((i < j) ? __expf(lgb * (float)(j - i)) : 2.f);
                RP[i * RLD + j] = f2bf((t ? s1[r] : s0[r]) * d); } }
    }
    __syncthreads();
#pragma unroll
    for (int r = 0; r < 4; ++r) { const int cidx = tid + 512 * r, row = cidx >> 4, cc = cidx & 15; *(LAS u32x4*)(RK + row * RLD + 8 * cc) = sfr[r]; }
#pragma unroll
    for (int r = 0; r < 4; ++r) sfr[r] = ldg8(SB + (size_t)(tid + 512 * r) * 8);
    __syncthreads();
    f32x16 ao0 = {}, ao1 = {};
    mma_nt128x2(ao0, ao1, RQ, 32 * mt, RK, 32 * ntb, r32, hi);
#pragma unroll
    for (int r = 0; r < 16; ++r) { const float sc = __expf(lgf * (float)(32 * mt + crow(r, hi) + 1)); ao0[r] *= sc; ao1[r] *= sc; }
    mma_nt128x2(ao0, ao1, RP, 32 * mt, RV, 32 * ntb, r32, hi);
    __syncthreads();
    {
        u32x4 gt[4];
#pragma unroll
        for (int r = 0; r < 4; ++r) { const int cidx = tid + 512 * r, j = cidx >> 4, cc = cidx & 15; gt[r] = ldg8(ZG + (size_t)(tok0 + j) * ZGW + OFF_R + 1536 + h * 128 + 8 * cc); }
#pragma unroll
        for (int r = 0; r < 4; ++r) { const int cidx = tid + 512 * r, row = cidx >> 4, cc = cidx & 15; *(LAS u32x4*)(RV + row * RLD + 8 * cc) = sfr[r]; }
#pragma unroll
        for (int r = 0; r < 4; ++r) { const int cidx = tid + 512 * r, j = cidx >> 4, cc = cidx & 15; *(LAS u32x4*)(RP + j * RLD + 8 * cc) = gt[r]; }
    }
    __syncthreads();
    f32x16 ab0 = {}, ab1 = {};
    mma_nt128x2(ab0, ab1, RQ, 32 * mt, RV, 32 * ntb, r32, hi);
    __syncthreads();
#pragma unroll
    for (int r = 0; r < 16; ++r) { const int i = 32 * mt + crow(r, hi); const float sc = __expf(lgb * (float)(128 - i));
        OF[i * 132 + 32 * ntb + r32] = ao0[r] + sc * ab0[r]; OF[i * 132 + 32 * (ntb + 1) + r32] = ao1[r] + sc * ab1[r]; }
    if (it_next >= 0) ret_out_load(F, it_next, pre);
    __syncthreads();
#pragma unroll 4
    for (int rr = 0; rr < 16; ++rr) { const int i = 16 * w + rr; const float v0 = OF[i * 132 + lane], v1 = OF[i * 132 + 64 + lane];
        const float mean = wave_sum(v0 + v1, lane) * (1.f / 128.f); const float d0 = v0 - mean, d1 = v1 - mean; const float rstd = rsqrtf(wave_sum(d0 * d0 + d1 * d1, lane) * (1.f / 128.f) + 1e-6f);
        const size_t tok = (size_t)(tok0 + i);
        const float g0 = bf1(RP[i * RLD + lane]), g1 = bf1(RP[i * RLD + 64 + lane]);
        bf16_t* yp = Y + tok * YW + 512 + h * 128; yp[lane] = f2bf(siluf_(g0) * d0 * rstd); yp[64 + lane] = f2bf(siluf_(g1) * d1 * rstd); }
    __syncthreads();
}

constexpr int HY_GCS = 16960;
constexpr int HY_URS = 13376;
constexpr int HY_PAD = 1024;
constexpr int HY_NSH = 160;
constexpr int HY_GC_OFF = 0, HY_UR_OFF = 4 * HY_GCS, HY_GT_OFF = HY_UR_OFF + 4 * HY_URS, HY_END = HY_GT_OFF + 4 * 8192;
static_assert(HY_END <= LDS_REGION, "hyena LDS");
__device__ __forceinline__ int hy_uphys(int idx) { const int L = 2 * idx; return L + ((L >> 8) << 4); }
__device__ __forceinline__ void dwconv8(const bf16_t* row, int n0, int len, float w0, float w1, float w2, float bias, float* out) {
    float z[10]; unpack8(ldg8(row + n0), z + 1);
    z[0] = n0 > 0 ? bf1(row[n0 - 1]) : 0.f; z[9] = (n0 + 8 < len) ? bf1(row[n0 + 8]) : 0.f;
#pragma unroll
    for (int e = 0; e < 8; ++e) out[e] = w0 * z[e] + w1 * z[e + 1] + w2 * z[e + 2] + bias;
}
struct HyRaw { u32x4 v[4]; bf16_t lo[4], hi[4]; };
__device__ __forceinline__ void hy_raw_load(HyRaw& R, const bf16_t* ZHT, int col, int tid) {
#pragma unroll
    for (int r = 0; r < 4; ++r) { const int gidx = tid + 512 * r, b = gidx >> 9, n0 = (gidx & 511) * 8; const bf16_t* row = ZHT + (size_t)(b * 1536 + col) * SEQ;
        R.v[r] = ldg8(row + n0); R.lo[r] = n0 > 0 ? row[n0 - 1] : (bf16_t)0; R.hi[r] = (n0 + 8 < SEQ) ? row[n0 + 8] : (bf16_t)0; }
}
__device__ __forceinline__ void hy_dw(const HyRaw& R, int r, float w0, float w1, float w2, float bias, float* out) {
    float z[10]; unpack8(R.v[r], z + 1); z[0] = bf1(R.lo[r]); z[9] = bf1(R.hi[r]);
#pragma unroll
    for (int e = 0; e < 8; ++e) out[e] = w0 * z[e] + w1 * z[e + 1] + w2 * z[e + 2] + bias;
}
__device__ __forceinline__ void hyena_item(const Frame& F, int l, int c, bool need_ctx) {
    const bf16_t* ZHT = wsp<bf16_t>(F, WS_ZHT); const bf16_t* ZHTC = wsp<bf16_t>(F, WS_ZHTC); bf16_t* YHT = wsp<bf16_t>(F, WS_YHT); bf16_t* YHTC = wsp<bf16_t>(F, WS_YHTC);
    const bf16_t* GF = wsp<bf16_t>(F, WS_GF); const float* GC = wsp<float>(F, WS_GC);
    const float* hcw = inptr(I_HCW) + (size_t)l * 3 * 1536; const float* hcb = inptr(I_HCB) + (size_t)l * 1536; const float* hsk = inptr(I_HSKIP) + (size_t)l * 2 * 512;
    LAS unsigned char* lds = F.lds; const int tid = F.tid, lane = F.lane, nt = F.wave & 3, kh = F.wave >> 2;
    LAS bf16_t* GT = (LAS bf16_t*)(lds + HY_GT_OFF);
    HyRaw rv, rg; u32x4 gr[2]; u32x2 gx[2];
    hy_raw_load(rv, ZHT, c, tid); hy_raw_load(rg, ZHT, 512 + c, tid);
#define HY_GLOAD(ord, tt) do { const bf16_t* grow = GF + (((size_t)l * 2 + (ord)) * 512 + c) * 8192; gr[0] = ldg8(grow + (tt) * 8); gr[1] = ldg8(grow + ((tt) + 512) * 8); \
        gx[0] = *(const u32x2*)(grow + (tt) * 8 + 8); gx[1] = ((tt) < 511) ? *(const u32x2*)(grow + ((tt) + 512) * 8 + 8) : (u32x2){0u, 0u}; } while (0)
    HY_GLOAD(0, tid);
    __builtin_amdgcn_sched_barrier(0);
    { unsigned z0 = 0u; asm volatile("" : "+v"(z0)); const u32x4 zz = {z0, z0, z0, z0};
      for (int i = tid; i < 4 * HY_URS / 16; i += NTHREADS) *(LAS u32x4*)(lds + HY_UR_OFF + 16 * i) = zz; }
    __syncthreads();
    { const float w0 = hcw[c], w1 = hcw[1536 + c], w2 = hcw[3072 + c], bb = hcb[c];
#pragma unroll
      for (int r = 0; r < 4; ++r) { const int gidx = tid + 512 * r, b = gidx >> 9, n0 = (gidx & 511) * 8; float y[8]; hy_dw(rv, r, w0, w1, w2, bb, y);
          LAS unsigned char* ub = lds + HY_UR_OFF + b * HY_URS;
#pragma unroll
          for (int e = 0; e < 8; ++e) *(LAS bf16_t*)(ub + hy_uphys(4096 - (n0 + e) + HY_PAD)) = f2bf(y[e]);
          __builtin_amdgcn_sched_barrier(0); } }
#pragma unroll 1
    for (int o = 0; o < 2; ++o) {
        int tid_o = tid; asm volatile("" : "+v"(tid_o));
        {
#pragma unroll
          for (int r = 0; r < 2; ++r) { const int i0 = (tid_o + 512 * r) * 8; const u32x4 w = gr[r]; const u32x2 x = gx[r];
              LAS unsigned char* cb = lds + HY_GC_OFF + i0 * 2;
              *(LAS u32x4*)(cb) = w;
              { u32x4 v; v.x = __builtin_amdgcn_alignbit(w.y, w.x, 16); v.y = __builtin_amdgcn_alignbit(w.z, w.y, 16); v.z = __builtin_amdgcn_alignbit(w.w, w.z, 16); v.w = __builtin_amdgcn_alignbit(x.x, w.w, 16); *(LAS u32x4*)(cb + HY_GCS) = v; }
              { u32x4 v; v.x = w.y; v.y = w.z; v.z = w.w; v.w = x.x; *(LAS u32x4*)(cb + 2 * HY_GCS) = v; }
              { u32x4 v; v.x = __builtin_amdgcn_alignbit(w.z, w.y, 16); v.y = __builtin_amdgcn_alignbit(w.w, w.z, 16); v.z = __builtin_amdgcn_alignbit(x.x, w.w, 16); v.w = __builtin_amdgcn_alignbit(x.y, x.x, 16); *(LAS u32x4*)(cb + 3 * HY_GCS) = v; } }
          for (int i = tid_o; i < 4 * 292; i += NTHREADS) { const int s = i / 292, k = i % 292; const int x = 8192 - s + k; if (x < 8480) ((LAS bf16_t*)(lds + HY_GC_OFF + s * HY_GCS))[x] = 0; }
          const int col = 512 * (o + 1) + c; const float w0 = hcw[col], w1 = hcw[1536 + col], w2 = hcw[3072 + col], bb = hcb[col];
#pragma unroll
          for (int r = 0; r < 4; ++r) { const int gidx = tid_o + 512 * r, b = gidx >> 9, n0 = (gidx & 511) * 8; float y[8]; hy_dw(rg, r, w0, w1, w2, bb, y);
              *(LAS u32x4*)(GT + b * 4096 + n0) = pack8(y); __builtin_amdgcn_sched_barrier(0); } }
        if (o == 0) { hy_raw_load(rg, ZHT, 1024 + c, tid_o); HY_GLOAD(1, tid_o); }
        __builtin_amdgcn_sched_barrier(0);
        __syncthreads();
        int lane_o = lane; asm volatile("" : "+v"(lane_o)); const int r32 = lane_o & 31, hi = lane_o >> 5;
        const int il = r32 >> 2, bb_ = r32 & 3;
        const LAS unsigned char* ap = lds + HY_GC_OFF + (r32 & 3) * HY_GCS + ((r32 & ~3) + 1024 * nt + 8 * hi + 16 * HY_NSH * kh) * 2;
        const LAS unsigned char* bbase = lds + HY_UR_OFF + bb_ * HY_URS; const int bL0 = 2 * (HY_PAD - 128 * il + 8 * hi + 16 * HY_NSH * kh);
#define HY_LDA(s) ({ const s16x4 _lo = *(const LAS s16x4*)(ap + 32 * (s)), _hi = *(const LAS s16x4*)(ap + 32 * (s) + 8); (bf16x8){_lo[0], _lo[1], _lo[2], _lo[3], _hi[0], _hi[1], _hi[2], _hi[3]}; })
#define HY_LDB(s) ({ const int _L = bL0 + 32 * (s); *(const LAS bf16x8*)(bbase + _L + ((_L >> 8) << 4)); })
#define HY_STEP(x0, x1, x2, x3, bcur, gnew, bnext, sn) do { __builtin_amdgcn_sched_barrier(0); acc0 = __builtin_amdgcn_mfma_f32_32x32x16_bf16(x0, bcur, acc0, 0, 0, 0); __builtin_amdgcn_sched_barrier(0); \
        gnew = HY_LDA((sn) + 7); bnext = HY_LDB((sn) + 1); __builtin_amdgcn_sched_barrier(0); \
        acc1 = __builtin_amdgcn_mfma_f32_32x32x16_bf16(x1, bcur, acc1, 0, 0, 0); acc2 = __builtin_amdgcn_mfma_f32_32x32x16_bf16(x2, bcur, acc2, 0, 0, 0); acc3 = __builtin_amdgcn_mfma_f32_32x32x16_bf16(x3, bcur, acc3, 0, 0, 0); \
        __builtin_amdgcn_sched_barrier(0); } while (0)
        f32x16 acc0 = {}, acc1 = {}, acc2 = {}, acc3 = {};
        bf16x8 g0 = HY_LDA(0), g1 = HY_LDA(1), g2 = HY_LDA(2), g3 = HY_LDA(3), g4 = HY_LDA(4), g5 = HY_LDA(5), g6 = HY_LDA(6), g7, b0 = HY_LDB(0), b1;
#pragma unroll 1
        for (int s = 0; s < HY_NSH; s += 8) {
            HY_STEP(g0, g2, g4, g6, b0, g7, b1, s);
            HY_STEP(g1, g3, g5, g7, b1, g0, b0, s + 1);
            HY_STEP(g2, g4, g6, g0, b0, g1, b1, s + 2);
            HY_STEP(g3, g5, g7, g1, b1, g2, b0, s + 3);
            HY_STEP(g4, g6, g0, g2, b0, g3, b1, s + 4);
            HY_STEP(g5, g7, g1, g3, b1, g4, b0, s + 5);
            HY_STEP(g6, g0, g2, g4, b0, g5, b1, s + 6);
            HY_STEP(g7, g1, g3, g5, b1, g6, b0, s + 7);
        }
#undef HY_LDA
#undef HY_LDB
#undef HY_STEP
        __syncthreads();
        LAS float* XCH = (LAS float*)(lds + HY_GC_OFF);
        { const f32x16 s0 = kh ? acc0 : acc2, s1 = kh ? acc1 : acc3; LAS float* xp = XCH + (size_t)(F.wave * 2) * 16 * 64 + lane_o;
#pragma unroll
          for (int r = 0; r < 16; ++r) { xp[r * 64] = s0[r]; xp[(16 + r) * 64] = s1[r]; } }
        __syncthreads();
        f32x16 o0 = kh ? acc2 : acc0, o1 = kh ? acc3 : acc1;
        { const LAS float* xp = XCH + (size_t)((F.wave ^ 4) * 2) * 16 * 64 + lane_o;
#pragma unroll
          for (int r = 0; r < 16; ++r) { o0[r] += xp[r * 64]; o1[r] += xp[(16 + r) * 64]; } }
        { const float sk = hsk[o * 512 + c]; const int nb0 = 128 * (8 * nt + il) + 64 * kh;
          LAS unsigned char* ub = lds + HY_UR_OFF + bb_ * HY_URS;
#pragma unroll
          for (int t = 0; t < 2; ++t)
#pragma unroll
              for (int g = 0; g < 4; ++g) { float yv[4];
#pragma unroll
                  for (int q = 0; q < 4; ++q) { const int n = nb0 + 32 * t + 8 * g + 4 * hi + q; const float cv = t ? o1[4 * g + q] : o0[4 * g + q];
                      const float ycur = bf1(*(const LAS bf16_t*)(ub + hy_uphys(4096 - n + HY_PAD))); const float gt = bf1(GT[bb_ * 4096 + n]); yv[q] = gt * (cv + sk * ycur); }
                  const int n4 = nb0 + 32 * t + 8 * g + 4 * hi;
                  if (o == 0) {
#pragma unroll
                      for (int q = 0; q < 4; ++q) *(LAS bf16_t*)(ub + hy_uphys(4096 - (n4 + q) + HY_PAD)) = f2bf(yv[q]); }
                  else { u32x2 pk; pk.x = pk2(yv[0], yv[1]); pk.y = pk2(yv[2], yv[3]); *(u32x2*)(YHT + (size_t)(bb_ * 512 + c) * SEQ + n4) = pk; } } }
        __syncthreads();
    }
    if (need_ctx) {
        LAS float* uc4 = (LAS float*)(lds);
        LAS float* gc = uc4 + 1024;
        LAS float* gt4 = gc + 512;
        LAS float* red4 = gt4 + 1024;
        { const float w0 = hcw[c], w1 = hcw[1536 + c], w2 = hcw[3072 + c], bb = hcb[c];
          if (tid < 128) { const int b = tid >> 5, n0 = (tid & 31) * 8; float y[8]; dwconv8(ZHTC + (size_t)(b * 1536 + c) * NCTX, n0, NCTX, w0, w1, w2, bb, y);
#pragma unroll
              for (int e = 0; e < 8; ++e) uc4[(n0 + e) * 4 + b] = y[e]; } }
#pragma unroll 1
        for (int o = 0; o < 2; ++o) {
            gc[tid] = GC[(((size_t)l * 2 + o) * 512 + c) * 512 + tid];
            { const int col = 512 * (o + 1) + c; const float w0 = hcw[col], w1 = hcw[1536 + col], w2 = hcw[3072 + col], bb = hcb[col];
              if (tid < 128) { const int b = tid >> 5, n0 = (tid & 31) * 8; float y[8]; dwconv8(ZHTC + (size_t)(b * 1536 + col) * NCTX, n0, NCTX, w0, w1, w2, bb, y);
#pragma unroll
                  for (int e = 0; e < 8; ++e) gt4[(n0 + e) * 4 + b] = y[e]; } }
            __syncthreads();
            const float sk = hsk[o * 512 + c]; const int n = tid & 255, mh = tid >> 8;
            { f32x4 acc = {0.f, 0.f, 0.f, 0.f};
#pragma unroll 8
              for (int m = 128 * mh; m < 128 * mh + 128; ++m) acc += *(const LAS f32x4*)(uc4 + 4 * m) * gc[256 + n - m];
              *(LAS f32x4*)(red4 + 4 * tid) = acc; }
            __syncthreads();
            f32x4 res = {0.f, 0.f, 0.f, 0.f};
            if (tid < 256) { const f32x4 s4 = *(const LAS f32x4*)(red4 + 4 * tid) + *(const LAS f32x4*)(red4 + 4 * (tid + 256)); const f32x4 u4 = *(const LAS f32x4*)(uc4 + 4 * n);
                res = *(const LAS f32x4*)(gt4 + 4 * n) * (s4 + u4 * sk); }
            __syncthreads();
            if (tid < 256) { *(LAS f32x4*)(uc4 + 4 * n) = res;
                if (o == 1) {
#pragma unroll
                    for (int b = 0; b < 4; ++b) YHTC[(size_t)(b * 512 + c) * NCTX + n] = f2bf(res[b]); } }
            __syncthreads();
        }
    }
}

__device__ __forceinline__ void ph4b_sum(const Frame& F, int nrows) {
    const bf16_t* ZG = wsp<bf16_t>(F, WS_ZG); bf16_t* MS = wsp<bf16_t>(F, WS_ZHT);
    u32x4 nx[2][4];
    if (F.gw < nrows) { const bf16_t* gp = ZG + (size_t)F.gw * ZGW + OFF_G;
#pragma unroll
        for (int j = 0; j < 2; ++j)
#pragma unroll
            for (int i = 0; i < 4; ++i) nx[j][i] = ldg8(gp + i * 1024 + 8 * F.lane + 512 * j); }
    for (int row = F.gw; row < nrows; row += F.NGW) {
        u32x4 cur[2][4];
#pragma unroll
        for (int j = 0; j < 2; ++j)
#pragma unroll
            for (int i = 0; i < 4; ++i) cur[j][i] = nx[j][i];
        if (row + F.NGW < nrows) { const bf16_t* gp = ZG + (size_t)(row + F.NGW) * ZGW + OFF_G;
#pragma unroll
            for (int j = 0; j < 2; ++j)
#pragma unroll
                for (int i = 0; i < 4; ++i) nx[j][i] = ldg8(gp + i * 1024 + 8 * F.lane + 512 * j); }
#pragma unroll
        for (int j = 0; j < 2; ++j) { const int col = 8 * F.lane + 512 * j; float a[8], t[8];
            unpack8(cur[j][0], a);
#pragma unroll
            for (int i = 1; i < 4; ++i) { unpack8(cur[j][i], t);
#pragma unroll
                for (int e = 0; e < 8; ++e) a[e] += t[e]; }
            *(u32x4*)(MS + (size_t)row * DM + col) = pack8(a); }
    }
}
__device__ __forceinline__ void ph6_ln1(const Frame& F, int l, int nrows, bool dry = false) {
    bf16_t* XF = wsp<bf16_t>(F, WS_XF); unsigned char* U8 = wsp<unsigned char>(F, WS_U); bf16_t* XFo = dry ? wsp<bf16_t>(F, WS_ZG) : XF; if (dry) U8 = wsp<unsigned char>(F, WS_ZG + (size_t)T_ALL * DM * 4); const float* MODl = wsp<float>(F, WS_MOD) + (size_t)l * 5 * 6144;
    const float* g = inptr(I_LNG) + (size_t)(l * 2 + 0) * DM; const float* bta = inptr(I_LNB) + (size_t)(l * 2 + 0) * DM;
    const bool moe = ((l & 1) != 0) && !dry; const int rpb = nrows / F.G, lane = F.lane; const bf16_t* MIX = wsp<bf16_t>(F, WS_Y);
    LAS float* RT = (LAS float*)(F.lds);
    LAS int* cnt = (LAS int*)(F.lds + 32768);
    LAS unsigned* rec = (LAS unsigned*)(F.lds + 32768 + 64);
    if (moe) { const float* rw = inptr(I_ROUTER) + (size_t)(l >> 1) * DM * NEXP;
        for (int i = F.tid; i < DM * NEXP; i += NTHREADS) RT[i] = rw[i];
        if (F.tid < 16) cnt[F.tid] = 0;
        __syncthreads(); }
    u32x2 nx[4]; u32x2 ny[4];
    { const int row = F.bid * rpb + F.wave;
#pragma unroll
      for (int j = 0; j < 4; ++j) { nx[j] = *(const u32x2*)(XF + (size_t)row * DM + 4 * lane + 256 * j); ny[j] = *(const u32x2*)(MIX + (size_t)row * DM + 4 * lane + 256 * j); } }
    for (int k = F.wave; k < rpb; k += NWAVES) {
        const int row = F.bid * rpb + k; bf16_t* xo = XFo + (size_t)row * DM;
        const float* m = MODl + (size_t)row_bsel(row) * 6144;
        f32x4 v[4]; u32x2 yy[4];
#pragma unroll
        for (int j = 0; j < 4; ++j) { v[j] = bf4_f32(nx[j]); yy[j] = ny[j]; }
        if (k + NWAVES < rpb) { const int rown = row + NWAVES;
#pragma unroll
            for (int j = 0; j < 4; ++j) { nx[j] = *(const u32x2*)(XF + (size_t)rown * DM + 4 * lane + 256 * j); ny[j] = *(const u32x2*)(MIX + (size_t)rown * DM + 4 * lane + 256 * j); } }
#pragma unroll
        for (int j = 0; j < 4; ++j) { const u32x2 y = yy[j]; const f32x4 mm = *(const f32x4*)(m + 2 * 1024 + 4 * lane + 256 * j);
            f32x4 f; f.x = bflo(y.x); f.y = bfhi(y.x); f.z = bflo(y.y); f.w = bfhi(y.y);
            v[j] = v[j] * ALPHA + mm * f; }
        ln_row(v, g, bta, lane);
#pragma unroll
        for (int j = 0; j < 4; ++j) *(u32x2*)(xo + 4 * lane + 256 * j) = f32_bf4(v[j]);
        store_mod_row8(v, m + 3 * 1024, m + 4 * 1024, U8 + (size_t)row * DM, lane);
        if (moe) {
            float lg[8] = {0.f, 0.f, 0.f, 0.f, 0.f, 0.f, 0.f, 0.f};
#pragma unroll
            for (int j = 0; j < 4; ++j) { const f32x4 a = *(const f32x4*)(m + 3 * 1024 + 4 * lane + 256 * j), s = *(const f32x4*)(m + 4 * 1024 + 4 * lane + 256 * j); const f32x4 u = v[j] * (s + 1.0f) + a;
#pragma unroll
                for (int c = 0; c < 4; ++c) { const LAS float* rp = RT + (size_t)(4 * lane + 256 * j + c) * 8; const f32x4 r0 = *(const LAS f32x4*)rp, r1 = *(const LAS f32x4*)(rp + 4); const float uu = u[c];
                    lg[0] += uu * r0.x; lg[1] += uu * r0.y; lg[2] += uu * r0.z; lg[3] += uu * r0.w; lg[4] += uu * r1.x; lg[5] += uu * r1.y; lg[6] += uu * r1.z; lg[7] += uu * r1.w; } }
#pragma unroll
            for (int e = 0; e < 8; ++e) lg[e] = wave_sum(lg[e], lane);
            float v0 = lg[0]; int i0 = 0;
#pragma unroll
            for (int e = 1; e < 8; ++e) if (lg[e] > v0) { v0 = lg[e]; i0 = e; }
            float v1 = -3.0e38f; int i1 = 0;
#pragma unroll
            for (int e = 0; e < 8; ++e) if (e != i0 && lg[e] > v1) { v1 = lg[e]; i1 = e; }
            const float w0 = __builtin_amdgcn_rcpf(1.f + __expf(v1 - v0)), w1 = 1.f - w0;
            if (lane == 0) { const int r0 = __hip_atomic_fetch_add(&cnt[i0], 1, __ATOMIC_RELAXED, __HIP_MEMORY_SCOPE_WORKGROUP), r1 = __hip_atomic_fetch_add(&cnt[i1], 1, __ATOMIC_RELAXED, __HIP_MEMORY_SCOPE_WORKGROUP);
                LAS unsigned* rc = rec + k * 8; rc[0] = (unsigned)i0; rc[1] = (unsigned)r0; rc[2] = (unsigned)i1; rc[3] = (unsigned)r1; rc[4] = __float_as_uint(w0); rc[5] = __float_as_uint(w1); }
        }
    }
    if (moe) {
        __syncthreads();
        if (F.tid < 8) cnt[8 + F.tid] = (int)__hip_atomic_fetch_add(F.ctl + CW_MOE + (l * 8 + F.tid) * 64, (unsigned)cnt[F.tid], __ATOMIC_RELAXED, __HIP_MEMORY_SCOPE_AGENT);
        __syncthreads();
        unsigned* PAIR = wsp<unsigned>(F, WS_PAIR);
        for (int k = F.tid; k < rpb; k += NTHREADS) { const int row = F.bid * rpb + k; const LAS unsigned* rc = rec + k * 8;
            u32x4 a; a.x = rc[0]; a.y = rc[1] + (unsigned)cnt[8 + rc[0]]; a.z = rc[2]; a.w = rc[3] + (unsigned)cnt[8 + rc[2]];
            *(u32x4*)(PAIR + (size_t)row * 8) = a; PAIR[(size_t)row * 8 + 4] = rc[4]; PAIR[(size_t)row * 8 + 5] = rc[5]; }
        __syncthreads();
    }
}
__device__ __forceinline__ void moe_tiles(const Frame& F, int l, bool moe, int nMr, int* ts  , int& ntiles) {
    int acc = 0;
#pragma unroll
    for (int e = 0; e < NEXP; ++e) { ts[e] = moe ? acc : (e ? 0x3fffffff : 0);
        const unsigned c = moe ? __hip_atomic_load(F.ctl + CW_MOE + (l * 8 + e) * 64, __ATOMIC_RELAXED, __HIP_MEMORY_SCOPE_AGENT) : 0u; acc += __builtin_amdgcn_readfirstlane((int)((c + 255u) >> 8)); }
    ntiles = moe ? acc : nMr;
}
__device__ __forceinline__ void ph7_gather(const Frame& F, int l, int nrows) {
    int ts[NEXP], ntiles; moe_tiles(F, l, true, 0, ts, ntiles);
    unsigned* PAIR = wsp<unsigned>(F, WS_PAIR); const unsigned char* U8 = wsp<unsigned char>(F, WS_U); unsigned char* XG = wsp<unsigned char>(F, WS_XG);
    u32x4 na = {0u, 0u, 0u, 0u}, nxr = {0u, 0u, 0u, 0u};
    if (F.gw < nrows) { na = *(const u32x4*)(PAIR + (size_t)F.gw * 8); nxr = ((const u32x4*)(U8 + (size_t)F.gw * DM))[F.lane]; }
    for (int tok = F.gw; tok < nrows; tok += F.NGW) {
        const u32x4 a = na, x0 = nxr;
        if (tok + F.NGW < nrows) { na = *(const u32x4*)(PAIR + (size_t)(tok + F.NGW) * 8); nxr = ((const u32x4*)(U8 + (size_t)(tok + F.NGW) * DM))[F.lane]; }
        int b0 = 0, b1 = 0;
#pragma unroll
        for (int e = 0; e < NEXP; ++e) { b0 = ((int)a.x == e) ? ts[e] : b0; b1 = ((int)a.z == e) ? ts[e] : b1; }
        const unsigned s0 = (unsigned)b0 * 256u + a.y, s1 = (unsigned)b1 * 256u + a.w;
        if (F.lane == 0) { PAIR[(size_t)tok * 8 + 6] = s0; PAIR[(size_t)tok * 8 + 7] = s1; }
        ((u32x4*)(XG + (size_t)s0 * DM))[F.lane] = x0; ((u32x4*)(XG + (size_t)s1 * DM))[F.lane] = x0;
    }
}
__device__ __forceinline__ void ph10_ln2(const Frame& F, int l, int nrows, bool dry = false) {
    bf16_t* XF = wsp<bf16_t>(F, WS_XF); bf16_t* U = dry ? wsp<bf16_t>(F, WS_ZG + (size_t)T_ALL * DM * 4) : wsp<bf16_t>(F, WS_U); bf16_t* XFo = dry ? wsp<bf16_t>(F, WS_ZG) : XF; float* OUTo = dry ? wsp<float>(F, WS_ZG) : F.out; const float* MOD = wsp<float>(F, WS_MOD);
    const float* g = inptr(I_LNG) + (size_t)(l * 2 + 1) * DM; const float* bta = inptr(I_LNB) + (size_t)(l * 2 + 1) * DM;
    const bool moe = (l & 1) != 0; const int lane = F.lane;
    const unsigned* PAIR = wsp<unsigned>(F, WS_PAIR); const bf16_t* YO = wsp<bf16_t>(F, WS_YO);
    for (int row0 = F.gw; row0 < nrows; row0 += 2 * F.NGW) {
        int rows[2]; rows[0] = row0; rows[1] = (row0 + F.NGW < nrows) ? row0 + F.NGW : row0;
        f32x4 v[2][4]; u32x2 ya[2][4], yb[2][4]; float w0[2], w1[2];
#pragma unroll
        for (int h = 0; h < 2; ++h) { const int row = rows[h]; const bf16_t* xr = XF + (size_t)row * DM;
            unsigned s0 = (unsigned)row, s1 = (unsigned)row; w0[h] = 1.f; w1[h] = 0.f;
            if (moe) { const unsigned* pr = PAIR + (size_t)row * 8; w0[h] = __uint_as_float(pr[4]); w1[h] = __uint_as_float(pr[5]); s0 = pr[6]; s1 = pr[7]; }
#pragma unroll
            for (int j = 0; j < 4; ++j) { v[h][j] = bf4_f32(*(const u32x2*)(xr + 4 * lane + 256 * j));
                ya[h][j] = *(const u32x2*)(YO + (size_t)s0 * DM + 4 * lane + 256 * j); yb[h][j] = *(const u32x2*)(YO + (size_t)s1 * DM + 4 * lane + 256 * j); } }
#pragma unroll
        for (int h = 0; h < 2; ++h) { const int row = rows[h];
            const float* m5 = MOD + ((size_t)l * 5 + row_bsel(row)) * 6144 + 5 * 1024;
#pragma unroll
            for (int j = 0; j < 4; ++j) { const u32x2 y0 = ya[h][j], y1 = yb[h][j]; const f32x4 mm = *(const f32x4*)(m5 + 4 * lane + 256 * j);
                f32x4 f; f.x = w0[h] * bflo(y0.x) + w1[h] * bflo(y1.x); f.y = w0[h] * bfhi(y0.x) + w1[h] * bfhi(y1.x); f.z = w0[h] * bflo(y0.y) + w1[h] * bflo(y1.y); f.w = w0[h] * bfhi(y0.y) + w1[h] * bfhi(y1.y);
                v[h][j] = v[h][j] * ALPHA + mm * f; }
            ln_row(v[h], g, bta, lane); }
#pragma unroll
        for (int h = 0; h < 2; ++h) { const int row = rows[h];
            if (l == DEPTH - 1) {
#pragma unroll
                for (int j = 0; j < 4; ++j) *(f32x4*)(OUTo + (size_t)row * DM + 4 * lane + 256 * j) = v[h][j];
            } else {
#pragma unroll
                for (int j = 0; j < 4; ++j) *(u32x2*)(XFo + (size_t)row * DM + 4 * lane + 256 * j) = f32_bf4(v[h][j]);
                const float* m = MOD + ((size_t)(l + 1) * 5 + row_bsel(row)) * 6144;
                store_mod_row(v[h], m, m + 1024, U + (size_t)row * DM, lane);
                if (!dry) store_mod_row8(v[h], m, m + 1024, wsp<unsigned char>(F, WS_U8M) + (size_t)row * DM, lane);
            } }
    }
}

constexpr int NPHL = 12;
constexpr int NPH = 2 + NPHL * DEPTH;
__device__ __forceinline__ bool in_range(int k, int lo, int hi) { asm volatile("" : "+s"(k)); return lo <= k && k < hi; }
__global__ void __launch_bounds__(NTHREADS, 2) mk_fwd(Args args) {
    extern __shared__ __attribute__((aligned(16))) unsigned char lds_raw[];
    Frame F;
    F.lds = (LAS unsigned char*)lds_raw + LDS_CTL; F.ldsg = lds_raw + LDS_CTL; F.lds0 = (unsigned)(uintptr_t)(LAS unsigned char*)lds_raw;
    F.out = args.out; F.ws = args.ws; F.ws0 = args.ws; F.ctl = (unsigned*)(args.ws + WS_CTL);
    F.tid = threadIdx.x; F.lane = F.tid & 63; F.wave = __builtin_amdgcn_readfirstlane(F.tid >> 6); F.wave0 = F.wave; F.G = gridDim.x; F.bid = blockIdx.x; F.gw = blockIdx.x * NWAVES + F.wave; F.NGW = F.G * NWAVES;
    volatile LAS unsigned* lctl = (volatile LAS unsigned*)((LAS unsigned char*)lds_raw);
    if (F.tid < 16) lctl[F.tid] = 0u;
    __syncthreads();
    const int lo = args.ph_lo, hi = args.ph_hi; const bool one = (hi - lo) > 1;
    XcdBarrier bar = xcd_barrier_post(F.ctl + CW_BAR, lctl);
#ifndef MK_REP
#define MK_REP 0
#endif
#ifndef MK_ONLY
#define MK_ONLY -1
#endif
#define EN(j) (MK_ONLY < 0 || MK_ONLY == (j))
#ifndef MK_SUB
#define MK_SUB -1
#endif
#define EN2(j) (MK_SUB < 0 || MK_SUB == (j))
#define IN(k) in_range((k), lo, hi)
#define SEAM(k) do { if (IN(k) && IN((k) + 1)) { xcd_barrier(bar); if (MK_REP == 12) xcd_barrier(bar); } } while (0)
#define QNEXT(headw, dst) do { if (F.tid == 0) lctl[4] = __hip_atomic_fetch_add((headw), 1u, __ATOMIC_RELAXED, __HIP_MEMORY_SCOPE_AGENT); __syncthreads(); dst = __builtin_amdgcn_readfirstlane((int)lctl[4]); __syncthreads(); } while (0)

    if (IN(0) && EN(0)) { frame_tid(F); cvt_range(F, 0, 0, CVT_NMIX + CVT_NF_D, 0); __syncthreads(); p0_mod(F); p0_filters(F); if (MK_REP == 8) { __syncthreads(); p0_mod(F); } if (MK_REP == 14) { __syncthreads(); p0_filters(F); } }
    SEAM(0);
    if (IN(1) && EN(1)) { frame_tid(F); p0b_rows(F); if (MK_REP == 15) p0b_rows(F); }
    SEAM(1);

#pragma unroll 1
    for (int l = 0; l < DEPTH; ++l) {
        const int pb = 2 + NPHL * l; const bool need_ctx = l < DEPTH - 1; const int nrows = need_ctx ? T_ALL : T_LAT, nMr = nrows / 256; const bool moe = (l & 1) != 0;
        if (IN(pb + 0) && EN(2)) { frame_tid(F); pg8::Gemm g{DM, DM, 64, 128, 32768}; pg8::GSched S; S.init(T_ALL / 256, INW / 256, F.G, F.bid, wsp<bf16_t>(F, WS_U), 256u * DM * 2, wsp<bf16_t>(F, WS_WCAT), 256u * DM * 2);
            pg8::EpiPlain E{(GAS bf16_t*)wsp<bf16_t>(F, WS_ZG), ZGW, 1.0f};
            pg8::gemm_phase(F.lds, g, S, E, F.tid);
            if (MK_REP == 5) { __syncthreads(); pg8::gemm_phase(F.lds, g, S, E, F.tid); }
            if (MK_REP == 16) { __syncthreads(); pg8::gemm_phase(F.lds, g, S, pg8::EpiNull{}, F.tid); }
            if (MK_REP == 18 || MK_REP == 19) { __syncthreads(); pg8::GSched S2; S2.init(64, MK_REP == 18 ? 4 : 8, F.G, F.bid, wsp<bf16_t>(F, WS_U), 256u * DM * 2, wsp<bf16_t>(F, WS_WCAT), 256u * DM * 2); pg8::gemm_phase(F.lds, g, S2, pg8::EpiNull{}, F.tid); }
            if (MK_REP == 20) { __syncthreads(); pg8::Gemm g2{DM, 64, 64, 32768, 32768}; pg8::gemm_phase(F.lds, g2, S, pg8::EpiNull{}, F.tid); }
            if (MK_REP == 21) { __syncthreads(); pg8::GSched S2; S2.init(T_ALL / 256, INW / 256, F.G, F.bid, wsp<bf16_t>(F, WS_U), 0u, wsp<bf16_t>(F, WS_WCAT), 0u); pg8::gemm_phase(F.lds, g, S2, pg8::EpiNull{}, F.tid); }
            if (MK_REP == 22) { __syncthreads(); pg8::Gemm g2{2 * DM, DM, DM}; pg8::gemm_phase(F.lds, g2, S, pg8::EpiNull{}, F.tid); }
            if (MK_REP == 23) { __syncthreads(); pg8::Gemm g2{DM, DM, 64, 128, 32768}; pg8::gemm_phase(F.lds, g2, S, pg8::EpiNull{}, F.tid); }
            if (MK_REP == 24) { __syncthreads(); pg8::Gemm g2{DM, 64, DM, 32768, 128}; pg8::gemm_phase(F.lds, g2, S, pg8::EpiNull{}, F.tid); }
            if (MK_REP == 25) { for (int rr = 0; rr < 3; ++rr) { __syncthreads(); pg8::SameSched S2{S}; pg8::gemm_phase(F.lds, g, S2, pg8::EpiNull{}, F.tid); } }
            if (MK_REP == 26) { for (int rr = 0; rr < 3; ++rr) { __syncthreads(); pg8::gemm_phase(F.lds, g, S, pg8::EpiNull{}, F.tid); } }
            if (MK_REP == 27) { for (int rr = 0; rr < 3; ++rr) { __syncthreads(); pg8::gemm_phase(F.lds, g, S, E, F.tid); } }
            if (MK_REP == 28) { for (int rr = 0; rr < 3; ++rr) { __syncthreads(); pg8::gemm_phase<false, 1>(F.lds, g, S, pg8::EpiNull{}, F.tid); } }
            if (MK_REP == 29) { for (int rr = 0; rr < 3; ++rr) { __syncthreads(); pg8::gemm_phase<false, 2>(F.lds, g, S, pg8::EpiNull{}, F.tid); } }
            if (MK_REP == 30) { for (int rr = 0; rr < 3; ++rr) { __syncthreads(); pg8::gemm_phase<false, 3>(F.lds, g, S, pg8::EpiNull{}, F.tid); } }
            if (MK_REP == 31) { for (int rr = 0; rr < 3; ++rr) { __syncthreads(); pg8::EpiZGNoStore E2{F.tid == 1000 ? 2.0f : 1.0f}; pg8::gemm_phase(F.lds, g, S, E2, F.tid); } }
            if (MK_REP == 32) { for (int rr = 0; rr < 3; ++rr) { __syncthreads(); pg8::EpiContig E2{(GAS unsigned char*)wsp<unsigned char>(F, WS_Y), 1.0f}; pg8::gemm_phase(F.lds, g, S, E2, F.tid); } }
            if (MK_REP == 33) { __syncthreads(); pg8::EpiContig E2{(GAS unsigned char*)wsp<unsigned char>(F, WS_Y), 1.0f}; pg8::gemm_phase(F.lds, g, S, E2, F.tid); __syncthreads(); pg8::gemm_phase(F.lds, g, S, E2, F.tid); }
            if (MK_REP == 34) { __syncthreads(); pg8::gemm_phase(F.lds, g, S, E, F.tid); __syncthreads(); pg8::gemm_phase(F.lds, g, S, E, F.tid); }
            if (MK_REP == 17) { __syncthreads(); pg8::Gemm g2{DM / 2, DM, DM}; pg8::gemm_phase(F.lds, g2, S, pg8::EpiNull{}, F.tid); } }
        if (IN(pb + 0) && EN(2)) { frame_tid(F); cvt_ffn_share<0>(F, l, ((T_ALL / 256) * (INW / 256)) % 256); }
        SEAM(pb + 0);
        if (IN(pb + 1) && EN(3)) { frame_tid(F); ph2_tokens(F, l, need_ctx); ph2_htrans(F); if (MK_REP == 1) { ph2_tokens(F, l, need_ctx); ph2_htrans(F); } __syncthreads(); ph2_retkv(F, l); }
        SEAM(pb + 1);
        if (IN(pb + 2) && EN(4)) { frame_tid(F);
            { pg8::Gemm g{DM / 2, DM / 2, 64, 128, 32768}; pg8::GSched S; S.init(nMr, 16, F.G, F.bid, wsp<unsigned char>(F, WS_U8M), 256u * DM, wsp<unsigned char>(F, WS_WG8), 256u * DM);
              pg8::EpiShift E{pg8::EpiZG{(GAS bf16_t*)wsp<bf16_t>(F, WS_ZG), (const GAS float*)(inptr(I_BGATE) + (size_t)l * 4096), 1.0f / F8_WSCALE}};
              pg8::gemm_phase<true>(F.lds, g, S, E, F.tid); }
            frame_tid(F);
            const int xcd_ = F.bid & 7, j_ = F.bid >> 3, au_ = (xcd_ >> 1) * 64 + (2 * (xcd_ & 1) + (j_ >> 4)) * 16 + (j_ & 15);
            for (int k = 0; k < 2; ++k) { const int it = k == 0 ? au_ : ((need_ctx && F.bid >= 64 && F.bid < 80) ? 256 + (F.bid - 64) : -1); if (it < 0) break;
                const bf16_t *Q, *K, *V; bf16_t* O; int seq;
                if (it < 256) { const int b = it >> 6, h = (it >> 4) & 3, qb = it & 15;
                    Q = wsp<bf16_t>(F, WS_QP) + ((size_t)(b * 4 + h) * SEQ + qb * 256) * 128; K = wsp<bf16_t>(F, WS_KALL) + (size_t)(b * 2 + (h >> 1)) * 4352 * 128; V = wsp<bf16_t>(F, WS_VALL) + (size_t)(b * 2 + (h >> 1)) * 4352 * 128;
                    O = wsp<bf16_t>(F, WS_Y) + (size_t)(b * SEQ + qb * 256) * YW + 1536 + h * 128; seq = 4352; }
                else { const int r = it - 256, b = r >> 2, h = r & 3;
                    Q = wsp<bf16_t>(F, WS_QC) + (size_t)(b * 4 + h) * NCTX * 128; K = wsp<bf16_t>(F, WS_KALL) + ((size_t)(b * 2 + (h >> 1)) * 4352 + SEQ) * 128; V = wsp<bf16_t>(F, WS_VALL) + ((size_t)(b * 2 + (h >> 1)) * 4352 + SEQ) * 128;
                    O = wsp<bf16_t>(F, WS_Y) + (size_t)(T_LAT + b * NCTX) * YW + 1536 + h * 128; seq = 256; }
                attn::attn_dense_body(Q, K, V, O, YW, seq, (char*)F.ldsg, F.tid); }
            frame_tid(F);
            for (int k = 0; k < 2; ++k) hyena_item(F, l, F.bid + 256 * k, need_ctx);
            frame_tid(F);
            for (int k = 0; k < 2; ++k) { const int it = k == 0 ? (F.bid >= 64 ? F.bid - 64 : -1) : ((F.bid >= 80 && F.bid < 144) ? 192 + (F.bid - 80) : -1); if (it < 0) break; ret_scan_item(F, l, it); }
        }
        SEAM(pb + 2);
        if (IN(pb + 3) && EN(5)) { frame_tid(F);
            for (int rep = 0; rep < (MK_REP == 4 ? 2 : 1); ++rep) {
            ph3b_ytrans(F, need_ctx); __syncthreads();
            { int it = F.bid; while (it < NBATCH * 4 * NCH && !need_ctx && (it % NCH) < 2) it += F.G;
              if (it < NBATCH * 4 * NCH) { RetPre pre; ret_out_load(F, it, pre);
                for (;;) { int nx = it + F.G; while (nx < NBATCH * 4 * NCH && !need_ctx && (nx % NCH) < 2) nx += F.G; if (nx >= NBATCH * 4 * NCH) nx = -1;
                    ret_out_item(F, l, it, pre, nx); if (nx < 0) break; it = nx; } } } }
        }
        SEAM(pb + 3);
        if (IN(pb + 4) && EN(6)) { frame_tid(F); pg8::Gemm g{512, YW, 64, 128, 32768}; pg8::GSched S; S.init(nMr, 16, F.G, F.bid, wsp<bf16_t>(F, WS_Y), 256u * YW * 2, wsp<bf16_t>(F, WS_WB), 256u * 512 * 2, 2, 512u * 2);
            pg8::EpiGate E{(GAS bf16_t*)wsp<bf16_t>(F, WS_ZG)};
            pg8::gemm_phase(F.lds, g, S, E, F.tid); }
        if (IN(pb + 4) && EN(6)) { frame_tid(F); cvt_ffn_share<1>(F, l, need_ctx ? 64 : 0); }
        SEAM(pb + 4);
        if (IN(pb + 5) && EN(13)) { frame_tid(F); ph4b_sum(F, nrows); if (MK_REP == 13) ph4b_sum(F, nrows); }
        SEAM(pb + 5);
        if (IN(pb + 6) && EN(7)) { frame_tid(F); pg8::Gemm g{DM, DM, 64, 128, 32768}; pg8::GSched S; S.init(nMr, 4, F.G, F.bid, wsp<bf16_t>(F, WS_ZHT), 256u * DM * 2, wsp<bf16_t>(F, WS_WO4), 256u * DM * 2);
            pg8::EpiPlain E{(GAS bf16_t*)wsp<bf16_t>(F, WS_Y), DM, 1.0f};
            pg8::gemm_phase(F.lds, g, S, E, F.tid);
            cvt_ffn_share<2>(F, l, need_ctx ? 16 : 0);
            if (MK_REP == 9) { __syncthreads(); pg8::gemm_phase(F.lds, g, S, E, F.tid); } }
        SEAM(pb + 6);
        if (IN(pb + 7) && EN(8)) { frame_tid(F); if (MK_REP == 16) ph6_ln1(F, l, nrows, true); ph6_ln1(F, l, nrows); }
        SEAM(pb + 7);
        if (IN(pb + 8) && EN(9)) { frame_tid(F); if (moe) { ph7_gather(F, l, nrows); if (MK_REP == 11) ph7_gather(F, l, nrows); } }
        if (moe) SEAM(pb + 8);
        if (IN(pb + 9) && EN(10)) { frame_tid(F);
            const int FF = moe ? FFE : FFD;
            pg8::Gemm g{DM / 2, DM / 2, 64, 128, 32768}; pg8::MoeSched S; S.G = F.G; S.c = F.bid; S.nN = 2 * FF / 256; moe_tiles(F, l, moe, nMr, S.ts, S.ntiles);
            S.A = (const char*)(moe ? wsp<unsigned char>(F, WS_XG) : wsp<unsigned char>(F, WS_U)); S.B = (const char*)wsp<unsigned char>(F, moe ? WS_W13 : WS_W13D); S.a_tile = 256u * DM; S.b_tile = 256u * DM;
            pg8::EpiSwiglu E{(GAS unsigned char*)wsp<unsigned char>(F, WS_HID), FF, 1.0f / F8_WSCALE};
            pg8::gemm_phase<true>(F.lds, g, S, E, F.tid);
            if (MK_REP == 6) { __syncthreads(); pg8::gemm_phase<true>(F.lds, g, S, E, F.tid); }
        }
        SEAM(pb + 9);
        if (IN(pb + 10) && EN(11)) { frame_tid(F);
            const int FF = moe ? FFE : FFD;
            pg8::Gemm g{FF / 2, FF / 2, 64, 128, 32768}; pg8::MoeSched S; S.G = F.G; S.c = F.bid; S.nN = 4; moe_tiles(F, l, moe, nMr, S.ts, S.ntiles);
            S.A = (const char*)wsp<unsigned char>(F, WS_HID); S.B = (const char*)wsp<unsigned char>(F, moe ? WS_W2 : WS_W2D); S.a_tile = 256u * (unsigned)FF; S.b_tile = 256u * (unsigned)FF;
            pg8::EpiPlain E{(GAS bf16_t*)wsp<bf16_t>(F, WS_YO), DM, 1.0f / F8_WSCALE};
            pg8::gemm_phase<true>(F.lds, g, S, E, F.tid);
            if (MK_REP == 10) { __syncthreads(); pg8::gemm_phase<true>(F.lds, g, S, E, F.tid); }
        }
        if (IN(pb + 10) && EN(11) && l + 1 < DEPTH) { frame_tid(F); int ts_[NEXP], nt_; moe_tiles(F, l, moe, nMr, ts_, nt_);
            cvt_range(F, l + 1, 0, CVT_NMIX + cvt_e1(l + 1), (nt_ * 4) & 255); }
        SEAM(pb + 10);
        if (IN(pb + 11) && EN(12)) { frame_tid(F); if (MK_REP == 17) ph10_ln2(F, l, nrows, true); ph10_ln2(F, l, nrows); }
        if (l + 1 < DEPTH) SEAM(pb + 11);
    }
#undef IN
#undef SEAM
#undef QNEXT
}

#ifndef MK_PER_PHASE
#define MK_PER_PHASE 0
#endif
extern "C" void kernel_launch(void* const* d_in, const int* in_sizes, int n_in, void* d_out, int out_size, void* d_ws, size_t ws_size, hipStream_t stream) {
    static int grid = 0;
    if (grid == 0) {
        if (n_in != N_IN || out_size != T_LAT * DM || ws_size < WS_END) { fprintf(stderr, "kernel_launch: unexpected shapes: n_in %d out %d ws %zu (need %zu)\n", n_in, out_size, ws_size, (size_t)WS_END); grid = -1; return; }
        int dev = 0, cus = 0, per_cu = 0;
        if (hipGetDevice(&dev) != hipSuccess || hipDeviceGetAttribute(&cus, hipDeviceAttributeMultiprocessorCount, dev) != hipSuccess) { grid = -1; return; }
        if (hipFuncSetAttribute((const void*)mk_fwd, hipFuncAttributeMaxDynamicSharedMemorySize, LDS_BYTES) != hipSuccess) { fprintf(stderr, "kernel_launch: hipFuncSetAttribute failed\n"); grid = -1; return; }
        if (hipOccupancyMaxActiveBlocksPerMultiprocessor(&per_cu, (const void*)mk_fwd, NTHREADS, LDS_BYTES) != hipSuccess || per_cu < 1) { fprintf(stderr, "kernel_launch: occupancy query says %d\n", per_cu); }
        (void)hipGetLastError();
        grid = cus;
        if (grid != 256) { fprintf(stderr, "kernel_launch: built for 256 CUs, got %d\n", grid); grid = -1; return; }
    }
    if (grid < 0) return;
    (void)hipMemsetAsync((char*)d_ws + WS_CTL, 0, CTL_BYTES, stream);
    Args a{};
    for (int i = 0; i < N_IN; ++i) a.in[i] = (const float*)d_in[i];
    a.out = (float*)d_out; a.ws = (unsigned char*)d_ws;
#if MK_PER_PHASE
    for (int p = 0; p < NPH; ++p) { a.ph_lo = p; a.ph_hi = p + 1; hipLaunchKernelGGL(mk_fwd, dim3(grid), dim3(NTHREADS), LDS_BYTES, stream, a); }
#else
    a.ph_lo = 0; a.ph_hi = NPH; hipLaunchKernelGGL(mk_fwd, dim3(grid), dim3(NTHREADS), LDS_BYTES, stream, a);
#endif
    const hipError_t le = hipPeekAtLastError();
    if (le != hipSuccess) fprintf(stderr, "kernel_launch: launch failed: %s\n", hipGetErrorName(le));
}
```

```cpp
#include <hip/hip_runtime.h>
#include <cstdio>
#include <cstdint>

#define LAS __attribute__((address_space(3)))
#define GAS __attribute__((address_space(1)))
typedef unsigned short bf16_t;
typedef short bf16x8 __attribute__((ext_vector_type(8)));
typedef short s16x4 __attribute__((ext_vector_type(4)));
typedef float f32x2 __attribute__((ext_vector_type(2)));
typedef float f32x4 __attribute__((ext_vector_type(4)));
typedef float f32x8 __attribute__((ext_vector_type(8)));
typedef float f32x16 __attribute__((ext_vector_type(16)));
typedef unsigned u32x2 __attribute__((ext_vector_type(2)));
typedef unsigned u32x4 __attribute__((ext_vector_type(4)));
typedef int i32x4 __attribute__((ext_vector_type(4)));
typedef int i32x8 __attribute__((ext_vector_type(8)));

constexpr int DM = 1024, NBATCH = 4, SEQ = 4096, DEPTH = 4, NCTX = 256;
constexpr int T_LAT = NBATCH * SEQ, T_CTX = NBATCH * NCTX, T_ALL = T_LAT + T_CTX;
constexpr int INW = 6144, ZGW = 10240, FFD = 2816, FFE = 3584, NEXP = 8;
constexpr int OFF_R = 1536, OFF_H = 3584, OFF_D = 5120, OFF_G = 6144;
constexpr int YW = 2048;
constexpr int NCH = 34;
constexpr int SLOT_MAX = 144 * 256;
constexpr float ALPHA = 1.681792830507429f;
constexpr float LN_EPS = 1e-6f;
constexpr int NTHREADS = 512, NWAVES = 8;

enum { I_X = 0, I_C, I_CTX, I_CCTX, I_WMOD, I_BMOD, I_WIN, I_CAW, I_CAB, I_RDEC, I_HCW, I_HCB, I_HW1, I_HB1, I_HW2, I_HB2, I_HW3, I_HFREQ, I_HSKIP,
       I_QN, I_KN, I_WGATE, I_BGATE, I_WBR, I_WO, I_LNG, I_LNB, I_FW1, I_FW3, I_FW2, I_ROUTER, I_MW1, I_MW3, I_MW2, N_IN };

constexpr size_t al256(size_t x) { return (x + 255) / 256 * 256; }
constexpr size_t WS_CTL   = 0;
constexpr size_t CTL_BYTES = 128 * 1024;
constexpr size_t WS_MOD   = WS_CTL + CTL_BYTES;
constexpr size_t WS_ROPE  = al256(WS_MOD + (size_t)DEPTH * 5 * 6144 * 4);
constexpr size_t WS_GF    = al256(WS_ROPE + 2 * 64 * 32 * 4);
constexpr size_t WS_GC    = al256(WS_GF + (size_t)DEPTH * 2 * 512 * 8192 * 2);
constexpr size_t WS_WCAT  = al256(WS_GC + (size_t)DEPTH * 2 * 512 * 512 * 4);
constexpr size_t WS_WB    = al256(WS_WCAT + (size_t)ZGW * DM * 2);
constexpr size_t WS_WO4   = al256(WS_WB + (size_t)4096 * 512 * 2);
constexpr size_t WS_W13   = al256(WS_WO4 + (size_t)1024 * 4096 * 2);
constexpr size_t WS_W13D  = WS_W13 + (size_t)NEXP * 2 * FFE * DM;
constexpr size_t WS_W2D   = WS_W13D + (size_t)2 * FFD * DM;
static_assert(WS_W2D + (size_t)DM * FFD <= WS_W13 + (size_t)NEXP * 2 * FFE * DM * 2, "dense FFN weights must fit in the W13 region");
constexpr size_t WS_W2    = al256(WS_W13 + (size_t)NEXP * 2 * FFE * DM * 2);
constexpr size_t WS_XF    = al256(WS_W2 + (size_t)NEXP * DM * FFE * 2);
constexpr size_t WS_U     = al256(WS_XF + (size_t)T_ALL * DM * 4);
constexpr size_t WS_ZG    = al256(WS_U + (size_t)T_ALL * DM * 2);
constexpr size_t WS_HID   = WS_ZG;
constexpr size_t WS_XG    = al256(WS_HID + (size_t)SLOT_MAX * FFE * 2);
constexpr size_t WS_Y     = al256(WS_ZG + (size_t)T_ALL * ZGW * 2);
constexpr size_t WS_YO    = WS_Y;
constexpr size_t WS_ZHT   = al256(WS_Y + (size_t)T_ALL * YW * 2);
constexpr size_t WS_ZHTC  = al256(WS_ZHT + (size_t)NBATCH * 1536 * SEQ * 2);
constexpr size_t WS_YHT   = al256(WS_ZHTC + (size_t)NBATCH * 1536 * NCTX * 2);
constexpr size_t WS_YHTC  = al256(WS_YHT + (size_t)NBATCH * 512 * SEQ * 2);
constexpr size_t WS_QP    = al256(WS_YHTC + (size_t)NBATCH * 512 * NCTX * 2);
constexpr size_t WS_QC    = al256(WS_QP + (size_t)NBATCH * 4 * SEQ * 128 * 2);
constexpr size_t WS_KALL  = al256(WS_QC + (size_t)NBATCH * 4 * NCTX * 128 * 2);
constexpr size_t WS_VALL  = al256(WS_KALL + (size_t)NBATCH * 2 * 4352 * 128 * 2);
constexpr size_t WS_KVS   = al256(WS_VALL + (size_t)NBATCH * 2 * 4352 * 128 * 2);
constexpr size_t WS_PAIR  = al256(WS_KVS + (size_t)NBATCH * 4 * 2 * NCH * 16384 * 4);
constexpr size_t WS_U8M   = al256(WS_PAIR + (size_t)T_ALL * 32);
constexpr size_t WS_WG8   = al256(WS_U8M + (size_t)T_ALL * DM);
constexpr size_t WS_END   = al256(WS_WG8 + (size_t)4096 * DM);
static_assert(WS_XG + (size_t)SLOT_MAX * DM * 2 <= WS_Y, "H + XG must fit inside the ZG region");
static_assert(WS_YO + (size_t)SLOT_MAX * DM * 2 <= WS_ZHTC, "YO must fit inside Y + ZHT");

constexpr int CW_BAR = 0;
constexpr int CW_QHEAD = 4096;
constexpr int CW_MOE = 8192;

__device__ __forceinline__ unsigned pk2(float lo, float hi) { unsigned r; asm("v_cvt_pk_bf16_f32 %0, %1, %2" : "=v"(r) : "v"(lo), "v"(hi)); return r; }
__device__ __forceinline__ bf16_t f2bf(float f) { return (bf16_t)(pk2(f, 0.f) & 0xffffu); }
__device__ __forceinline__ float bflo(unsigned w) { return __uint_as_float(w << 16); }
__device__ __forceinline__ float bfhi(unsigned w) { return __uint_as_float(w & 0xffff0000u); }
__device__ __forceinline__ f32x4 bf4_f32(u32x2 w) { f32x4 f; f.x = bflo(w.x); f.y = bfhi(w.x); f.z = bflo(w.y); f.w = bfhi(w.y); return f; }
__device__ __forceinline__ u32x2 f32_bf4(f32x4 v) { u32x2 w; w.x = pk2(v.x, v.y); w.y = pk2(v.z, v.w); return w; }
__device__ __forceinline__ float bf1(bf16_t h) { return __uint_as_float(((unsigned)h) << 16); }
__device__ __forceinline__ void unpack8(u32x4 w, float* f) { f[0] = bflo(w.x); f[1] = bfhi(w.x); f[2] = bflo(w.y); f[3] = bfhi(w.y); f[4] = bflo(w.z); f[5] = bfhi(w.z); f[6] = bflo(w.w); f[7] = bfhi(w.w); }
__device__ __forceinline__ u32x4 pack8(const float* f) { u32x4 w; w.x = pk2(f[0], f[1]); w.y = pk2(f[2], f[3]); w.z = pk2(f[4], f[5]); w.w = pk2(f[6], f[7]); return w; }
__device__ __forceinline__ float shfl_xor_l(float v, int o, int lane) { return __int_as_float(__builtin_amdgcn_ds_bpermute((lane ^ o) << 2, __float_as_int(v))); }
__device__ __forceinline__ float wave_sum(float v, int lane) {
#pragma unroll
    for (int o = 1; o < 64; o <<= 1) v += shfl_xor_l(v, o, lane);
    return v;
}
__device__ __forceinline__ float sigmoidf_(float x) { return __builtin_amdgcn_rcpf(1.f + __expf(-x)); }
__device__ __forceinline__ float siluf_(float x) { return x * sigmoidf_(x); }
__device__ __forceinline__ int crow(int r, int hi) { return (r & 3) + 8 * (r >> 2) + 4 * hi; }
#define LDS_WAIT() asm volatile("s_waitcnt lgkmcnt(0)" ::: "memory")
constexpr float F8_WSCALE = 64.0f;
__device__ __forceinline__ float clamp448(float x) { return __builtin_amdgcn_fmed3f(x, -448.f, 448.f); }
__device__ __forceinline__ unsigned pk4_fp8(float a, float b, float c, float d) {
    int w = __builtin_amdgcn_cvt_pk_fp8_f32(clamp448(a), clamp448(b), 0, false); w = __builtin_amdgcn_cvt_pk_fp8_f32(clamp448(c), clamp448(d), w, true); return (unsigned)w; }

#define XB_TMO      128
#define XB_XCNT(j)  (256  + 64 * (j))
#define XB_XSUB(j)  (1280 + 64 * (j))
#define XB_XGEN(j)  (2304 + 64 * (j))
#define XB_TOP      3328
#define XB_TOPGEN   3392
#define XCD_BAR_WORDS 3456
#define XB_SPIN_CAP (1u << 22)

__device__ __forceinline__ unsigned xb_ld(unsigned* p)              { return __hip_atomic_load(p, __ATOMIC_RELAXED, __HIP_MEMORY_SCOPE_AGENT); }
__device__ __forceinline__ unsigned xb_add(unsigned* p, unsigned v) { return __hip_atomic_fetch_add(p, v, __ATOMIC_RELAXED, __HIP_MEMORY_SCOPE_AGENT); }
__device__ __forceinline__ unsigned xb_xcc_id() { return (unsigned)__builtin_amdgcn_s_getreg((3 << 11) | 20) & 0xFu; }
#define XB_SPIN(cond, bar) do { unsigned _sp = 0; while (cond) { __builtin_amdgcn_s_sleep(1); \
    if ((++_sp & 255u) == 0u) { if (xb_ld(&(bar)[XB_TMO])) break; if (_sp > XB_SPIN_CAP) { atomicAdd(&(bar)[XB_TMO], 1u); break; } } } } while (0)

struct XcdBarrier { unsigned* bar; unsigned x; volatile LAS unsigned* st; };

__device__ __forceinline__ XcdBarrier xcd_barrier_post(unsigned* bar, volatile LAS unsigned* st) {
    XcdBarrier b; b.bar = bar; b.x = xb_xcc_id(); b.st = st;
    if (threadIdx.x == 0) (void)xb_add(&bar[XB_XCNT(b.x)], 1u);
    return b;
}
__device__ __forceinline__ void xcd_barrier_complete(unsigned* bar, unsigned x, unsigned& nloc, unsigned& nx) {
    const unsigned G = gridDim.x * gridDim.y * gridDim.z;
    unsigned sum, cnt, mine, sp = 0u;
    for (;;) {
        sum = 0u; cnt = 0u; mine = 0u;
#pragma unroll
        for (unsigned j = 0; j < 16; ++j) { const unsigned c = xb_ld(&bar[XB_XCNT(j)]); sum += c; cnt += (c > 0u) ? 1u : 0u; mine = (j == x) ? c : mine; }
        if (sum == G) break;
        __builtin_amdgcn_s_sleep(1);
        if ((++sp & 255u) == 0u) { if (xb_ld(&bar[XB_TMO])) break; if (sp > XB_SPIN_CAP) { atomicAdd(&bar[XB_TMO], 1u); break; } }
    }
    nloc = mine > 0u ? mine : 1u; nx = cnt > 0u ? cnt : 1u;
}
__device__ __forceinline__ void xcd_barrier(const XcdBarrier& b) {
    asm volatile("s_waitcnt vmcnt(0)" ::: "memory");
    __syncthreads();
    int t0_ = threadIdx.x; asm volatile("" : "+v"(t0_));
    if (t0_ == 0) {
        unsigned* bar = b.bar; unsigned bx = b.x;
        asm volatile("" : "+s"(bar), "+s"(bx));
        __builtin_amdgcn_s_waitcnt(0);
        unsigned nloc = b.st[0], nx = b.st[1];
        if (nloc == 0u) { xcd_barrier_complete(bar, bx, nloc, nx); b.st[0] = nloc; b.st[1] = nx; }
        const unsigned old = xb_add(&bar[XB_XSUB(bx)], 1u);
        const unsigned gen = old / nloc;
        if (old + 1u == (gen + 1u) * nloc) {
            __builtin_amdgcn_fence(__ATOMIC_RELEASE, "agent");
            asm volatile("s_waitcnt vmcnt(0)" ::: "memory");
            const unsigned og = xb_add(&bar[XB_TOP], 1u);
            const unsigned tg = og / nx;
            if (og + 1u == (tg + 1u) * nx) xb_add(&bar[XB_TOPGEN], 1u);
            else XB_SPIN(xb_ld(&bar[XB_TOPGEN]) == tg, bar);
            __builtin_amdgcn_fence(__ATOMIC_ACQUIRE, "agent");
            xb_add(&bar[XB_XGEN(bx)], 1u);
            asm volatile("s_waitcnt vmcnt(0)" ::: "memory");
        } else {
            XB_SPIN(xb_ld(&bar[XB_XGEN(bx)]) == gen, bar);
            __builtin_amdgcn_fence(__ATOMIC_ACQUIRE, "agent");
            asm volatile("s_waitcnt vmcnt(0)" ::: "memory");
        }
    }
    __syncthreads();
}

namespace pg8 {
constexpr int BM = 256, BK = 64, HALF = 128, HTB = HALF * BK * 2, STAGE_BYTES = 8 * HTB, NXCD = 8, WGM = 8;
__device__ __forceinline__ int lds_byte(int r, int c) { const int st = (r >> 4) * 2 + (c >> 5), rr = r & 15, cc = c & 31, ob = rr * 64 + cc * 2; return st * 1024 + (ob ^ (((ob >> 9) & 1) << 5)); }
__device__ __forceinline__ void stage_rc(int b, int& R, int& C) { const int st = b / 1024, sb = b % 1024, swz = sb ^ (((sb >> 9) & 1) << 5); R = (st >> 1) * 16 + swz / 64; C = (st & 1) * 32 + (swz % 64) / 2; }
__device__ __forceinline__ int perm32(int rho) { const int n = rho >> 4, i = rho & 15; return 8 * (i >> 2) + 4 * n + (i & 3); }

struct Unit { const char* A; const char* B; int pm, pn, e, pad; };
struct Gemm { int K, lda, ldb; int kstep = BK * 2, kstepb = BK * 2; };

struct GSched {
    int nM, nN, nwg, G, c;
    const char* A; const char* B; unsigned a_tile, b_tile, a_col; int a_sh;
    __device__ void init(int nM_, int nN_, int G_, int c_, const void* A_, unsigned a_tile_, const void* B_, unsigned b_tile_, int a_sh_ = 30, unsigned a_col_ = 0) {
        nM = nM_; nN = nN_; nwg = nM * nN; G = G_; c = c_; A = (const char*)A_; B = (const char*)B_; a_tile = a_tile_; b_tile = b_tile_; a_sh = a_sh_; a_col = a_col_; }
    __device__ __forceinline__ bool next(int i, Unit& u) const {
        const int L = i * G + c; if (L >= nwg) return false;
        int wgid = L; { const int q = nwg / NXCD, r = nwg % NXCD, xcd = wgid % NXCD, off = wgid / NXCD; wgid = (xcd < r ? xcd * (q + 1) : r * (q + 1) + (xcd - r) * q) + off; }
        const int nig = WGM * nN, gid = wgid / nig, fm = gid * WGM, gsz = (nM - fm) < WGM ? (nM - fm) : WGM;
        u.pm = fm + ((wgid % nig) % gsz); u.pn = (wgid % nig) / gsz; u.e = 0; u.pad = 0;
        u.A = A + (size_t)((unsigned)u.pm * a_tile + (unsigned)(u.pn >> a_sh) * a_col); u.B = B + (size_t)((unsigned)u.pn * b_tile); return true;
    }
};
struct SameSched { GSched s; __device__ __forceinline__ bool next(int i, Unit& u) const { Unit t; if (!s.next(i, t)) return false; s.next(0, u); return true; } };
struct MoeSched {
    int G, c, nN, ntiles; int ts[NEXP];
    const char* A; const char* B; unsigned a_tile, b_tile;
    __device__ __forceinline__ bool next(int i, Unit& u) const {
        const int L = i * G + c; if (L >= ntiles * nN) return false;
        const int rt = L / nN, pn = L % nN; int e = 0;
#pragma unroll
        for (int k = 1; k < NEXP; ++k) e += (rt >= ts[k]) ? 1 : 0;
        u.pm = rt; u.pn = pn; u.e = e; u.pad = 0; u.A = A + (size_t)((unsigned)rt * a_tile); u.B = B + (size_t)((unsigned)(e * nN + pn) * b_tile); return true;
    }
};

__device__ __forceinline__ unsigned cvt_pk_bf16(float lo, float hi) { return pk2(lo, hi); }

template <bool F8 = false, int PROBE = 0, class Epi, class Sched>
__device__ __forceinline__ void gemm_phase(LAS unsigned char* lds, const Gemm g, const Sched& S, const Epi& E, const int tid) {
    const int wid = __builtin_amdgcn_readfirstlane(tid >> 6), lane = tid & 63, wr = wid >> 2, wc = wid & 3, fr = lane & 15, fq = lane >> 4;
    const int K = g.K, nt = K / BK;
    unsigned voffA[2], voffB[2];
#pragma unroll
    for (int i = 0; i < 2; ++i) { int R, C; stage_rc(tid * 16 + i * 8192, R, C); const int Rb = Epi::PERM ? ((R & ~31) + perm32(R & 31)) : R;
        voffA[i] = (unsigned)(R * g.lda + C) * 2u; voffB[i] = (unsigned)(Rb * g.ldb + C) * 2u; }
    const size_t kstep = (size_t)g.kstep, kstepb = (size_t)g.kstepb;
    const size_t hstepA = (size_t)HALF * g.lda * 2, hstepB = (size_t)HALF * g.ldb * 2;
    const unsigned ldsw = (unsigned)wid * 1024u;
    const int aoff = lds_byte(wr * 64 + fr, fq * 8), boff = lds_byte(wc * 32 + fr, fq * 8);
#define PG8_SA(b, h) (((b) * 2 + (h)) * HTB)
#define PG8_SB(b, h) ((4 + (b) * 2 + (h)) * HTB)
#define PG8_STAGE(bufoff, gbase, voff) do { if constexpr (PROBE == 1 || PROBE == 3) break; _Pragma("unroll") for (int _i = 0; _i < 2; ++_i) { unsigned _vo = (voff)[_i]; if constexpr (F8) asm volatile("" : "+v"(_vo));     \
        __builtin_amdgcn_global_load_lds((const unsigned*)((const char*)(gbase) + _vo), (LAS unsigned*)(lds + (bufoff) + ldsw + _i * 8192), 16, 0, 0); } } while (0)
#define PG8_CAT(x0, x1) __builtin_shufflevector(__builtin_bit_cast(i32x4, x0), __builtin_bit_cast(i32x4, x1), 0, 1, 2, 3, 4, 5, 6, 7)
#define PG8_LDA(dst, b, h) do { if constexpr (PROBE == 3) { _Pragma("unroll") for (int m = 0; m < 4; ++m) asm volatile("" : "+v"(dst[m][0]), "+v"(dst[m][1])); break; } _Pragma("unroll") for (int m = 0; m < 4; ++m) { const bf16x8 _x0 = *(const LAS bf16x8*)(lds + PG8_SA(b, h) + aoff + m * 2048), _x1 = *(const LAS bf16x8*)(lds + PG8_SA(b, h) + aoff + m * 2048 + 1024); \
        if constexpr (F8) dst##8[m] = PG8_CAT(_x0, _x1); else { dst[m][0] = _x0; dst[m][1] = _x1; } } } while (0)
#define PG8_LDB(dst, b, h) do { if constexpr (PROBE == 3) { _Pragma("unroll") for (int n = 0; n < 2; ++n) asm volatile("" : "+v"(dst[n][0]), "+v"(dst[n][1])); break; } _Pragma("unroll") for (int n = 0; n < 2; ++n) { const bf16x8 _x0 = *(const LAS bf16x8*)(lds + PG8_SB(b, h) + boff + n * 2048), _x1 = *(const LAS bf16x8*)(lds + PG8_SB(b, h) + boff + n * 2048 + 1024); \
        if constexpr (F8) dst##8[n] = PG8_CAT(_x0, _x1); else { dst[n][0] = _x0; dst[n][1] = _x1; } } } while (0)
#define PG8_MMA(ai, bj, At, Bt) do { if constexpr (PROBE == 2) { _Pragma("unroll") for (int m = 0; m < 4; ++m) asm volatile("" :: "v"(At[m][0]), "v"(At[m][1])); _Pragma("unroll") for (int n = 0; n < 2; ++n) asm volatile("" :: "v"(Bt[n][0]), "v"(Bt[n][1])); break; } __builtin_amdgcn_s_setprio(1); _Pragma("unroll") for (int m = 0; m < 4; ++m) _Pragma("unroll") for (int n = 0; n < 2; ++n) { \
        if constexpr (F8) asm volatile("v_mfma_f32_16x16x128_f8f6f4 %0, %1, %2, %0" : "+v"(acc[ai][bj][m][n]) : "v"(Bt##8[n]), "v"(At##8[m]));     \
        else { _Pragma("unroll") for (int k = 0; k < 2; ++k) acc[ai][bj][m][n] = __builtin_amdgcn_mfma_f32_16x16x32_bf16(Bt[n][k], At[m][k], acc[ai][bj][m][n], 0, 0, 0); } } __builtin_amdgcn_s_setprio(0); } while (0)
#define PG8_WAIT_V(n) asm volatile("s_waitcnt vmcnt(" #n ")" ::: "memory")
#define PG8_WAIT_L(n) asm volatile("s_waitcnt lgkmcnt(" #n ")" ::: "memory")
#define PG8_BAR __builtin_amdgcn_s_barrier()
#define PG8_SCHED __builtin_amdgcn_sched_barrier(0)
    Unit cur, nxt; int ui = 0;
    if (!S.next(0, cur)) return;
    f32x4 acc[2][2][4][2];
    float zero_ = 0.f; asm volatile("" : "+v"(zero_));
#pragma unroll
    for (int a = 0; a < 2; ++a)
#pragma unroll
        for (int b = 0; b < 2; ++b)
#pragma unroll
            for (int m = 0; m < 4; ++m)
#pragma unroll
                for (int n = 0; n < 2; ++n) acc[a][b][m][n] = (f32x4){zero_, zero_, zero_, zero_};
    bf16x8 At[4][2], B0[2][2], B1[2][2]; i32x8 At8[4], B08[2], B18[2];
    if constexpr (PROBE == 3) { _Pragma("unroll") for (int m = 0; m < 4; ++m) { At[m][0] = (bf16x8)0; At[m][1] = (bf16x8)0; } _Pragma("unroll") for (int n = 0; n < 2; ++n) { B0[n][0] = (bf16x8)0; B0[n][1] = (bf16x8)0; B1[n][0] = (bf16x8)0; B1[n][1] = (bf16x8)0; } }
    const char* cA = cur.A; const char* cB = cur.B;
    PG8_STAGE(PG8_SB(0, 0), cB, voffB); PG8_STAGE(PG8_SA(0, 0), cA, voffA); PG8_STAGE(PG8_SB(0, 1), cB + hstepB, voffB); PG8_STAGE(PG8_SA(0, 1), cA + hstepA, voffA);
    if (wr == 1) PG8_BAR;
    PG8_WAIT_V(4); PG8_BAR;
    PG8_STAGE(PG8_SB(1, 0), cB + kstepb, voffB); PG8_STAGE(PG8_SA(1, 0), cA + kstep, voffA); PG8_STAGE(PG8_SB(1, 1), cB + hstepB + kstepb, voffB); PG8_STAGE(PG8_SA(1, 1), cA + hstepA + kstep, voffA);
    PG8_WAIT_V(8); PG8_BAR;
    for (;;) {
        const bool has_next = S.next(ui + 1, nxt);
        const char* nA = has_next ? nxt.A : cA; const char* nB = has_next ? nxt.B : cB;
#pragma clang loop unroll(disable)
        for (int t = 0; t < nt; t += 2) {
            const bool last = (t == nt - 2), first = (t == 0);
            const char* a1 = cA + (size_t)(t + 1) * kstep;
            const char* a2 = last ? nA : cA + (size_t)(t + 2) * kstep; const char* b2 = last ? nB : cB + (size_t)(t + 2) * kstepb;
            const char* a3 = a2 + kstep; const char* b3 = b2 + kstepb;
            PG8_LDB(B0, 0, 0); PG8_SCHED; PG8_LDA(At, 0, 0); if (!first) PG8_STAGE(PG8_SA(1, 1), a1 + hstepA, voffA);
            PG8_WAIT_L(8); PG8_BAR; PG8_WAIT_L(0); PG8_MMA(0, 0, At, B0); PG8_BAR; PG8_SCHED;
            PG8_LDB(B1, 0, 1); PG8_STAGE(PG8_SB(0, 0), b2, voffB);
            PG8_BAR; PG8_WAIT_L(0); PG8_MMA(0, 1, At, B1); PG8_BAR;
            PG8_LDA(At, 0, 1); PG8_STAGE(PG8_SA(0, 0), a2, voffA);
            PG8_BAR; PG8_WAIT_L(0); PG8_MMA(1, 0, At, B0); PG8_BAR; PG8_SCHED;
            PG8_STAGE(PG8_SB(0, 1), b2 + hstepB, voffB);
            if (first && ui > 0) { if constexpr (Epi::NST == 16) PG8_WAIT_V(22); else if constexpr (Epi::NST == 8) PG8_WAIT_V(14); else PG8_WAIT_V(6); }
            else PG8_WAIT_V(6);
            PG8_BAR; PG8_MMA(1, 1, At, B1); PG8_BAR;
            PG8_LDB(B0, 1, 0); PG8_SCHED; PG8_LDA(At, 1, 0); PG8_STAGE(PG8_SA(0, 1), a2 + hstepA, voffA);
            PG8_WAIT_L(8); PG8_BAR; PG8_WAIT_L(0); PG8_MMA(0, 0, At, B0); PG8_BAR; PG8_SCHED;
            PG8_LDB(B1, 1, 1); PG8_STAGE(PG8_SB(1, 0), b3, voffB);
            PG8_BAR; PG8_WAIT_L(0); PG8_MMA(0, 1, At, B1); PG8_BAR;
            PG8_LDA(At, 1, 1); PG8_STAGE(PG8_SA(1, 0), a3, voffA);
            PG8_BAR; PG8_WAIT_L(0); PG8_MMA(1, 0, At, B0); PG8_BAR; PG8_SCHED;
            PG8_STAGE(PG8_SB(1, 1), b3 + hstepB, voffB);
            PG8_WAIT_V(6); PG8_BAR; PG8_MMA(1, 1, At, B1); PG8_BAR;
        }
        const auto epre = E.pre(cur, wr, wc, fr, fq); asm volatile("" ::: "memory");
        PG8_STAGE(PG8_SA(1, 1), nA + kstep + hstepA, voffA); asm volatile("" ::: "memory");
        if constexpr (F8) asm volatile("s_nop 15\n\ts_nop 15" ::: "memory");
        E(acc, cur, wr, wc, fr, fq, epre);
        if (!has_next) break;
        asm volatile("" : "+v"(zero_));
#pragma unroll
        for (int a = 0; a < 2; ++a)
#pragma unroll
            for (int b = 0; b < 2; ++b)
#pragma unroll
                for (int m = 0; m < 4; ++m)
#pragma unroll
                    for (int n = 0; n < 2; ++n) acc[a][b][m][n] = (f32x4){zero_, zero_, zero_, zero_};
        cur = nxt; cA = nA; cB = nB; ++ui;
    }
    PG8_WAIT_V(0);
    if (wr == 0) PG8_BAR;
    PG8_BAR;
#undef PG8_SA
#undef PG8_SB
#undef PG8_STAGE
#undef PG8_LDA
#undef PG8_LDB
#undef PG8_MMA
#undef PG8_CAT
#undef PG8_WAIT_V
#undef PG8_WAIT_L
#undef PG8_BAR
#undef PG8_SCHED
}

typedef f32x4 Acc[2][2][4][2];

struct EpiPreNone {};
struct EpiZG { static constexpr bool PERM = true; static constexpr int NST = 16;
    GAS bf16_t* ZG; const GAS float* bgate; float sc;
    struct Pre { f32x4 bv[2][2]; };
    __device__ __forceinline__ Pre pre(const Unit& u, int wr, int wc, int fr, int fq) const {
        const int col0 = u.pn * BM + wc * 32 + 8 * fq; const bool gate = (u.pn >= 24); Pre p;
#pragma unroll
        for (int bj = 0; bj < 2; ++bj)
#pragma unroll
            for (int n = 0; n < 2; ++n) p.bv[bj][n] = gate ? *(const GAS f32x4*)(bgate + (col0 - OFF_G) + bj * HALF + 4 * n) : (f32x4){0.f, 0.f, 0.f, 0.f};
        return p; }
    __device__ __forceinline__ void operator()(const Acc& acc, const Unit& u, int wr, int wc, int fr, int fq, const Pre& p) const {
        const int row0 = u.pm * BM + wr * 64 + fr, col0 = u.pn * BM + wc * 32 + 8 * fq; const bool gate = (u.pn >= 24);
#pragma unroll
        for (int ai = 0; ai < 2; ++ai)
#pragma unroll
            for (int m = 0; m < 4; ++m) { GAS bf16_t* rowp = ZG + (size_t)(row0 + ai * HALF + m * 16) * ZGW + col0;
#pragma unroll
                for (int bj = 0; bj < 2; ++bj) { f32x4 v0 = acc[ai][bj][m][0] * sc + p.bv[bj][0], v1 = acc[ai][bj][m][1] * sc + p.bv[bj][1];
                    if (gate) {
#pragma unroll
                        for (int j = 0; j < 4; ++j) { v0[j] = sigmoidf_(v0[j]); v1[j] = sigmoidf_(v1[j]); } }
                    u32x4 w; w.x = pk2(v0[0], v0[1]); w.y = pk2(v0[2], v0[3]); w.z = pk2(v1[0], v1[1]); w.w = pk2(v1[2], v1[3]);
                    *(GAS u32x4*)(rowp + bj * HALF) = w; } }
    }
};
struct EpiShift { static constexpr bool PERM = true; static constexpr int NST = 16; EpiZG e;
    typedef EpiZG::Pre Pre;
    __device__ __forceinline__ Pre pre(const Unit& u, int wr, int wc, int fr, int fq) const { Unit u2 = u; u2.pn += 24; return e.pre(u2, wr, wc, fr, fq); }
    __device__ __forceinline__ void operator()(const Acc& acc, const Unit& u, int wr, int wc, int fr, int fq, const Pre& p) const { Unit u2 = u; u2.pn += 24; e(acc, u2, wr, wc, fr, fq, p); } };
struct EpiGate { static constexpr bool PERM = true; static constexpr int NST = 16;
    GAS bf16_t* ZG;
    struct Pre { u32x4 gw[2][4][2]; };
    __device__ __forceinline__ Pre pre(const Unit& u, int wr, int wc, int fr, int fq) const {
        const int row0 = u.pm * BM + wr * 64 + fr, col0 = OFF_G + u.pn * BM + wc * 32 + 8 * fq;
        GAS bf16_t* base = ZG + (size_t)row0 * ZGW + col0; Pre p;
#pragma unroll
        for (int ai = 0; ai < 2; ++ai)
#pragma unroll
            for (int m = 0; m < 4; ++m)
#pragma unroll
                for (int bj = 0; bj < 2; ++bj) p.gw[ai][m][bj] = *(const GAS u32x4*)(base + (size_t)(ai * HALF + m * 16) * ZGW + bj * HALF);
        return p; }
    __device__ __forceinline__ void operator()(const Acc& acc, const Unit& u, int wr, int wc, int fr, int fq, const Pre& p) const {
        const int row0 = u.pm * BM + wr * 64 + fr, col0 = OFF_G + u.pn * BM + wc * 32 + 8 * fq;
        GAS bf16_t* base = ZG + (size_t)row0 * ZGW + col0;
#pragma unroll
        for (int ai = 0; ai < 2; ++ai)
#pragma unroll
            for (int m = 0; m < 4; ++m)
#pragma unroll
                for (int bj = 0; bj < 2; ++bj) { float gf[8]; unpack8(p.gw[ai][m][bj], gf);
                    const f32x4 v0 = acc[ai][bj][m][0], v1 = acc[ai][bj][m][1];
                    u32x4 w; w.x = pk2(v0[0] * gf[0], v0[1] * gf[1]); w.y = pk2(v0[2] * gf[2], v0[3] * gf[3]); w.z = pk2(v1[0] * gf[4], v1[1] * gf[5]); w.w = pk2(v1[2] * gf[6], v1[3] * gf[7]);
                    *(GAS u32x4*)(base + (size_t)(ai * HALF + m * 16) * ZGW + bj * HALF) = w; }
    }
};
struct EpiSwiglu { static constexpr bool PERM = true; static constexpr int NST = 8;
    GAS unsigned char* H; int ldh; float sc;
    typedef EpiPreNone Pre; __device__ __forceinline__ Pre pre(const Unit&, int, int, int, int) const { return Pre{}; }
    __device__ __forceinline__ void operator()(const Acc& acc, const Unit& u, int wr, int wc, int fr, int fq, const Pre&) const {
        const int row0 = u.pm * BM + wr * 64 + fr, col0 = u.pn * HALF + wc * 32 + 8 * fq;
#pragma unroll
        for (int ai = 0; ai < 2; ++ai)
#pragma unroll
            for (int m = 0; m < 4; ++m) { GAS unsigned char* rowp = H + (size_t)(row0 + ai * HALF + m * 16) * ldh + col0;
                const f32x4 a0 = acc[ai][0][m][0] * sc, a1 = acc[ai][0][m][1] * sc, b0 = acc[ai][1][m][0] * sc, b1 = acc[ai][1][m][1] * sc;
                float h[8];
#pragma unroll
                for (int j = 0; j < 4; ++j) { h[j] = siluf_(a0[j]) * b0[j]; h[4 + j] = siluf_(a1[j]) * b1[j]; }
                u32x2 w; w.x = pk4_fp8(h[0], h[1], h[2], h[3]); w.y = pk4_fp8(h[4], h[5], h[6], h[7]); *(GAS u32x2*)rowp = w; }
    }
};
struct EpiPlain { static constexpr bool PERM = true; static constexpr int NST = 16;
    GAS bf16_t* O; int ldo; float sc;
    typedef EpiPreNone Pre; __device__ __forceinline__ Pre pre(const Unit&, int, int, int, int) const { return Pre{}; }
    __device__ __forceinline__ void operator()(const Acc& acc, const Unit& u, int wr, int wc, int fr, int fq, const Pre&) const {
        const int row0 = u.pm * BM + wr * 64 + fr, col0 = u.pn * BM + wc * 32 + 8 * fq;
#pragma unroll
        for (int ai = 0; ai < 2; ++ai)
#pragma unroll
            for (int m = 0; m < 4; ++m) { GAS bf16_t* rowp = O + (size_t)(row0 + ai * HALF + m * 16) * ldo + col0;
#pragma unroll
                for (int bj = 0; bj < 2; ++bj) { const f32x4 v0 = acc[ai][bj][m][0] * sc, v1 = acc[ai][bj][m][1] * sc;
                    u32x4 w; w.x = pk2(v0[0], v0[1]); w.y = pk2(v0[2], v0[3]); w.z = pk2(v1[0], v1[1]); w.w = pk2(v1[2], v1[3]);
                    *(GAS u32x4*)(rowp + bj * HALF) = w; } }
    }
};
struct EpiZGNoStore { static constexpr bool PERM = true; static constexpr int NST = 0; float sc;
    typedef EpiPreNone Pre; __device__ __forceinline__ Pre pre(const Unit&, int, int, int, int) const { return Pre{}; }
    __device__ __forceinline__ void operator()(const Acc& acc, const Unit& u, int wr, int wc, int fr, int fq, const Pre&) const {
#pragma unroll
        for (int ai = 0; ai < 2; ++ai)
#pragma unroll
            for (int m = 0; m < 4; ++m)
#pragma unroll
                for (int bj = 0; bj < 2; ++bj) { f32x4 v0 = acc[ai][bj][m][0] * sc, v1 = acc[ai][bj][m][1] * sc;
                    u32x4 w; w.x = pk2(v0[0], v0[1]); w.y = pk2(v0[2], v0[3]); w.z = pk2(v1[0], v1[1]); w.w = pk2(v1[2], v1[3]);
                    asm volatile("" :: "v"(w)); }
    }
};
struct EpiContig { static constexpr bool PERM = true; static constexpr int NST = 16; GAS unsigned char* O; float sc;
    typedef EpiPreNone Pre; __device__ __forceinline__ Pre pre(const Unit&, int, int, int, int) const { return Pre{}; }
    __device__ __forceinline__ void operator()(const Acc& acc, const Unit& u, int wr, int wc, int fr, int fq, const Pre&) const {
        GAS unsigned char* base = O + (size_t)((u.pm * 24 + u.pn) & 511) * 131072u + (size_t)((wr * 4 + wc) * 1024 + (fq * 16 + fr) * 16);
#pragma unroll
        for (int ai = 0; ai < 2; ++ai)
#pragma unroll
            for (int m = 0; m < 4; ++m)
#pragma unroll
                for (int bj = 0; bj < 2; ++bj) { f32x4 v0 = acc[ai][bj][m][0] * sc, v1 = acc[ai][bj][m][1] * sc;
                    u32x4 w; w.x = pk2(v0[0], v0[1]); w.y = pk2(v0[2], v0[3]); w.z = pk2(v1[0], v1[1]); w.w = pk2(v1[2], v1[3]);
                    *(GAS u32x4*)(base + ((ai * 4 + m) * 2 + bj) * 8192) = w; }
    }
};
struct EpiNull { static constexpr bool PERM = true; static constexpr int NST = 0;
    typedef EpiPreNone Pre; __device__ __forceinline__ Pre pre(const Unit&, int, int, int, int) const { return Pre{}; }
    __device__ __forceinline__ void operator()(const Acc& acc, const Unit& u, int wr, int wc, int fr, int fq, const Pre&) const {
#pragma unroll
        for (int ai = 0; ai < 2; ++ai)
#pragma unroll
            for (int bj = 0; bj < 2; ++bj)
#pragma unroll
                for (int m = 0; m < 4; ++m)
#pragma unroll
                    for (int n = 0; n < 2; ++n) asm volatile("" :: "v"(acc[ai][bj][m][n]));
    }
};
}

namespace attn {
constexpr int D = 128, NW = 8, QBLK = 32, KVBLK = 64;
constexpr float SCALE = 0.088388347648318440f;
constexpr float THR = 8.f;
constexpr int LDQ = 128, LDK = 128;
constexpr size_t SHM_V = KVBLK * D * 2, SHM_K = KVBLK * D * 2, SHM_ATTN = 2 * SHM_V + 2 * SHM_K + NW * 64 * 4;
#define KSWZ(row, colB) ((row) * 256 + ((colB) ^ (((row) & 7) << 4)))
#define SBAR() __builtin_amdgcn_sched_barrier(0)
__device__ __forceinline__ unsigned cvtpk(float lo, float hi) { unsigned r; asm volatile("v_cvt_pk_bf16_f32 %0, %1, %2" : "=v"(r) : "v"(lo), "v"(hi)); return r; }
__device__ __forceinline__ bf16x8 ld8(const bf16_t* p) { return *reinterpret_cast<const bf16x8*>(p); }

__device__ __forceinline__ void partialSM(f32x16& p0, f32x16& p1, float& m_reg, float& mn, float& alpha) {
  constexpr float C = SCALE * 1.4426950408889634f;
  float pmax = p0[0]; for (int r = 1; r < 16; ++r) pmax = fmaxf(pmax, p0[r]); for (int r = 0; r < 16; ++r) pmax = fmaxf(pmax, p1[r]);
  { auto rr = __builtin_amdgcn_permlane32_swap(__float_as_uint(pmax), __float_as_uint(pmax), false, false);
    pmax = fmaxf(__uint_as_float(rr[0]), __uint_as_float(rr[1])); }
  if (__builtin_expect(__all(pmax - m_reg <= THR / SCALE), 1)) { mn = m_reg; alpha = 1.f; }
  else { mn = fmaxf(m_reg, pmax); alpha = __builtin_amdgcn_exp2f((m_reg - mn) * C); m_reg = mn; }
  float mnC = -mn * C;
  for (int r = 0; r < 16; ++r) p0[r] = fmaf(p0[r], C, mnC); for (int r = 0; r < 16; ++r) p1[r] = fmaf(p1[r], C, mnC);
  for (int r = 0; r < 16; ++r) p0[r] = __builtin_amdgcn_exp2f(p0[r]);
}
__device__ __forceinline__ void finishSM(f32x16& p0, f32x16& p1, float alpha, float& l_reg, bf16x8& pa0, bf16x8& pa1, bf16x8& pa2, bf16x8& pa3) {
  for (int r = 0; r < 16; ++r) p1[r] = __builtin_amdgcn_exp2f(p1[r]);
  float ps = 0; for (int r = 0; r < 16; ++r) ps += p0[r]; for (int r = 0; r < 16; ++r) ps += p1[r];
  { auto rr = __builtin_amdgcn_permlane32_swap(__float_as_uint(ps), __float_as_uint(ps), false, false);
    ps = __uint_as_float(rr[0]) + __uint_as_float(rr[1]); }
  l_reg = l_reg * alpha + ps;
#define PK4(P, BASE, OUT) do { unsigned a0 = cvtpk(P[BASE + 0], P[BASE + 1]), a1 = cvtpk(P[BASE + 2], P[BASE + 3]);   \
    unsigned b0 = cvtpk(P[BASE + 4], P[BASE + 5]), b1 = cvtpk(P[BASE + 6], P[BASE + 7]);                              \
    auto r0 = __builtin_amdgcn_permlane32_swap(a0, b0, false, false); auto r1 = __builtin_amdgcn_permlane32_swap(a1, b1, false, false); \
    u32x4 w = {r0[0], r1[0], r0[1], r1[1]}; OUT = *reinterpret_cast<bf16x8*>(&w); } while (0)
  PK4(p0, 0, pa0); PK4(p0, 8, pa1); PK4(p1, 0, pa2); PK4(p1, 8, pa3);
#undef PK4
}
__device__ __forceinline__ void qkt(f32x16& p0, f32x16& p1, const bf16_t* Ks, const bf16x8* qr, int r32, int hi) {
  p0 = f32x16{}; p1 = f32x16{};
  for (int d0 = 0; d0 < 8; ++d0) { int cb = (d0 * 16 + hi * 8) * 2;
    bf16x8 b0 = *reinterpret_cast<const bf16x8*>((const char*)Ks + KSWZ(r32, cb));
    bf16x8 b1 = *reinterpret_cast<const bf16x8*>((const char*)Ks + KSWZ(32 + r32, cb));
    p0 = __builtin_amdgcn_mfma_f32_32x32x16_bf16(b0, qr[d0], p0, 0, 0, 0);
    p1 = __builtin_amdgcn_mfma_f32_32x32x16_bf16(b1, qr[d0], p1, 0, 0, 0); }
}
__device__ __forceinline__ int v_st(int k, int c) { const int kk = (k & ~0xC) | ((k & 4) << 1) | ((k & 8) >> 1); return ((kk >> 3) * 4 + (c >> 5)) * 512 + ((kk & 7) * 32 + (c & 31)) * 2; }
__device__ __forceinline__ int v_rd_base(int lane) { return ((lane & 3) << 3) | (((lane >> 2) & 3) << 6) | (((lane >> 4) & 1) << 5) | (((lane >> 5) & 1) << 8); }
constexpr int v_rd_off(int d0, int ks, int half) { return d0 * 512 + ks * 4096 + half * 2048; }
template <int OFF> __device__ __forceinline__ s16x4 tr_read(int vb) {
  s16x4 r; asm volatile("ds_read_b64_tr_b16 %0, %1 offset:%2" : "=&v"(r) : "v"(vb), "i"(OFF) : "memory"); return r;
}
template <int D0> __device__ __forceinline__ void pv_one(f32x16& od, int vb, bf16x8 pa0, bf16x8 pa1, bf16x8 pa2, bf16x8 pa3) {
  const s16x4 l0 = tr_read<v_rd_off(D0, 0, 0)>(vb), h0 = tr_read<v_rd_off(D0, 0, 1)>(vb), l1 = tr_read<v_rd_off(D0, 1, 0)>(vb), h1 = tr_read<v_rd_off(D0, 1, 1)>(vb);
  const s16x4 l2 = tr_read<v_rd_off(D0, 2, 0)>(vb), h2 = tr_read<v_rd_off(D0, 2, 1)>(vb), l3 = tr_read<v_rd_off(D0, 3, 0)>(vb), h3 = tr_read<v_rd_off(D0, 3, 1)>(vb);
  asm volatile("s_waitcnt lgkmcnt(0)" ::: "memory"); SBAR();
#define PK(L, H) (bf16x8){L[0], L[1], L[2], L[3], H[0], H[1], H[2], H[3]}
  od = __builtin_amdgcn_mfma_f32_32x32x16_bf16(pa0, PK(l0, h0), od, 0, 0, 0);
  od = __builtin_amdgcn_mfma_f32_32x32x16_bf16(pa1, PK(l1, h1), od, 0, 0, 0);
  od = __builtin_amdgcn_mfma_f32_32x32x16_bf16(pa2, PK(l2, h2), od, 0, 0, 0);
  od = __builtin_amdgcn_mfma_f32_32x32x16_bf16(pa3, PK(l3, h3), od, 0, 0, 0);
#undef PK
}
__device__ __forceinline__ void pv_d0(f32x16* o, int vb, bf16x8 pa0, bf16x8 pa1, bf16x8 pa2, bf16x8 pa3) {
  pv_one<0>(o[0], vb, pa0, pa1, pa2, pa3); pv_one<1>(o[1], vb, pa0, pa1, pa2, pa3); pv_one<2>(o[2], vb, pa0, pa1, pa2, pa3); pv_one<3>(o[3], vb, pa0, pa1, pa2, pa3);
}
__device__ __forceinline__ void attn_dense_body(const bf16_t* __restrict__ Qb, const bf16_t* __restrict__ Kh, const bf16_t* __restrict__ Vh,
                                                bf16_t* __restrict__ Ob, int ldo, int seq, char* lds, const int tid) {
  const int wid = tid >> 6, lane = tid & 63, r32 = lane & 31, hi = lane >> 5;
  bf16_t* V_lds = (bf16_t*)lds; bf16_t* K_lds = (bf16_t*)(lds + 2 * SHM_V);
  float* ws = (float*)(lds + 2 * SHM_V + 2 * SHM_K) + wid * 64; float* li_l = ws; float* al_l = ws + 32;
  float m_reg = -1e30f, l_reg = 0; f32x16 o[4] = {}; bf16x8 qr[8];
  const bf16_t* Qw = Qb + (long)(wid * QBLK + r32) * LDQ + hi * 8;
#pragma unroll
  for (int d0 = 0; d0 < 8; ++d0) qr[d0] = ld8(Qw + d0 * 16);
  const int sr = tid >> 4, sc = (tid & 15) * 8, vst0 = v_st(sr, sc), vst1 = v_st(32 + sr, sc);
  const int vb0 = (int)(uintptr_t)V_lds + v_rd_base(lane);
  struct { bf16x8 vs0, vs1, ks0, ks1; } sr_[2];
#define SLOAD(i, k0) do { sr_[i].vs0 = ld8(&Vh[(long)((k0) + sr) * LDK + sc]); sr_[i].vs1 = ld8(&Vh[(long)((k0) + 32 + sr) * LDK + sc]); \
    sr_[i].ks0 = ld8(&Kh[(long)((k0) + sr) * LDK + sc]); sr_[i].ks1 = ld8(&Kh[(long)((k0) + 32 + sr) * LDK + sc]); } while (0)
#define SWRITE(b, i) do { *(bf16x8*)((char*)V_lds + (b) * SHM_V + vst0) = sr_[i].vs0;          \
    *(bf16x8*)((char*)V_lds + (b) * SHM_V + vst1) = sr_[i].vs1; int kc = sc * 2;               \
    *(bf16x8*)((char*)K_lds + (b) * SHM_K + KSWZ(sr, kc)) = sr_[i].ks0;                       \
    *(bf16x8*)((char*)K_lds + (b) * SHM_K + KSWZ(32 + sr, kc)) = sr_[i].ks1; } while (0)
#define SWAIT() asm volatile("s_waitcnt vmcnt(4)" ::: "memory")
#define RESC(a) do { if (__any((a) < 1.f)) { if (hi == 0) al_l[r32] = (a); asm volatile("s_waitcnt lgkmcnt(0)" ::: "memory"); \
    for (int d = 0; d < 4; ++d) for (int r = 0; r < 16; ++r) o[d][r] *= al_l[crow(r, hi)]; } } while (0)
  f32x16 pA0, pA1, pB0, pB1; float mnA, mnB, alA, alB; bf16x8 pa0, pa1, pa2, pa3; const int NT = seq / KVBLK;
  constexpr int SE = 0, SO = 1;
  SLOAD(SE, 0); asm volatile("s_waitcnt vmcnt(0)" ::: "memory"); SWRITE(0, SE); __syncthreads();
  qkt(pA0, pA1, K_lds, qr, r32, hi); partialSM(pA0, pA1, m_reg, mnA, alA);
  SLOAD(SO, KVBLK); if (2 < NT) SLOAD(SE, 2 * KVBLK);
  SWAIT(); SWRITE(1, SO); __syncthreads();
  for (int j = 1; j + 1 < NT; j += 2) {
    SBAR(); qkt(pB0, pB1, (bf16_t*)((char*)K_lds + SHM_K), qr, r32, hi);
    finishSM(pA0, pA1, alA, l_reg, pa0, pa1, pa2, pa3); SBAR();
    SLOAD(SO, (j + 2) * KVBLK); SBAR();
    pv_d0(o, vb0, pa0, pa1, pa2, pa3); partialSM(pB0, pB1, m_reg, mnB, alB);
    __syncthreads(); SWAIT(); SWRITE(0, SE);
    RESC(alB); __syncthreads();
    SBAR(); qkt(pA0, pA1, K_lds, qr, r32, hi);
    finishSM(pB0, pB1, alB, l_reg, pa0, pa1, pa2, pa3); SBAR();
    if (j + 3 < NT) SLOAD(SE, (j + 3) * KVBLK); SBAR();
    pv_d0(o, vb0 + (int)SHM_V, pa0, pa1, pa2, pa3); partialSM(pA0, pA1, m_reg, mnA, alA);
    __syncthreads(); SWAIT(); SWRITE(1, SO);
    RESC(alA); __syncthreads();
  }
  SBAR(); qkt(pB0, pB1, (bf16_t*)((char*)K_lds + SHM_K), qr, r32, hi);
  finishSM(pA0, pA1, alA, l_reg, pa0, pa1, pa2, pa3); SBAR();
  pv_d0(o, vb0, pa0, pa1, pa2, pa3); partialSM(pB0, pB1, m_reg, mnB, alB);
  __syncthreads(); RESC(alB);
  finishSM(pB0, pB1, alB, l_reg, pa0, pa1, pa2, pa3); SBAR();
  pv_d0(o, vb0 + (int)SHM_V, pa0, pa1, pa2, pa3);
  if (hi == 0) li_l[r32] = l_reg; asm volatile("s_waitcnt lgkmcnt(0)" ::: "memory");
  float rli[16];
#pragma unroll
  for (int r = 0; r < 16; ++r) rli[r] = __builtin_amdgcn_rcpf(li_l[crow(r, hi)]);
  int wid_o = __builtin_amdgcn_readfirstlane(wid); asm volatile("" : "+s"(wid_o));
  bf16_t* Ow = Ob + (long)(wid_o * QBLK) * ldo;
  int lane_o = lane; asm volatile("" : "+v"(lane_o)); const int r32o = lane_o & 31, hio = lane_o >> 5;
#pragma unroll
  for (int r = 0; r < 16; ++r) { int orow = crow(r, hio);
    for (int d0 = 0; d0 < 4; ++d0) Ow[(long)orow * ldo + d0 * 32 + r32o] = f2bf(o[d0][r] * rli[r]); }
  __syncthreads();
#undef SLOAD
#undef SWRITE
#undef SWAIT
#undef RESC
}
}

struct Args { const float* in[N_IN]; float* out; unsigned char* ws; int ph_lo, ph_hi; };
struct Frame {
    LAS unsigned char* lds;
    unsigned char* ldsg;
    float* out; unsigned char* ws; unsigned* ctl;
    unsigned char* ws0; unsigned lds0;
    int tid, lane, wave, G, gw, NGW, bid;
    int wave0;
};
#define CAS __attribute__((address_space(4)))
__device__ __forceinline__ const float* inptr(int i) { const CAS char* k = (const CAS char*)__builtin_amdgcn_kernarg_segment_ptr(); return *(const float* const volatile CAS*)(k + 8 * i); }
constexpr int LDS_CTL = 64;
constexpr int LDS_REGION = 156 * 1024;
constexpr int LDS_BYTES = LDS_CTL + LDS_REGION;

__device__ __forceinline__ void frame_tid(Frame& F) { int t = F.wave0 * 64 + (int)__builtin_amdgcn_mbcnt_hi(~0u, __builtin_amdgcn_mbcnt_lo(~0u, 0u)); asm volatile("" : "+v"(t)); F.tid = t; F.lane = t & 63; F.wave = __builtin_amdgcn_readfirstlane(t >> 6);
    int bid = blockIdx.x; asm volatile("" : "+s"(bid)); F.bid = bid; F.gw = bid * NWAVES + F.wave;
    unsigned char* w = F.ws0; unsigned lb = F.lds0; asm volatile("" : "+s"(w), "+s"(lb));
    F.ws = w; F.ctl = (unsigned*)(w + WS_CTL); F.lds = (LAS unsigned char*)(uintptr_t)lb + LDS_CTL; F.ldsg = (unsigned char*)F.lds; }
template <typename T> __device__ __forceinline__ T* wsp(const Frame& F, size_t off) { return (T*)(F.ws + off); }

struct CvtItem { const float* src; unsigned ld_src; int f8; unsigned char* dst; };
__device__ __forceinline__ size_t wtile_off(int n, int kbyte, int kb) { return (size_t)(n >> 8) * 256u * (size_t)kb + (size_t)(kbyte >> 7) * 32768u + (size_t)(n & 255) * 128u + (size_t)(kbyte & 127); }
__device__ __forceinline__ void cvt_load(const CvtItem& c, f32x4* v, int lane) {
    const int r4 = lane >> 4, c4 = (lane & 15) * 4;
#pragma unroll
    for (int i = 0; i < 16; ++i) v[i] = __builtin_nontemporal_load((const f32x4*)(c.src + (size_t)(4 * i + r4) * c.ld_src + c4));
}
__device__ __forceinline__ void cvt_store(const CvtItem& c, const f32x4* v, LAS float* scr, int lane) {
    const int r4 = lane >> 4, c4 = (lane & 15) * 4;
#pragma unroll
    for (int i = 0; i < 16; ++i) { LAS float* q = scr + (4 * i + r4) * 65 + c4; q[0] = v[i].x; q[1] = v[i].y; q[2] = v[i].z; q[3] = v[i].w; }
    LDS_WAIT();
    const int cc = lane & 7;
    if (c.f8) {
#pragma unroll
        for (int j = 0; j < 8; ++j) { const int n = (lane >> 3) + 8 * j; const LAS float* t = scr + (8 * cc) * 65 + n;
            u32x2 o; o.x = pk4_fp8(t[0 * 65] * F8_WSCALE, t[1 * 65] * F8_WSCALE, t[2 * 65] * F8_WSCALE, t[3 * 65] * F8_WSCALE); o.y = pk4_fp8(t[4 * 65] * F8_WSCALE, t[5 * 65] * F8_WSCALE, t[6 * 65] * F8_WSCALE, t[7 * 65] * F8_WSCALE);
            __builtin_nontemporal_store(o, (u32x2*)(c.dst + (size_t)n * 128 + 8 * cc)); }
    } else {
#pragma unroll
        for (int j = 0; j < 8; ++j) { const int n = (lane >> 3) + 8 * j; const LAS float* t = scr + (8 * cc) * 65 + n;
            u32x4 o; o.x = pk2(t[0 * 65], t[1 * 65]); o.y = pk2(t[2 * 65], t[3 * 65]); o.z = pk2(t[4 * 65], t[5 * 65]); o.w = pk2(t[6 * 65], t[7 * 65]);
            __builtin_nontemporal_store(o, (u32x4*)(c.dst + (size_t)n * 128 + 16 * cc)); }
    }
    LDS_WAIT();
}
constexpr int TR_SCR = 64 * 65;
constexpr int CVT_NMIX = 16 * 96 + 4 * 16 * 16 + 4 * 8 * 16 + 16 * 16;
__device__ __forceinline__ int cvt_count(int l) { return CVT_NMIX + (((l & 1) == 0) ? (2 * 16 * 44 + 44 * 16) : NEXP * (2 * 16 * 56 + 56 * 16)); }
__device__ __forceinline__ CvtItem cvt_item(const Frame& F, int l, int r) {
    CvtItem c; constexpr int N1 = 16 * 96, N2 = 4 * 16 * 16, N3 = 4 * 8 * 16, N4 = 16 * 16;
    if (r < N1) { const int kb = r / 96, nb = r % 96; c.src = inptr(I_WIN) + (size_t)l * DM * INW + (size_t)(64 * kb) * INW + 64 * nb; c.ld_src = INW; c.f8 = 0; c.dst = wsp<unsigned char>(F, WS_WCAT) + wtile_off(64 * nb, 128 * kb, 2 * DM); return c; } r -= N1;
    if (r < N2) { const int i = r / 256, r2 = r % 256, kb = r2 / 16, nb = r2 % 16; c.src = inptr(I_WGATE) + (size_t)l * 4 * DM * DM + (size_t)i * DM * DM + (size_t)(64 * kb) * DM + 64 * nb; c.ld_src = DM; c.f8 = 1;
        c.dst = wsp<unsigned char>(F, WS_WG8) + wtile_off(i * 1024 + 64 * nb, 64 * kb, DM); return c; } r -= N2;
    if (r < N3) { const int i = r / 128, r2 = r % 128, kb = r2 / 16, nb = r2 % 16; c.src = inptr(I_WBR) + (size_t)l * 4 * 512 * DM + (size_t)i * 512 * DM + (size_t)(64 * kb) * DM + 64 * nb; c.ld_src = DM; c.f8 = 0;
        c.dst = wsp<unsigned char>(F, WS_WB) + wtile_off(i * 1024 + 64 * nb, 128 * kb, 1024); return c; } r -= N3;
    if (r < N4) { const int kb = r / 16, nb = r % 16; c.src = inptr(I_WO) + (size_t)l * DM * DM + (size_t)(64 * kb) * DM + 64 * nb; c.ld_src = DM; c.f8 = 0; c.dst = wsp<unsigned char>(F, WS_WO4) + wtile_off(64 * nb, 128 * kb, 2 * DM); return c; } r -= N4;
    unsigned char* W13 = wsp<unsigned char>(F, (l & 1) ? WS_W13 : WS_W13D); unsigned char* W2 = wsp<unsigned char>(F, (l & 1) ? WS_W2 : WS_W2D);
    const int i = l >> 1; c.f8 = 1;
    if ((l & 1) == 0) { constexpr int NA = 16 * 44;
        if (r < 2 * NA) { const int which = r / NA; r %= NA; const int kb = r / 44, nb = r % 44, n0 = 64 * nb, drow = (n0 >> 7) * 256 + (n0 & 127) + which * 128;
            c.src = inptr(which ? I_FW3 : I_FW1) + (size_t)i * DM * FFD + (size_t)(64 * kb) * FFD + n0; c.ld_src = FFD; c.dst = W13 + wtile_off(drow, 64 * kb, DM); return c; } r -= 2 * NA;
        { const int kb = r / 16, nb = r % 16; c.src = inptr(I_FW2) + (size_t)i * FFD * DM + (size_t)(64 * kb) * DM + 64 * nb; c.ld_src = DM; c.dst = W2 + wtile_off(64 * nb, 64 * kb, FFD); return c; }
    } else { constexpr int NA = 16 * 56, NC = 56 * 16;
        if (r < NEXP * 2 * NA) { const int e = r / (2 * NA); r %= 2 * NA; const int which = r / NA; r %= NA; const int kb = r / 56, nb = r % 56, n0 = 64 * nb, drow = e * 2 * FFE + (n0 >> 7) * 256 + (n0 & 127) + which * 128;
            c.src = inptr(which ? I_MW3 : I_MW1) + (size_t)(i * NEXP + e) * DM * FFE + (size_t)(64 * kb) * FFE + n0; c.ld_src = FFE; c.dst = W13 + wtile_off(drow, 64 * kb, DM); return c; } r -= NEXP * 2 * NA;
        { const int e = r / NC; r %= NC; const int kb = r / 16, nb = r % 16; c.src = inptr(I_MW2) + (size_t)(i * NEXP + e) * FFE * DM + (size_t)(64 * kb) * DM + 64 * nb; c.ld_src = DM; c.dst = W2 + wtile_off(e * DM + 64 * nb, 64 * kb, FFE); return c; }
    }
}
__device__ __forceinline__ void cvt_range(const Frame& F, int l, int i0, int i1, int b0) {
    if (F.bid < b0) return;
    LAS float* scr = (LAS float*)(F.lds) + F.wave * TR_SCR;
    const int stride = (256 - b0) * NWAVES; int it = i0 + (F.bid - b0) * NWAVES + F.wave; if (it >= i1) return;
    CvtItem cur = cvt_item(F, l, it); f32x4 v[16]; cvt_load(cur, v, F.lane);
    for (;;) {
        const int nx = it + stride; const bool has = nx < i1; CvtItem nxt = cur; f32x4 vn[16];
        if (has) { nxt = cvt_item(F, l, nx); cvt_load(nxt, vn, F.lane); }
        cvt_store(cur, v, scr, F.lane);
        if (!has) break;
        cur = nxt; it = nx;
#pragma unroll
        for (int i = 0; i < 16; ++i) v[i] = vn[i];
    }
}
constexpr int CVT_NF_D = 2 * 16 * 44 + 44 * 16, CVT_NF_M = NEXP * (2 * 16 * 56 + 56 * 16), CVT_D1 = 5000, CVT_A1 = 11000, CVT_B1 = 14800;
template <int K> __device__ __forceinline__ void cvt_ffn_share(const Frame& F, int l, int b0) {
    if ((l & 1) || l + 1 >= DEPTH) return;
    const int lo = K == 0 ? CVT_D1 : (K == 1 ? CVT_A1 : CVT_B1), hi = K == 0 ? CVT_A1 : (K == 1 ? CVT_B1 : CVT_NF_M);
    cvt_range(F, l + 1, CVT_NMIX + lo, CVT_NMIX + hi, b0);
}
__device__ __forceinline__ int cvt_e1(int l) { return (l & 1) ? CVT_D1 : CVT_NF_D; }

__device__ __forceinline__ void p0_mod(const Frame& F) {
    LAS float* act = (LAS float*)(F.lds);
    LAS float* red = act + 5 * 1024;
    const float* c = inptr(I_C); const float* cc = inptr(I_CCTX);
    for (int i = F.tid; i < 5 * 1024; i += NTHREADS) { const float v = (i < 4096) ? c[i] : cc[i - 4096]; act[i] = siluf_(v); }
    __syncthreads();
    float* MOD = wsp<float>(F, WS_MOD);
    for (int u = F.bid; u < DEPTH * 96; u += F.G) {
        const int l = u / 96, cg = u % 96, cl = F.tid & 63, ks = F.tid >> 6, col = cg * 64 + cl;
        const float* w = inptr(I_WMOD) + (size_t)l * DM * 6144 + col;
        float a0 = 0.f, a1 = 0.f, a2 = 0.f, a3 = 0.f, a4 = 0.f;
#pragma unroll 16
        for (int k = ks * 128; k < ks * 128 + 128; ++k) { const float wv = w[(size_t)k * 6144];
            a0 += act[k] * wv; a1 += act[1024 + k] * wv; a2 += act[2048 + k] * wv; a3 += act[3072 + k] * wv; a4 += act[4096 + k] * wv; }
        red[(ks * 5 + 0) * 64 + cl] = a0; red[(ks * 5 + 1) * 64 + cl] = a1; red[(ks * 5 + 2) * 64 + cl] = a2; red[(ks * 5 + 3) * 64 + cl] = a3; red[(ks * 5 + 4) * 64 + cl] = a4;
        __syncthreads();
        if (F.tid < 320) { const int j = F.tid >> 6, c2 = F.tid & 63; float s = inptr(I_BMOD)[(size_t)l * 6144 + cg * 64 + c2];
#pragma unroll
            for (int k2 = 0; k2 < 8; ++k2) s += red[(k2 * 5 + j) * 64 + c2];
            MOD[((size_t)l * 5 + j) * 6144 + cg * 64 + c2] = s; }
        __syncthreads();
    }
}

__device__ __forceinline__ void p0_filters(const Frame& F) {
    constexpr int NR = 96, HLD = 72;
    LAS float* FT = (LAS float*)(F.lds);
    LAS float* H1 = FT + NR * 33;
    LAS bf16_t* H2 = (LAS bf16_t*)(H1 + NR * 64);
    LAS float* W1 = (LAS float*)(H2 + 98 * HLD);
    LAS float* W2 = W1 + 33 * 64;
    LAS bf16_t* W3T = (LAS bf16_t*)(W2 + 64 * 64);
    bf16_t* GF = wsp<bf16_t>(F, WS_GF); float* GC = wsp<float>(F, WS_GC);
    const float min_decay = -3.0701134573253944f, max_decay = -15.350567286626972f;
    const int lane = F.lane, r32 = lane & 31, hi = lane >> 5;
    for (int u = F.bid; u < DEPTH * 64; u += F.G) {
        const int l = u / 64, q = u % 64; const bool hasctx = q < 16;
        const float* w1 = inptr(I_HW1) + (size_t)l * 33 * 64; const float* b1 = inptr(I_HB1) + l * 64; const float* w2 = inptr(I_HW2) + (size_t)l * 64 * 64; const float* b2 = inptr(I_HB2) + l * 64;
        const float* w3 = inptr(I_HW3) + (size_t)l * 64 * 2048; const float* fr0 = inptr(I_HFREQ) + l * 128; const float* fr1 = fr0 + 64;
        for (int i = F.tid; i < 33 * 64; i += NTHREADS) W1[i] = w1[i];
        for (int i = F.tid; i < 64 * 64; i += NTHREADS) W2[i] = w2[i];
        for (int idx = F.tid; idx < NR * 33; idx += NTHREADS) { const int R = idx / 33, f = idx % 33; const bool isctx = R >= 68;
            const int L = isctx ? NCTX : SEQ, p = isctx ? 16 * q + R - 68 : 64 * q + R;
            const float t = (float)p / (float)(L - 1); float v;
            if (f == 0) v = t; else { const int k = (f - 1) & 15; const float fk = 1e-4f + (float)k * ((15.0f - 1e-4f) / 15.0f); float qq = (float)p * fk / (float)L; qq -= floorf(qq);
                v = (f <= 16) ? __builtin_amdgcn_cosf(qq) : -__builtin_amdgcn_sinf(qq); }
            FT[idx] = v; }
        __syncthreads();
        for (int idx = F.tid; idx < NR * 64; idx += NTHREADS) { const int R = idx >> 6, jj = idx & 63; float sacc = b1[jj];
#pragma unroll 11
            for (int f = 0; f < 33; ++f) sacc += FT[R * 33 + f] * W1[f * 64 + jj];
            H1[idx] = __builtin_amdgcn_sinf(fr0[jj] * sacc * 0.15915494309189535f); }
        __syncthreads();
        for (int idx = F.tid; idx < NR * 64; idx += NTHREADS) { const int R = idx >> 6, jj = idx & 63; float sacc = b2[jj];
#pragma unroll 16
            for (int k = 0; k < 64; ++k) sacc += H1[R * 64 + k] * W2[k * 64 + jj];
            H2[R * HLD + jj] = f2bf(__builtin_amdgcn_sinf(fr1[jj] * sacc * 0.15915494309189535f)); }
        if (F.tid < 64) H2[NR * HLD + F.tid] = 0;
        __syncthreads();
#pragma unroll 1
        for (int r = 0; r < 4; ++r) {
            const int o = r >> 1, dir = r & 1;
            { const int j = F.tid + 512 * r; float wc[64];
#pragma unroll
              for (int k = 0; k < 64; ++k) wc[k] = w3[(size_t)k * 2048 + j];
#pragma unroll
              for (int k = 0; k < 64; k += 8) *(LAS u32x4*)(W3T + F.tid * HLD + k) = pack8(wc + k); }
            __syncthreads();
#pragma unroll 1
            for (int t2 = 0; t2 < 2; ++t2) {
                const int n0 = 32 * (2 * F.wave + t2), ch = n0 + r32, j = ch + 512 * r;
                f32x16 acc[3] = {};
                const LAS bf16_t* ap = H2 + (r32 + dir) * HLD + 8 * hi; const LAS bf16_t* bp = W3T + (n0 + r32) * HLD + 8 * hi;
#pragma unroll
                for (int k0 = 0; k0 < 64; k0 += 16) { const bf16x8 bv = *(const LAS bf16x8*)(bp + k0);
#pragma unroll
                    for (int mt = 0; mt < 3; ++mt) acc[mt] = __builtin_amdgcn_mfma_f32_32x32x16_bf16(*(const LAS bf16x8*)(ap + mt * 32 * HLD + k0), bv, acc[mt], 0, 0, 0); }
                const float adelta = fabsf(min_decay + (float)j * ((max_decay - min_decay) / 2047.0f));
                bf16_t* grow = GF + (((size_t)l * 2 + o) * 512 + ch) * 8192; float* crow_ = GC + (((size_t)l * 2 + o) * 512 + ch) * 512;
#pragma unroll
                for (int mt = 0; mt < 2; ++mt)
#pragma unroll
                    for (int g = 0; g < 4; ++g) { const int X = 64 * q + 32 * mt + 8 * g + 4 * hi; float v[4];
#pragma unroll
                        for (int e = 0; e < 4; ++e) { const int p = X + dir + e; v[e] = (p < SEQ) ? acc[mt][4 * g + e] * __expf(-(float)p * (1.f / (float)(SEQ - 1)) * adelta) : 0.f; }
                        u32x2 w; if (dir == 0) { w.x = pk2(v[0], v[1]); w.y = pk2(v[2], v[3]); *(u32x2*)(grow + 4096 + X) = w; }
                        else { w.x = pk2(v[3], v[2]); w.y = pk2(v[1], v[0]); *(u32x2*)(grow + 4092 - X) = w; } }
                if (hasctx) {
#pragma unroll
                    for (int g = 0; g < 3; ++g) { const int rr = 8 * g + 4 * hi; if (rr >= 4 && rr < 20) {
#pragma unroll
                        for (int e = 0; e < 4; ++e) { const int p = 16 * q + (rr - 4) + dir + e; const float val = (p < NCTX) ? acc[2][4 * g + e] * __expf(-(float)p * (1.f / (float)(NCTX - 1)) * adelta) : 0.f;
                            if (dir == 0) crow_[256 + p] = val; else crow_[256 - p] = val; } } } }
            }
            __syncthreads();
        }
    }
    if (F.bid == 0) { float* TB = wsp<float>(F, WS_ROPE);
        for (int idx = F.tid; idx < 64 * 32; idx += NTHREADS) { const int v = idx >> 5, k = idx & 31; const float inv = __builtin_amdgcn_exp2f(-(float)k * (13.287712379549449f / 32.0f)); const float rev = (float)v * inv * 0.15915494309189535f;
            TB[idx] = __builtin_amdgcn_cosf(rev); TB[2048 + idx] = __builtin_amdgcn_sinf(rev); } }
}

__device__ __forceinline__ void store_mod_row(const f32x4* v, const float* m0, const float* m1, bf16_t* orow, int lane) {
#pragma unroll
    for (int j = 0; j < 4; ++j) { const f32x4 a = *(const f32x4*)(m0 + 4 * lane + 256 * j), s = *(const f32x4*)(m1 + 4 * lane + 256 * j); const f32x4 u = v[j] * (s + 1.0f) + a;
        u32x2 w; w.x = pk2(u.x, u.y); w.y = pk2(u.z, u.w); *(u32x2*)(orow + 4 * lane + 256 * j) = w; }
}
__device__ __forceinline__ void store_mod_row8(const f32x4* v, const float* m0, const float* m1, unsigned char* orow, int lane) {
#pragma unroll
    for (int j = 0; j < 4; ++j) { const f32x4 a = *(const f32x4*)(m0 + 4 * lane + 256 * j), sc = *(const f32x4*)(m1 + 4 * lane + 256 * j); const f32x4 u = v[j] * (sc + 1.0f) + a;
        *(unsigned*)(orow + 4 * lane + 256 * j) = pk4_fp8(u.x, u.y, u.z, u.w); }
}
__device__ __forceinline__ int row_bsel(int row) { return row < T_LAT ? (row >> 12) : 4; }
__device__ __forceinline__ void p0b_rows(const Frame& F) {
    bf16_t* XF = wsp<bf16_t>(F, WS_XF); bf16_t* U = wsp<bf16_t>(F, WS_U); const float* MOD = wsp<float>(F, WS_MOD);
    f32x4 nv[4];
    if (F.gw < T_ALL) { const int row = F.gw; const float* src = row < T_LAT ? inptr(I_X) + (size_t)row * DM : inptr(I_CTX) + (size_t)(row - T_LAT) * DM;
#pragma unroll
        for (int j = 0; j < 4; ++j) nv[j] = *(const f32x4*)(src + 4 * F.lane + 256 * j); }
    for (int row = F.gw; row < T_ALL; row += F.NGW) {
        f32x4 v[4];
#pragma unroll
        for (int j = 0; j < 4; ++j) v[j] = nv[j];
        if (row + F.NGW < T_ALL) { const int r2 = row + F.NGW; const float* src = r2 < T_LAT ? inptr(I_X) + (size_t)r2 * DM : inptr(I_CTX) + (size_t)(r2 - T_LAT) * DM;
#pragma unroll
            for (int j = 0; j < 4; ++j) nv[j] = *(const f32x4*)(src + 4 * F.lane + 256 * j); }
#pragma unroll
        for (int j = 0; j < 4; ++j) *(u32x2*)(XF + (size_t)row * DM + 4 * F.lane + 256 * j) = f32_bf4(v[j]);
        const float* m = MOD + (size_t)row_bsel(row) * 6144;
        store_mod_row(v, m, m + 1024, U + (size_t)row * DM, F.lane);
        store_mod_row8(v, m, m + 1024, wsp<unsigned char>(F, WS_U8M) + (size_t)row * DM, F.lane);
    }
}
__device__ __forceinline__ void ln_row(f32x4* v, const float* g, const float* b, int lane) {
    float s = 0.f;
#pragma unroll
    for (int j = 0; j < 4; ++j) s += (v[j].x + v[j].y) + (v[j].z + v[j].w);
    const float mean = wave_sum(s, lane) * (1.f / DM); float s2 = 0.f;
#pragma unroll
    for (int j = 0; j < 4; ++j) { v[j] = v[j] - mean; s2 += (v[j].x * v[j].x + v[j].y * v[j].y) + (v[j].z * v[j].z + v[j].w * v[j].w); }
    const float rstd = rsqrtf(wave_sum(s2, lane) * (1.f / DM) + LN_EPS);
#pragma unroll
    for (int j = 0; j < 4; ++j) { const f32x4 gg = *(const f32x4*)(g + 4 * lane + 256 * j), bb = *(const f32x4*)(b + 4 * lane + 256 * j); v[j] = v[j] * rstd * gg + bb; }
}

__device__ __forceinline__ u32x4 ldg8(const bf16_t* p) { return *(const u32x4*)p; }
struct TokRaw { u32x4 bg, c0, x0, cm, xm, cp, xp, q, kv; float cs[8], sn[8]; };
__device__ __forceinline__ void tok_load(const bf16_t* ZG, const float* TBC, const float* TBS, int tok, bool need_ctx, int c8, int axis, int kf0, TokRaw& r) {
    const bool isctx = tok >= T_LAT; const int t = isctx ? (tok - T_LAT) & 255 : tok & 4095, Ls = isctx ? NCTX : SEQ;
    const bf16_t* zr = ZG + (size_t)tok * ZGW; const u32x4 z4 = {0u, 0u, 0u, 0u};
    if (!isctx || need_ctx) {
        r.bg = ldg8(zr + c8); r.c0 = ldg8(zr + 512 + c8); r.x0 = ldg8(zr + 1024 + c8);
        if (t > 0) { r.cm = ldg8(zr - ZGW + 512 + c8); r.xm = ldg8(zr - ZGW + 1024 + c8); } else { r.cm = z4; r.xm = z4; }
        if (t < Ls - 1) { r.cp = ldg8(zr + ZGW + 512 + c8); r.xp = ldg8(zr + ZGW + 1024 + c8); } else { r.cp = z4; r.xp = z4; }
        r.q = ldg8(zr + OFF_D + c8);
    } else { r.bg = z4; r.c0 = z4; r.x0 = z4; r.cm = z4; r.xm = z4; r.cp = z4; r.xp = z4; r.q = z4; }
    r.kv = ldg8(zr + OFF_D + 512 + c8);
    const int v = axis ? (t & 63) : (t >> 6);
#pragma unroll
    for (int e = 0; e < 8; ++e) { r.cs[e] = isctx ? 1.f : TBC[v * 32 + kf0 + e]; r.sn[e] = isctx ? 0.f : TBS[v * 32 + kf0 + e]; }
}
__device__ __forceinline__ void ph2_tokens(const Frame& F, int l, bool need_ctx) {
    const bf16_t* ZG = wsp<bf16_t>(F, WS_ZG); bf16_t* Y = wsp<bf16_t>(F, WS_Y);
    bf16_t* QP = wsp<bf16_t>(F, WS_QP); bf16_t* QC = wsp<bf16_t>(F, WS_QC); bf16_t* KALL = wsp<bf16_t>(F, WS_KALL); bf16_t* VALL = wsp<bf16_t>(F, WS_VALL);
    const float* TBC = wsp<float>(F, WS_ROPE); const float* TBS = TBC + 2048;
    const int lane = F.lane, c8 = 8 * lane, cc = lane & 15;
    float w0[8], w1[8], w2[8], cb[8], gq[8], gk[8];
    { const float* caw = inptr(I_CAW) + (size_t)l * 3 * 512; const float* cab = inptr(I_CAB) + (size_t)l * 512;
#pragma unroll
      for (int e = 0; e < 8; ++e) { w0[e] = caw[c8 + e]; w1[e] = caw[512 + c8 + e]; w2[e] = caw[1024 + c8 + e]; cb[e] = cab[c8 + e];
          gq[e] = inptr(I_QN)[l * 128 + 8 * cc + e]; gk[e] = inptr(I_KN)[l * 128 + 8 * cc + e]; } }
    const int axis = cc >> 3, half = (cc >> 2) & 1, kf0 = 8 * (cc & 3);
    const int tok_b = F.gw < 256 ? F.gw * 6 : 1536 + (F.gw - 256) * 9, tok_e0 = tok_b + (F.gw < 256 ? 6 : 9), tok_e = tok_e0 < T_ALL ? tok_e0 : T_ALL;
    if (tok_b >= tok_e) return;
    TokRaw cur; tok_load(ZG, TBC, TBS, tok_b, need_ctx, c8, axis, kf0, cur);
    for (int tok = tok_b; tok < tok_e; ++tok) {
        TokRaw nxt = cur; if (tok + 1 < tok_e) tok_load(ZG, TBC, TBS, tok + 1, need_ctx, c8, axis, kf0, nxt);
        const bool isctx = tok >= T_LAT; const int b = isctx ? (tok - T_LAT) >> 8 : tok >> 12, t = isctx ? (tok - T_LAT) & 255 : tok & 4095;
        if (!isctx || need_ctx) {
            float bg[8], c0[8], x0[8], cm[8], xm[8], cp[8], xp[8];
            unpack8(cur.bg, bg); unpack8(cur.c0, c0); unpack8(cur.x0, x0); unpack8(cur.cm, cm); unpack8(cur.xm, xm); unpack8(cur.cp, cp); unpack8(cur.xp, xp);
            float y[8];
#pragma unroll
            for (int e = 0; e < 8; ++e) y[e] = bg[e] * (w0[e] * (cm[e] * xm[e]) + w1[e] * (c0[e] * x0[e]) + w2[e] * (cp[e] * xp[e]) + cb[e]);
            *(u32x4*)(Y + (size_t)tok * YW + c8) = pack8(y);
        }
        if (!isctx || need_ctx) {
            float q[8]; unpack8(cur.q, q);
            float ss = 0.f;
#pragma unroll
            for (int e = 0; e < 8; ++e) ss += q[e] * q[e];
            ss += shfl_xor_l(ss, 1, lane); ss += shfl_xor_l(ss, 2, lane); ss += shfl_xor_l(ss, 4, lane); ss += shfl_xor_l(ss, 8, lane);
            const float r = rsqrtf(ss * (1.f / 128.f) + 1e-6f);
            float o[8];
#pragma unroll
            for (int e = 0; e < 8; ++e) { q[e] = q[e] * r * gq[e]; }
#pragma unroll
            for (int e = 0; e < 8; ++e) { const float pr = shfl_xor_l(q[e], 4, lane); o[e] = half ? (q[e] * cur.cs[e] + pr * cur.sn[e]) : (q[e] * cur.cs[e] - pr * cur.sn[e]); }
            const int head = lane >> 4;
            bf16_t* dst = isctx ? QC + ((size_t)(b * 4 + head) * NCTX + t) * 128 + 8 * cc : QP + ((size_t)(b * 4 + head) * SEQ + t) * 128 + 8 * cc;
            *(u32x4*)dst = pack8(o);
        }
        { const u32x4 raw = cur.kv; float k[8]; unpack8(raw, k);
            float ss = 0.f;
#pragma unroll
            for (int e = 0; e < 8; ++e) ss += k[e] * k[e];
            ss += shfl_xor_l(ss, 1, lane); ss += shfl_xor_l(ss, 2, lane); ss += shfl_xor_l(ss, 4, lane); ss += shfl_xor_l(ss, 8, lane);
            const float r = rsqrtf(ss * (1.f / 128.f) + 1e-6f);
            float o[8];
#pragma unroll
            for (int e = 0; e < 8; ++e) k[e] = k[e] * r * gk[e];
#pragma unroll
            for (int e = 0; e < 8; ++e) { const float pr = shfl_xor_l(k[e], 4, lane); o[e] = half ? (k[e] * cur.cs[e] + pr * cur.sn[e]) : (k[e] * cur.cs[e] - pr * cur.sn[e]); }
            const int hh = (lane >> 4) & 1, pos = isctx ? SEQ + t : t; const size_t off = ((size_t)(b * 2 + hh) * 4352 + pos) * 128 + 8 * cc;
            if (lane < 32) *(u32x4*)(KALL + off) = pack8(o); else *(u32x4*)(VALL + off) = raw; }
        cur = nxt;
    }
}
__device__ __forceinline__ void tr64_write(LAS unsigned char* tile, int row, int ck, u32x4 w) { *(LAS u32x4*)(tile + row * 128 + ((ck ^ ((row >> 3) & 7)) << 4)) = w; }
__device__ __forceinline__ u32x4 tr64_read(const LAS unsigned char* tile, int col, int tk) {
    unsigned short e[8];
#pragma unroll
    for (int i = 0; i < 8; ++i) e[i] = *(const LAS unsigned short*)(tile + (8 * tk + i) * 128 + ((((col >> 3) ^ tk) & 7) << 4) + (col & 7) * 2);
    u32x4 w; w.x = e[0] | ((unsigned)e[1] << 16); w.y = e[2] | ((unsigned)e[3] << 16); w.z = e[4] | ((unsigned)e[5] << 16); w.w = e[6] | ((unsigned)e[7] << 16); return w;
}
__device__ __forceinline__ void ph2_htrans(const Frame& F) {
    const bf16_t* ZG = wsp<bf16_t>(F, WS_ZG); bf16_t* ZHT = wsp<bf16_t>(F, WS_ZHT); bf16_t* ZHTC = wsp<bf16_t>(F, WS_ZHTC);
    LAS unsigned char* tile = F.lds + F.wave * 8192;
    const int lane = F.lane, rr = lane >> 3, ck = lane & 7;
    u32x4 nx[8];
    if (F.gw < 272 * 24) { const int tb = F.gw / 24, cbk = F.gw % 24, tok0 = tb * 64;
#pragma unroll
        for (int r = 0; r < 8; ++r) nx[r] = ldg8(ZG + (size_t)(tok0 + rr + 8 * r) * ZGW + OFF_H + cbk * 64 + 8 * ck); }
    for (int it = F.gw; it < 272 * 24; it += F.NGW) {
        const int tb = it / 24, cbk = it % 24, tok0 = tb * 64;
#pragma unroll
        for (int r = 0; r < 8; ++r) { const int row = rr + 8 * r; tr64_write(tile, row, ck, nx[r]); }
        if (it + F.NGW < 272 * 24) { const int it2 = it + F.NGW, tb2 = it2 / 24, cbk2 = it2 % 24, tok2 = tb2 * 64;
#pragma unroll
            for (int r = 0; r < 8; ++r) nx[r] = ldg8(ZG + (size_t)(tok2 + rr + 8 * r) * ZGW + OFF_H + cbk2 * 64 + 8 * ck); }
        LDS_WAIT();
        const bool isctx = tok0 >= T_LAT; const int b = isctx ? (tok0 - T_LAT) >> 8 : tok0 >> 12, t0 = isctx ? (tok0 - T_LAT) & 255 : tok0 & 4095;
#pragma unroll
        for (int r = 0; r < 8; ++r) { const int ch = rr + 8 * r; const u32x4 w = tr64_read(tile, ch, ck);
            bf16_t* dst = isctx ? ZHTC + ((size_t)(b * 1536 + cbk * 64 + ch) * NCTX + t0 + 8 * ck) : ZHT + ((size_t)(b * 1536 + cbk * 64 + ch) * SEQ + t0 + 8 * ck);
            *(u32x4*)dst = w; }
        LDS_WAIT();
    }
}
__device__ __forceinline__ void ph3b_ytrans(const Frame& F, bool need_ctx) {
    bf16_t* Y = wsp<bf16_t>(F, WS_Y); const bf16_t* YHT = wsp<bf16_t>(F, WS_YHT); const bf16_t* YHTC = wsp<bf16_t>(F, WS_YHTC);
    LAS unsigned char* tile = F.lds + F.wave * 8192;
    const int lane = F.lane, rr = lane >> 3, ck = lane & 7;
    const int ntb = need_ctx ? 272 : 256;
    const int skip = need_ctx ? 32 : 0; if (F.bid < skip) return;
    const int it0 = F.gw - skip * NWAVES, step = F.NGW - skip * NWAVES;
#define YT_LOAD(itx) do { const int tb_ = (itx) / 8, cbk_ = (itx) % 8, tok_ = tb_ * 64; const bool ic_ = tok_ >= T_LAT; const int b_ = ic_ ? (tok_ - T_LAT) >> 8 : tok_ >> 12, t_ = ic_ ? (tok_ - T_LAT) & 255 : tok_ & 4095; \
        _Pragma("unroll") for (int r = 0; r < 8; ++r) { const int ch = rr + 8 * r; \
            nx[r] = ldg8(ic_ ? YHTC + ((size_t)(b_ * 512 + cbk_ * 64 + ch) * NCTX + t_ + 8 * ck) : YHT + ((size_t)(b_ * 512 + cbk_ * 64 + ch) * SEQ + t_ + 8 * ck)); } } while (0)
    u32x4 nx[8];
    if (it0 < ntb * 8) YT_LOAD(it0);
    for (int it = it0; it < ntb * 8; it += step) {
        const int tb = it / 8, cbk = it % 8, tok0 = tb * 64;
#pragma unroll
        for (int r = 0; r < 8; ++r) tr64_write(tile, rr + 8 * r, ck, nx[r]);
        if (it + step < ntb * 8) YT_LOAD(it + step);
        LDS_WAIT();
#pragma unroll
        for (int r = 0; r < 8; ++r) { const int row = rr + 8 * r; *(u32x4*)(Y + (size_t)(tok0 + row) * YW + 1024 + cbk * 64 + 8 * ck) = tr64_read(tile, row, ck); }
        LDS_WAIT();
    }
#undef YT_LOAD
}

constexpr int RLD = 136;
constexpr int RREG = 128 * RLD * 2;
__device__ __forceinline__ void mma_nt128(f32x16& acc, const LAS bf16_t* A, int m0, const LAS bf16_t* Bt, int n0, int r32, int hi) {
    const LAS bf16_t* ap = A + (m0 + r32) * RLD + 8 * hi; const LAS bf16_t* bp = Bt + (n0 + r32) * RLD + 8 * hi;
#pragma unroll
    for (int k0 = 0; k0 < 128; k0 += 16) { const bf16x8 a = *(const LAS bf16x8*)(ap + k0); const bf16x8 b = *(const LAS bf16x8*)(bp + k0);
        acc = __builtin_amdgcn_mfma_f32_32x32x16_bf16(a, b, acc, 0, 0, 0); }
}
__device__ __forceinline__ void mma_nt128x2(f32x16& c0, f32x16& c1, const LAS bf16_t* A, int m0, const LAS bf16_t* Bt, int n0, int r32, int hi) {
    const LAS bf16_t* ap = A + (m0 + r32) * RLD + 8 * hi; const LAS bf16_t* bp = Bt + (n0 + r32) * RLD + 8 * hi;
#pragma unroll 2
    for (int k0 = 0; k0 < 128; k0 += 16) { const bf16x8 a = *(const LAS bf16x8*)(ap + k0); const bf16x8 b0 = *(const LAS bf16x8*)(bp + k0); const bf16x8 b1 = *(const LAS bf16x8*)(bp + 32 * RLD + k0);
        c0 = __builtin_amdgcn_mfma_f32_32x32x16_bf16(a, b0, c0, 0, 0, 0); c1 = __builtin_amdgcn_mfma_f32_32x32x16_bf16(a, b1, c1, 0, 0, 0); }
}
__device__ __forceinline__ int ret_tok0(int b, int n) { return n < 2 ? T_LAT + b * NCTX + n * 128 : b * SEQ + (n - 2) * 128; }
__device__ __forceinline__ void ph2_retkv(const Frame& F, int l) {
    bf16_t* ZG = wsp<bf16_t>(F, WS_ZG); float* KVS = wsp<float>(F, WS_KVS);
    const float* TBC = wsp<float>(F, WS_ROPE); const float* TBS = TBC + 2048;
    LAS bf16_t* VT = (LAS bf16_t*)(F.lds); LAS bf16_t* KF = (LAS bf16_t*)(F.lds + RREG); LAS bf16_t* KB = (LAS bf16_t*)(F.lds + 2 * RREG);
    const int tid = F.tid, lane = F.lane, r32 = lane & 31, hi = lane >> 5, w = F.wave;
    u32x4 raw[2][6];
#define RKV_LOAD(itx) do { const int b_ = (itx) / (4 * NCH), h_ = ((itx) / NCH) & 3, n_ = (itx) % NCH, tk_ = ret_tok0(b_, n_); \
        _Pragma("unroll") for (int r = 0; r < 2; ++r) { const int idx = tid + 512 * r, j = idx & 127, pp = idx >> 7, cc = (pp & 3) + 8 * (pp >> 2); \
            const bf16_t* zr = ZG + (size_t)(tk_ + j) * ZGW + OFF_R + h_ * 128 + 8 * cc; \
            raw[r][0] = ldg8(zr); raw[r][1] = ldg8(zr + 32); raw[r][2] = ldg8(zr + 512); raw[r][3] = ldg8(zr + 512 + 32); raw[r][4] = ldg8(zr + 1024); raw[r][5] = ldg8(zr + 1024 + 32); } } while (0)
    if (F.bid < NBATCH * 4 * NCH) RKV_LOAD(F.bid);
    for (int it = F.bid; it < NBATCH * 4 * NCH; it += F.G) {
        const int b = it / (4 * NCH), h = (it / NCH) & 3, n = it % NCH, tok0 = ret_tok0(b, n); const bool lat = n >= 2;
        const float lgf = -__expf(inptr(I_RDEC)[l * 8 + h]), lgb = -__expf(inptr(I_RDEC)[l * 8 + 4 + h]);
#pragma unroll 2
        for (int r = 0; r < 2; ++r) {
            const int idx = tid + 512 * r, j = idx & 127, pp = idx >> 7, cc = (pp & 3) + 8 * (pp >> 2);
            bf16_t* zr = ZG + (size_t)(tok0 + j) * ZGW + OFF_R + h * 128 + 8 * cc;
            float q1[8], q2[8], k1[8], k2[8]; unpack8(raw[r][0], q1); unpack8(raw[r][1], q2); unpack8(raw[r][2], k1); unpack8(raw[r][3], k2);
            const u32x4 v1raw = raw[r][4], v2raw = raw[r][5];
            const int axis = cc >> 3, kf0 = 8 * (cc & 3), p = lat ? (n - 2) * 128 + j : 0, v = axis ? (p & 63) : (p >> 6);
            float qo1[8], qo2[8], ko1[8], ko2[8];
#pragma unroll
            for (int e = 0; e < 8; ++e) { const float cs = lat ? TBC[v * 32 + kf0 + e] : 1.f, sn = lat ? TBS[v * 32 + kf0 + e] : 0.f;
                qo1[e] = q1[e] * cs - q2[e] * sn; qo2[e] = q2[e] * cs + q1[e] * sn;
                ko1[e] = (k1[e] * cs - k2[e] * sn) * 0.08838834764831845f; ko2[e] = (k2[e] * cs + k1[e] * sn) * 0.08838834764831845f; }
            if (lat) { *(u32x4*)zr = pack8(qo1); *(u32x4*)(zr + 32) = pack8(qo2); }
            const u32x4 kp1 = pack8(ko1), kp2 = pack8(ko2); *(u32x4*)(zr + 512) = kp1; *(u32x4*)(zr + 512 + 32) = kp2;
            float kr1[8], kr2[8]; unpack8(kp1, kr1); unpack8(kp2, kr2);
            const float df = __expf(lgf * (float)(127 - j)), db = __expf(lgb * (float)j);
            const bf16_t va[8] = {(bf16_t)(v1raw.x & 0xffff), (bf16_t)(v1raw.x >> 16), (bf16_t)(v1raw.y & 0xffff), (bf16_t)(v1raw.y >> 16), (bf16_t)(v1raw.z & 0xffff), (bf16_t)(v1raw.z >> 16), (bf16_t)(v1raw.w & 0xffff), (bf16_t)(v1raw.w >> 16)};
            const bf16_t vb[8] = {(bf16_t)(v2raw.x & 0xffff), (bf16_t)(v2raw.x >> 16), (bf16_t)(v2raw.y & 0xffff), (bf16_t)(v2raw.y >> 16), (bf16_t)(v2raw.z & 0xffff), (bf16_t)(v2raw.z >> 16), (bf16_t)(v2raw.w & 0xffff), (bf16_t)(v2raw.w >> 16)};
#pragma unroll
            for (int e = 0; e < 8; ++e) { const int d1 = 8 * cc + e, d2 = d1 + 32;
                VT[d1 * RLD + j] = va[e]; KF[d1 * RLD + j] = f2bf(kr1[e] * df); KB[d1 * RLD + j] = f2bf(kr1[e] * db);
                VT[d2 * RLD + j] = vb[e]; KF[d2 * RLD + j] = f2bf(kr2[e] * df); KB[d2 * RLD + j] = f2bf(kr2[e] * db); }
        }
        if (it + F.G < NBATCH * 4 * NCH) RKV_LOAD(it + F.G);
        __syncthreads();
        { const int dir = w >> 2, mt = w & 3; const LAS bf16_t* KX = dir ? KB : KF;
            f32x16 acc[4] = {};
#pragma unroll
            for (int nt = 0; nt < 4; ++nt) mma_nt128(acc[nt], VT, 32 * mt, KX, 32 * nt, r32, hi);
            float* dst = KVS + (((size_t)(b * 4 + h) * 2 + dir) * NCH + n) * 16384;
#pragma unroll
            for (int nt = 0; nt < 4; ++nt)
#pragma unroll
                for (int r = 0; r < 16; ++r) dst[(32 * mt + crow(r, hi)) * 128 + 32 * nt + r32] = acc[nt][r]; }
        __syncthreads();
    }
#undef RKV_LOAD
}
__device__ __forceinline__ void ret_scan_item(const Frame& F, int l, int item) {
    float* KVS = wsp<float>(F, WS_KVS);
    const int combo = item >> 3, part = item & 7, dir = combo & 1, h = (combo >> 1) & 3;
    const float lg = -__expf(inptr(I_RDEC)[l * 8 + dir * 4 + h]); const float cd = __expf(lg * 128.f);
    float* base = KVS + (size_t)combo * NCH * 16384 + part * 2048 + F.tid * 4;
    bf16_t* baseb = wsp<bf16_t>(F, WS_U) + (size_t)combo * NCH * 16384 + part * 2048 + F.tid * 4;
    float z0 = 0.f; asm volatile("" : "+v"(z0));
    f32x4 s = {z0, z0, z0, z0};
    f32x4 kv[34];
#pragma unroll
    for (int t = 0; t < 34; ++t) { const int n = dir ? (t < 2 ? 1 - t : 35 - t) : t; kv[t] = *(const f32x4*)(base + (size_t)n * 16384); }
#pragma unroll
    for (int t = 0; t < 34; ++t) { const int n = dir ? (t < 2 ? 1 - t : 35 - t) : t; { u32x2 o; o.x = pk2(s.x, s.y); o.y = pk2(s.z, s.w); *(u32x2*)(baseb + (size_t)n * 16384) = o; } s = s * cd + kv[t]; }
}
struct RetPre { u32x4 q[4], k[4], v[4]; };
__device__ __forceinline__ void ret_out_load(const Frame& F, int it, RetPre& p) {
    const bf16_t* ZG = wsp<bf16_t>(F, WS_ZG); const int tid = F.tid;
    const int b = it / (4 * NCH), h = (it / NCH) & 3, n = it % NCH, tok0 = ret_tok0(b, n);
#pragma unroll
    for (int r = 0; r < 4; ++r) { const int cidx = tid + 512 * r, j = cidx >> 4, cc = cidx & 15;
        const bf16_t* zr = ZG + (size_t)(tok0 + j) * ZGW + OFF_R + h * 128 + 8 * cc; p.q[r] = ldg8(zr); p.k[r] = ldg8(zr + 512);
        const int j2 = cidx & 127, c2 = cidx >> 7; p.v[r] = ldg8(ZG + (size_t)(tok0 + j2) * ZGW + OFF_R + 1024 + h * 128 + 8 * c2); }
}
__device__ __forceinline__ void ret_out_item(const Frame& F, int l, int it, RetPre& pre, int it_next) {
    const bf16_t* ZG = wsp<bf16_t>(F, WS_ZG); const bf16_t* KVB = wsp<bf16_t>(F, WS_U); bf16_t* Y = wsp<bf16_t>(F, WS_Y);
    LAS bf16_t* RQ = (LAS bf16_t*)(F.lds); LAS bf16_t* RK = (LAS bf16_t*)(F.lds + RREG); LAS bf16_t* RV = (LAS bf16_t*)(F.lds + 2 * RREG); LAS bf16_t* RP = (LAS bf16_t*)(F.lds + 3 * RREG);
    LAS float* OF = (LAS float*)(F.lds);
    int lane_i = F.lane; asm volatile("" : "+v"(lane_i));
    const int tid = F.tid, lane = lane_i, r32 = lane & 31, hi = lane >> 5, w = F.wave;
    const int b = it / (4 * NCH), h = (it / NCH) & 3, n = it % NCH, tok0 = ret_tok0(b, n);
    const float lgf = -__expf(inptr(I_RDEC)[l * 8 + h]), lgb = -__expf(inptr(I_RDEC)[l * 8 + 4 + h]);
#pragma unroll
    for (int r = 0; r < 4; ++r) {
        const int cidx = tid + 512 * r, j = cidx >> 4, cc = cidx & 15;
        *(LAS u32x4*)(RQ + j * RLD + 8 * cc) = pre.q[r]; *(LAS u32x4*)(RK + j * RLD + 8 * cc) = pre.k[r];
        const int j2 = cidx & 127, c2 = cidx >> 7;
        const u32x4 vraw = pre.v[r];
        const bf16_t vv[8] = {(bf16_t)(vraw.x & 0xffff), (bf16_t)(vraw.x >> 16), (bf16_t)(vraw.y & 0xffff), (bf16_t)(vraw.y >> 16), (bf16_t)(vraw.z & 0xffff), (bf16_t)(vraw.z >> 16), (bf16_t)(vraw.w & 0xffff), (bf16_t)(vraw.w >> 16)};
#pragma unroll
        for (int e = 0; e < 8; ++e) RV[(8 * c2 + e) * RLD + j2] = vv[e];
    }
    const bf16_t* SF = KVB + (((size_t)(b * 4 + h) * 2 + 0) * NCH + n) * 16384; const bf16_t* SB = KVB + (((size_t)(b * 4 + h) * 2 + 1) * NCH + n) * 16384;
    u32x4 sfr[4];
#pragma unroll
    for (int r = 0; r < 4; ++r) sfr[r] = ldg8(SF + (size_t)(tid + 512 * r) * 8);
    __syncthreads();
    const int mt = w >> 1, ntb = 2 * (w & 1);
    {   f32x16 s0 = {}, s1 = {};
        mma_nt128x2(s0, s1, RQ, 32 * mt, RK, 32 * ntb, r32, hi);
#pragma unroll
        for (int r = 0; r < 16; ++r) { const int i = 32 * mt + crow(r, hi);
#pragma unroll
            for (int t = 0; t < 2; ++t) { const int j = 32 * (ntb + t) + r32;
                const float d = (i > j) ? __expf(lgf * (float)(i - j)) : ((i < j) ? __expf(lgb * (float)(j - i)) : 2.f);
                RP[i * RLD + j] = f2bf((t ? s1[r] : s0[r]) * d); } }
    }
    __syncthreads();
#pragma unroll
    for (int r = 0; r < 4; ++r) { const int cidx = tid + 512 * r, row = cidx >> 4, cc = cidx & 15; *(LAS u32x4*)(RK + row * RLD + 8 * cc) = sfr[r]; }
#pragma unroll
    for (int r = 0; r < 4; ++r) sfr[r] = ldg8(SB + (size_t)(tid + 512 * r) * 8);
    __syncthreads();
    f32x16 ao0 = {}, ao1 = {};
    mma_nt128x2(ao0, ao1, RQ, 32 * mt, RK, 32 * ntb, r32, hi);
#pragma unroll
    for (int r = 0; r < 16; ++r) { const float sc = __expf(lgf * (float)(32 * mt + crow(r, hi) + 1)); ao0[r] *= sc; ao1[r] *= sc; }
    mma_nt128x2(ao0, ao1, RP, 32 * mt, RV, 32 * ntb, r32, hi);
    __syncthreads();
    {
        u32x4 gt[4];
#pragma unroll
        for (int r = 0; r < 4; ++r) { const int cidx = tid + 512 * r, j = cidx >> 4, cc = cidx & 15; gt[r] = ldg8(ZG + (size_t)(tok0 + j) * ZGW + OFF_R + 1536 + h * 128 + 8 * cc); }
#pragma unroll
        for (int r = 0; r < 4; ++r) { const int cidx = tid + 512 * r, row = cidx >> 4, cc = cidx & 15; *(LAS u32x4*)(RV + row * RLD + 8 * cc) = sfr[r]; }
#pragma unroll
        for (int r = 0; r < 4; ++r) { const int cidx = tid + 512 * r, j = cidx >> 4, cc = cidx & 15; *(LAS u32x4*)(RP + j * RLD + 8 * cc) = gt[r]; }
    }
    __syncthreads();
    f32x16 ab0 = {}, ab1 = {};
    mma_nt128x2(ab0, ab1, RQ, 32 * mt, RV, 32 * ntb, r32, hi);
    __syncthreads();
#pragma unroll
    for (int r = 0; r < 16; ++r) { const int i = 32 * mt + crow(r, hi); const float sc = __expf(lgb * (float)(128 - i));
        OF[i * 132 + 32 * ntb + r32] = ao0[r] + sc * ab0[r]; OF[i * 132 + 32 * (ntb + 1) + r32] = ao1[r] + sc * ab1[r]; }
    if (it_next >= 0) ret_out_load(F, it_next, pre);
    __syncthreads();
#pragma unroll 4
    for (int rr = 0; rr < 16; ++rr) { const int i = 16 * w + rr; const float v0 = OF[i * 132 + lane], v1 = OF[i * 132 + 64 + lane];
        const float mean = wave_sum(v0 + v1, lane) * (1.f / 128.f); const float d0 = v0 - mean, d1 = v1 - mean; const float rstd = rsqrtf(wave_sum(d0 * d0 + d1 * d1, lane) * (1.f / 128.f) + 1e-6f);
        const size_t tok = (size_t)(tok0 + i);
        const float g0 = bf1(RP[i * RLD + lane]), g1 = bf1(RP[i * RLD + 64 + lane]);
        bf16_t* yp = Y + tok * YW + 512 + h * 128; yp[lane] = f2bf(siluf_(g0) * d0 * rstd); yp[64 + lane] = f2bf(siluf_(g1) * d1 * rstd); }
    __syncthreads();
}

constexpr int HY_GCS = 16960;
constexpr int HY_URS = 13376;
constexpr int HY_PAD = 1024;
constexpr int HY_NSH = 160;
constexpr int HY_GC_OFF = 0, HY_UR_OFF = 4 * HY_GCS, HY_GT_OFF = HY_UR_OFF + 4 * HY_URS, HY_END = HY_GT_OFF + 4 * 8192;
static_assert(HY_END <= LDS_REGION, "hyena LDS");
__device__ __forceinline__ int hy_uphys(int idx) { const int L = 2 * idx; return L + ((L >> 8) << 4); }
__device__ __forceinline__ void dwconv8(const bf16_t* row, int n0, int len, float w0, float w1, float w2, float bias, float* out) {
    float z[10]; unpack8(ldg8(row + n0), z + 1);
    z[0] = n0 > 0 ? bf1(row[n0 - 1]) : 0.f; z[9] = (n0 + 8 < len) ? bf1(row[n0 + 8]) : 0.f;
#pragma unroll
    for (int e = 0; e < 8; ++e) out[e] = w0 * z[e] + w1 * z[e + 1] + w2 * z[e + 2] + bias;
}
struct HyRaw { u32x4 v[4]; bf16_t lo[4], hi[4]; };
__device__ __forceinline__ void hy_raw_load(HyRaw& R, const bf16_t* ZHT, int col, int tid) {
#pragma unroll
    for (int r = 0; r < 4; ++r) { const int gidx = tid + 512 * r, b = gidx >> 9, n0 = (gidx & 511) * 8; const bf16_t* row = ZHT + (size_t)(b * 1536 + col) * SEQ;
        R.v[r] = ldg8(row + n0); R.lo[r] = n0 > 0 ? row[n0 - 1] : (bf16_t)0; R.hi[r] = (n0 + 8 < SEQ) ? row[n0 + 8] : (bf16_t)0; }
}
__device__ __forceinline__ void hy_dw(const HyRaw& R, int r, float w0, float w1, float w2, float bias, float* out) {
    float z[10]; unpack8(R.v[r], z + 1); z[0] = bf1(R.lo[r]); z[9] = bf1(R.hi[r]);
#pragma unroll
    for (int e = 0; e < 8; ++e) out[e] = w0 * z[e] + w1 * z[e + 1] + w2 * z[e + 2] + bias;
}
__device__ __forceinline__ void hyena_item(const Frame& F, int l, int c, bool need_ctx) {
    const bf16_t* ZHT = wsp<bf16_t>(F, WS_ZHT); const bf16_t* ZHTC = wsp<bf16_t>(F, WS_ZHTC); bf16_t* YHT = wsp<bf16_t>(F, WS_YHT); bf16_t* YHTC = wsp<bf16_t>(F, WS_YHTC);
    const bf16_t* GF = wsp<bf16_t>(F, WS_GF); const float* GC = wsp<float>(F, WS_GC);
    const float* hcw = inptr(I_HCW) + (size_t)l * 3 * 1536; const float* hcb = inptr(I_HCB) + (size_t)l * 1536; const float* hsk = inptr(I_HSKIP) + (size_t)l * 2 * 512;
    LAS unsigned char* lds = F.lds; const int tid = F.tid, lane = F.lane, nt = F.wave & 3, kh = F.wave >> 2;
    LAS bf16_t* GT = (LAS bf16_t*)(lds + HY_GT_OFF);
    HyRaw rv, rg; u32x4 gr[2]; u32x2 gx[2];
    hy_raw_load(rv, ZHT, c, tid); hy_raw_load(rg, ZHT, 512 + c, tid);
#define HY_GLOAD(ord, tt) do { const bf16_t* grow = GF + (((size_t)l * 2 + (ord)) * 512 + c) * 8192; gr[0] = ldg8(grow + (tt) * 8); gr[1] = ldg8(grow + ((tt) + 512) * 8); \
        gx[0] = *(const u32x2*)(grow + (tt) * 8 + 8); gx[1] = ((tt) < 511) ? *(const u32x2*)(grow + ((tt) + 512) * 8 + 8) : (u32x2){0u, 0u}; } while (0)
    HY_GLOAD(0, tid);
    __builtin_amdgcn_sched_barrier(0);
    { unsigned z0 = 0u; asm volatile("" : "+v"(z0)); const u32x4 zz = {z0, z0, z0, z0};
      for (int i = tid; i < 4 * HY_URS / 16; i += NTHREADS) *(LAS u32x4*)(lds + HY_UR_OFF + 16 * i) = zz; }
    __syncthreads();
    { const float w0 = hcw[c], w1 = hcw[1536 + c], w2 = hcw[3072 + c], bb = hcb[c];
#pragma unroll
      for (int r = 0; r < 4; ++r) { const int gidx = tid + 512 * r, b = gidx >> 9, n0 = (gidx & 511) * 8; float y[8]; hy_dw(rv, r, w0, w1, w2, bb, y);
          LAS unsigned char* ub = lds + HY_UR_OFF + b * HY_URS;
#pragma unroll
          for (int e = 0; e < 8; ++e) *(LAS bf16_t*)(ub + hy_uphys(4096 - (n0 + e) + HY_PAD)) = f2bf(y[e]);
          __builtin_amdgcn_sched_barrier(0); } }
#pragma unroll 1
    for (int o = 0; o < 2; ++o) {
        int tid_o = tid; asm volatile("" : "+v"(tid_o));
        {
#pragma unroll
          for (int r = 0; r < 2; ++r) { const int i0 = (tid_o + 512 * r) * 8; const u32x4 w = gr[r]; const u32x2 x = gx[r];
              LAS unsigned char* cb = lds + HY_GC_OFF + i0 * 2;
              *(LAS u32x4*)(cb) = w;
              { u32x4 v; v.x = __builtin_amdgcn_alignbit(w.y, w.x, 16); v.y = __builtin_amdgcn_alignbit(w.z, w.y, 16); v.z = __builtin_amdgcn_alignbit(w.w, w.z, 16); v.w = __builtin_amdgcn_alignbit(x.x, w.w, 16); *(LAS u32x4*)(cb + HY_GCS) = v; }
              { u32x4 v; v.x = w.y; v.y = w.z; v.z = w.w; v.w = x.x; *(LAS u32x4*)(cb + 2 * HY_GCS) = v; }
              { u32x4 v; v.x = __builtin_amdgcn_alignbit(w.z, w.y, 16); v.y = __builtin_amdgcn_alignbit(w.w, w.z, 16); v.z = __builtin_amdgcn_alignbit(x.x, w.w, 16); v.w = __builtin_amdgcn_alignbit(x.y, x.x, 16); *(LAS u32x4*)(cb + 3 * HY_GCS) = v; } }
          for (int i = tid_o; i < 4 * 292; i += NTHREADS) { const int s = i / 292, k = i % 292; const int x = 8192 - s + k; if (x < 8480) ((LAS bf16_t*)(lds + HY_GC_OFF + s * HY_GCS))[x] = 0; }
          const int col = 512 * (o + 1) + c; const float w0 = hcw[col], w1 = hcw[1536 + col], w2 = hcw[3072 + col], bb = hcb[col];
#pragma unroll
          for (int r = 0; r < 4; ++r) { const int gidx = tid_o + 512 * r, b = gidx >> 9, n0 = (gidx & 511) * 8; float y[8]; hy_dw(rg, r, w0, w1, w2, bb, y);
              *(LAS u32x4*)(GT + b * 4096 + n0) = pack8(y); __builtin_amdgcn_sched_barrier(0); } }
        if (o == 0) { hy_raw_load(rg, ZHT, 1024 + c, tid_o); HY_GLOAD(1, tid_o); }
        __builtin_amdgcn_sched_barrier(0);
        __syncthreads();
        int lane_o = lane; asm volatile("" : "+v"(lane_o)); const int r32 = lane_o & 31, hi = lane_o >> 5;
        const int il = r32 >> 2, bb_ = r32 & 3;
        const LAS unsigned char* ap = lds + HY_GC_OFF + (r32 & 3) * HY_GCS + ((r32 & ~3) + 1024 * nt + 8 * hi + 16 * HY_NSH * kh) * 2;
        const LAS unsigned char* bbase = lds + HY_UR_OFF + bb_ * HY_URS; const int bL0 = 2 * (HY_PAD - 128 * il + 8 * hi + 16 * HY_NSH * kh);
#define HY_LDA(s) ({ const s16x4 _lo = *(const LAS s16x4*)(ap + 32 * (s)), _hi = *(const LAS s16x4*)(ap + 32 * (s) + 8); (bf16x8){_lo[0], _lo[1], _lo[2], _lo[3], _hi[0], _hi[1], _hi[2], _hi[3]}; })
#define HY_LDB(s) ({ const int _L = bL0 + 32 * (s); *(const LAS bf16x8*)(bbase + _L + ((_L >> 8) << 4)); })
#define HY_STEP(x0, x1, x2, x3, bcur, gnew, bnext, sn) do { __builtin_amdgcn_sched_barrier(0); acc0 = __builtin_amdgcn_mfma_f32_32x32x16_bf16(x0, bcur, acc0, 0, 0, 0); __builtin_amdgcn_sched_barrier(0); \
        gnew = HY_LDA((sn) + 7); bnext = HY_LDB((sn) + 1); __builtin_amdgcn_sched_barrier(0); \
        acc1 = __builtin_amdgcn_mfma_f32_32x32x16_bf16(x1, bcur, acc1, 0, 0, 0); acc2 = __builtin_amdgcn_mfma_f32_32x32x16_bf16(x2, bcur, acc2, 0, 0, 0); acc3 = __builtin_amdgcn_mfma_f32_32x32x16_bf16(x3, bcur, acc3, 0, 0, 0); \
        __builtin_amdgcn_sched_barrier(0); } while (0)
        f32x16 acc0 = {}, acc1 = {}, acc2 = {}, acc3 = {};
        bf16x8 g0 = HY_LDA(0), g1 = HY_LDA(1), g2 = HY_LDA(2), g3 = HY_LDA(3), g4 = HY_LDA(4), g5 = HY_LDA(5), g6 = HY_LDA(6), g7, b0 = HY_LDB(0), b1;
#pragma unroll 1
        for (int s = 0; s < HY_NSH; s += 8) {
            HY_STEP(g0, g2, g4, g6, b0, g7, b1, s);
            HY_STEP(g1, g3, g5, g7, b1, g0, b0, s + 1);
            HY_STEP(g2, g4, g6, g0, b0, g1, b1, s + 2);
            HY_STEP(g3, g5, g7, g1, b1, g2, b0, s + 3);
            HY_STEP(g4, g6, g0, g2, b0, g3, b1, s + 4);
            HY_STEP(g5, g7, g1, g3, b1, g4, b0, s + 5);
            HY_STEP(g6, g0, g2, g4, b0, g5, b1, s + 6);
            HY_STEP(g7, g1, g3, g5, b1, g6, b0, s + 7);
        }
#undef HY_LDA
#undef HY_LDB
#undef HY_STEP
        __syncthreads();
        LAS float* XCH = (LAS float*)(lds + HY_GC_OFF);
        { const f32x16 s0 = kh ? acc0 : acc2, s1 = kh ? acc1 : acc3; LAS float* xp = XCH + (size_t)(F.wave * 2) * 16 * 64 + lane_o;
#pragma unroll
          for (int r = 0; r < 16; ++r) { xp[r * 64] = s0[r]; xp[(16 + r) * 64] = s1[r]; } }
        __syncthreads();
        f32x16 o0 = kh ? acc2 : acc0, o1 = kh ? acc3 : acc1;
        { const LAS float* xp = XCH + (size_t)((F.wave ^ 4) * 2) * 16 * 64 + lane_o;
#pragma unroll
          for (int r = 0; r < 16; ++r) { o0[r] += xp[r * 64]; o1[r] += xp[(16 + r) * 64]; } }
        { const float sk = hsk[o * 512 + c]; const int nb0 = 128 * (8 * nt + il) + 64 * kh;
          LAS unsigned char* ub = lds + HY_UR_OFF + bb_ * HY_URS;
#pragma unroll
          for (int t = 0; t < 2; ++t)
#pragma unroll
              for (int g = 0; g < 4; ++g) { float yv[4];
#pragma unroll
                  for (int q = 0; q < 4; ++q) { const int n = nb0 + 32 * t + 8 * g + 4 * hi + q; const float cv = t ? o1[4 * g + q] : o0[4 * g + q];
                      const float ycur = bf1(*(const LAS bf16_t*)(ub + hy_uphys(4096 - n + HY_PAD))); const float gt = bf1(GT[bb_ * 4096 + n]); yv[q] = gt * (cv + sk * ycur); }
                  const int n4 = nb0 + 32 * t + 8 * g + 4 * hi;
                  if (o == 0) {
#pragma unroll
                      for (int q = 0; q < 4; ++q) *(LAS bf16_t*)(ub + hy_uphys(4096 - (n4 + q) + HY_PAD)) = f2bf(yv[q]); }
                  else { u32x2 pk; pk.x = pk2(yv[0], yv[1]); pk.y = pk2(yv[2], yv[3]); *(u32x2*)(YHT + (size_t)(bb_ * 512 + c) * SEQ + n4) = pk; } } }
        __syncthreads();
    }
    if (need_ctx) {
        LAS float* uc4 = (LAS float*)(lds);
        LAS float* gc = uc4 + 1024;
        LAS float* gt4 = gc + 512;
        LAS float* red4 = gt4 + 1024;
        { const float w0 = hcw[c], w1 = hcw[1536 + c], w2 = hcw[3072 + c], bb = hcb[c];
          if (tid < 128) { const int b = tid >> 5, n0 = (tid & 31) * 8; float y[8]; dwconv8(ZHTC + (size_t)(b * 1536 + c) * NCTX, n0, NCTX, w0, w1, w2, bb, y);
#pragma unroll
              for (int e = 0; e < 8; ++e) uc4[(n0 + e) * 4 + b] = y[e]; } }
#pragma unroll 1
        for (int o = 0; o < 2; ++o) {
            gc[tid] = GC[(((size_t)l * 2 + o) * 512 + c) * 512 + tid];
            { const int col = 512 * (o + 1) + c; const float w0 = hcw[col], w1 = hcw[1536 + col], w2 = hcw[3072 + col], bb = hcb[col];
              if (tid < 128) { const int b = tid >> 5, n0 = (tid & 31) * 8; float y[8]; dwconv8(ZHTC + (size_t)(b * 1536 + col) * NCTX, n0, NCTX, w0, w1, w2, bb, y);
#pragma unroll
                  for (int e = 0; e < 8; ++e) gt4[(n0 + e) * 4 + b] = y[e]; } }
            __syncthreads();
            const float sk = hsk[o * 512 + c]; const int n = tid & 255, mh = tid >> 8;
            { f32x4 acc = {0.f, 0.f, 0.f, 0.f};
#pragma unroll 8
              for (int m = 128 * mh; m < 128 * mh + 128; ++m) acc += *(const LAS f32x4*)(uc4 + 4 * m) * gc[256 + n - m];
              *(LAS f32x4*)(red4 + 4 * tid) = acc; }
            __syncthreads();
            f32x4 res = {0.f, 0.f, 0.f, 0.f};
            if (tid < 256) { const f32x4 s4 = *(const LAS f32x4*)(red4 + 4 * tid) + *(const LAS f32x4*)(red4 + 4 * (tid + 256)); const f32x4 u4 = *(const LAS f32x4*)(uc4 + 4 * n);
                res = *(const LAS f32x4*)(gt4 + 4 * n) * (s4 + u4 * sk); }
            __syncthreads();
            if (tid < 256) { *(LAS f32x4*)(uc4 + 4 * n) = res;
                if (o == 1) {
#pragma unroll
                    for (int b = 0; b < 4; ++b) YHTC[(size_t)(b * 512 + c) * NCTX + n] = f2bf(res[b]); } }
            __syncthreads();
        }
    }
}

__device__ __forceinline__ void ph4b_sum(const Frame& F, int nrows) {
    const bf16_t* ZG = wsp<bf16_t>(F, WS_ZG); bf16_t* MS = wsp<bf16_t>(F, WS_ZHT);
    u32x4 nx[2][4];
    if (F.gw < nrows) { const bf16_t* gp = ZG + (size_t)F.gw * ZGW + OFF_G;
#pragma unroll
        for (int j = 0; j < 2; ++j)
#pragma unroll
            for (int i = 0; i < 4; ++i) nx[j][i] = ldg8(gp + i * 1024 + 8 * F.lane + 512 * j); }
    for (int row = F.gw; row < nrows; row += F.NGW) {
        u32x4 cur[2][4];
#pragma unroll
        for (int j = 0; j < 2; ++j)
#pragma unroll
            for (int i = 0; i < 4; ++i) cur[j][i] = nx[j][i];
        if (row + F.NGW < nrows) { const bf16_t* gp = ZG + (size_t)(row + F.NGW) * ZGW + OFF_G;
#pragma unroll
            for (int j = 0; j < 2; ++j)
#pragma unroll
                for (int i = 0; i < 4; ++i) nx[j][i] = ldg8(gp + i * 1024 + 8 * F.lane + 512 * j); }
#pragma unroll
        for (int j = 0; j < 2; ++j) { const int col = 8 * F.lane + 512 * j; float a[8], t[8];
            unpack8(cur[j][0], a);
#pragma unroll
            for (int i = 1; i < 4; ++i) { unpack8(cur[j][i], t);
#pragma unroll
                for (int e = 0; e < 8; ++e) a[e] += t[e]; }
            *(u32x4*)(MS + (size_t)row * DM + col) = pack8(a); }
    }
}
__device__ __forceinline__ void ph6_ln1(const Frame& F, int l, int nrows, bool dry = false) {
    bf16_t* XF = wsp<bf16_t>(F, WS_XF); unsigned char* U8 = wsp<unsigned char>(F, WS_U); bf16_t* XFo = dry ? wsp<bf16_t>(F, WS_ZG) : XF; if (dry) U8 = wsp<unsigned char>(F, WS_ZG + (size_t)T_ALL * DM * 4); const float* MODl = wsp<float>(F, WS_MOD) + (size_t)l * 5 * 6144;
    const float* g = inptr(I_LNG) + (size_t)(l * 2 + 0) * DM; const float* bta = inptr(I_LNB) + (size_t)(l * 2 + 0) * DM;
    const bool moe = ((l & 1) != 0) && !dry; const int rpb = nrows / F.G, lane = F.lane; const bf16_t* MIX = wsp<bf16_t>(F, WS_Y);
    LAS float* RT = (LAS float*)(F.lds);
    LAS int* cnt = (LAS int*)(F.lds + 32768);
    LAS unsigned* rec = (LAS unsigned*)(F.lds + 32768 + 64);
    if (moe) { const float* rw = inptr(I_ROUTER) + (size_t)(l >> 1) * DM * NEXP;
        for (int i = F.tid; i < DM * NEXP; i += NTHREADS) RT[i] = rw[i];
        if (F.tid < 16) cnt[F.tid] = 0;
        __syncthreads(); }
    u32x2 nx[4]; u32x2 ny[4];
    { const int row = F.bid * rpb + F.wave;
#pragma unroll
      for (int j = 0; j < 4; ++j) { nx[j] = *(const u32x2*)(XF + (size_t)row * DM + 4 * lane + 256 * j); ny[j] = *(const u32x2*)(MIX + (size_t)row * DM + 4 * lane + 256 * j); } }
    for (int k = F.wave; k < rpb; k += NWAVES) {
        const int row = F.bid * rpb + k; bf16_t* xo = XFo + (size_t)row * DM;
        const float* m = MODl + (size_t)row_bsel(row) * 6144;
        f32x4 v[4]; u32x2 yy[4];
#pragma unroll
        for (int j = 0; j < 4; ++j) { v[j] = bf4_f32(nx[j]); yy[j] = ny[j]; }
        if (k + NWAVES < rpb) { const int rown = row + NWAVES;
#pragma unroll
            for (int j = 0; j < 4; ++j) { nx[j] = *(const u32x2*)(XF + (size_t)rown * DM + 4 * lane + 256 * j); ny[j] = *(const u32x2*)(MIX + (size_t)rown * DM + 4 * lane + 256 * j); } }
#pragma unroll
        for (int j = 0; j < 4; ++j) { const u32x2 y = yy[j]; const f32x4 mm = *(const f32x4*)(m + 2 * 1024 + 4 * lane + 256 * j);
            f32x4 f; f.x = bflo(y.x); f.y = bfhi(y.x); f.z = bflo(y.y); f.w = bfhi(y.y);
            v[j] = v[j] * ALPHA + mm * f; }
        ln_row(v, g, bta, lane);
#pragma unroll
        for (int j = 0; j < 4; ++j) *(u32x2*)(xo + 4 * lane + 256 * j) = f32_bf4(v[j]);
        store_mod_row8(v, m + 3 * 1024, m + 4 * 1024, U8 + (size_t)row * DM, lane);
        if (moe) {
            float lg[8] = {0.f, 0.f, 0.f, 0.f, 0.f, 0.f, 0.f, 0.f};
#pragma unroll
            for (int j = 0; j < 4; ++j) { const f32x4 a = *(const f32x4*)(m + 3 * 1024 + 4 * lane + 256 * j), s = *(const f32x4*)(m + 4 * 1024 + 4 * lane + 256 * j); const f32x4 u = v[j] * (s + 1.0f) + a;
#pragma unroll
                for (int c = 0; c < 4; ++c) { const LAS float* rp = RT + (size_t)(4 * lane + 256 * j + c) * 8; const f32x4 r0 = *(const LAS f32x4*)rp, r1 = *(const LAS f32x4*)(rp + 4); const float uu = u[c];
                    lg[0] += uu * r0.x; lg[1] += uu * r0.y; lg[2] += uu * r0.z; lg[3] += uu * r0.w; lg[4] += uu * r1.x; lg[5] += uu * r1.y; lg[6] += uu * r1.z; lg[7] += uu * r1.w; } }
#pragma unroll
            for (int e = 0; e < 8; ++e) lg[e] = wave_sum(lg[e], lane);
            float v0 = lg[0]; int i0 = 0;
#pragma unroll
            for (int e = 1; e < 8; ++e) if (lg[e] > v0) { v0 = lg[e]; i0 = e; }
            float v1 = -3.0e38f; int i1 = 0;
#pragma unroll
            for (int e = 0; e < 8; ++e) if (e != i0 && lg[e] > v1) { v1 = lg[e]; i1 = e; }
            const float w0 = __builtin_amdgcn_rcpf(1.f + __expf(v1 - v0)), w1 = 1.f - w0;
            if (lane == 0) { const int r0 = __hip_atomic_fetch_add(&cnt[i0], 1, __ATOMIC_RELAXED, __HIP_MEMORY_SCOPE_WORKGROUP), r1 = __hip_atomic_fetch_add(&cnt[i1], 1, __ATOMIC_RELAXED, __HIP_MEMORY_SCOPE_WORKGROUP);
                LAS unsigned* rc = rec + k * 8; rc[0] = (unsigned)i0; rc[1] = (unsigned)r0; rc[2] = (unsigned)i1; rc[3] = (unsigned)r1; rc[4] = __float_as_uint(w0); rc[5] = __float_as_uint(w1); }
        }
    }
    if (moe) {
        __syncthreads();
        if (F.tid < 8) cnt[8 + F.tid] = (int)__hip_atomic_fetch_add(F.ctl + CW_MOE + (l * 8 + F.tid) * 64, (unsigned)cnt[F.tid], __ATOMIC_RELAXED, __HIP_MEMORY_SCOPE_AGENT);
        __syncthreads();
        unsigned* PAIR = wsp<unsigned>(F, WS_PAIR);
        for (int k = F.tid; k < rpb; k += NTHREADS) { const int row = F.bid * rpb + k; const LAS unsigned* rc = rec + k * 8;
            u32x4 a; a.x = rc[0]; a.y = rc[1] + (unsigned)cnt[8 + rc[0]]; a.z = rc[2]; a.w = rc[3] + (unsigned)cnt[8 + rc[2]];
            *(u32x4*)(PAIR + (size_t)row * 8) = a; PAIR[(size_t)row * 8 + 4] = rc[4]; PAIR[(size_t)row * 8 + 5] = rc[5]; }
        __syncthreads();
    }
}
__device__ __forceinline__ void moe_tiles(const Frame& F, int l, bool moe, int nMr, int* ts  , int& ntiles) {
    int acc = 0;
#pragma unroll
    for (int e = 0; e < NEXP; ++e) { ts[e] = moe ? acc : (e ? 0x3fffffff : 0);
        const unsigned c = moe ? __hip_atomic_load(F.ctl + CW_MOE + (l * 8 + e) * 64, __ATOMIC_RELAXED, __HIP_MEMORY_SCOPE_AGENT) : 0u; acc += __builtin_amdgcn_readfirstlane((int)((c + 255u) >> 8)); }
    ntiles = moe ? acc : nMr;
}
__device__ __forceinline__ void ph7_gather(const Frame& F, int l, int nrows) {
    int ts[NEXP], ntiles; moe_tiles(F, l, true, 0, ts, ntiles);
    unsigned* PAIR = wsp<unsigned>(F, WS_PAIR); const unsigned char* U8 = wsp<unsigned char>(F, WS_U); unsigned char* XG = wsp<unsigned char>(F, WS_XG);
    u32x4 na = {0u, 0u, 0u, 0u}, nxr = {0u, 0u, 0u, 0u};
    if (F.gw < nrows) { na = *(const u32x4*)(PAIR + (size_t)F.gw * 8); nxr = ((const u32x4*)(U8 + (size_t)F.gw * DM))[F.lane]; }
    for (int tok = F.gw; tok < nrows; tok += F.NGW) {
        const u32x4 a = na, x0 = nxr;
        if (tok + F.NGW < nrows) { na = *(const u32x4*)(PAIR + (size_t)(tok + F.NGW) * 8); nxr = ((const u32x4*)(U8 + (size_t)(tok + F.NGW) * DM))[F.lane]; }
        int b0 = 0, b1 = 0;
#pragma unroll
        for (int e = 0; e < NEXP; ++e) { b0 = ((int)a.x == e) ? ts[e] : b0; b1 = ((int)a.z == e) ? ts[e] : b1; }
        const unsigned s0 = (unsigned)b0 * 256u + a.y, s1 = (unsigned)b1 * 256u + a.w;
        if (F.lane == 0) { PAIR[(size_t)tok * 8 + 6] = s0; PAIR[(size_t)tok * 8 + 7] = s1; }
        ((u32x4*)(XG + (size_t)s0 * DM))[F.lane] = x0; ((u32x4*)(XG + (size_t)s1 * DM))[F.lane] = x0;
    }
}
__device__ __forceinline__ void ph10_ln2(const Frame& F, int l, int nrows, bool dry = false) {
    bf16_t* XF = wsp<bf16_t>(F, WS_XF); bf16_t* U = dry ? wsp<bf16_t>(F, WS_ZG + (size_t)T_ALL * DM * 4) : wsp<bf16_t>(F, WS_U); bf16_t* XFo = dry ? wsp<bf16_t>(F, WS_ZG) : XF; float* OUTo = dry ? wsp<float>(F, WS_ZG) : F.out; const float* MOD = wsp<float>(F, WS_MOD);
    const float* g = inptr(I_LNG) + (size_t)(l * 2 + 1) * DM; const float* bta = inptr(I_LNB) + (size_t)(l * 2 + 1) * DM;
    const bool moe = (l & 1) != 0; const int lane = F.lane;
    const unsigned* PAIR = wsp<unsigned>(F, WS_PAIR); const bf16_t* YO = wsp<bf16_t>(F, WS_YO);
    for (int row0 = F.gw; row0 < nrows; row0 += 2 * F.NGW) {
        int rows[2]; rows[0] = row0; rows[1] = (row0 + F.NGW < nrows) ? row0 + F.NGW : row0;
        f32x4 v[2][4]; u32x2 ya[2][4], yb[2][4]; float w0[2], w1[2];
#pragma unroll
        for (int h = 0; h < 2; ++h) { const int row = rows[h]; const bf16_t* xr = XF + (size_t)row * DM;
            unsigned s0 = (unsigned)row, s1 = (unsigned)row; w0[h] = 1.f; w1[h] = 0.f;
            if (moe) { const unsigned* pr = PAIR + (size_t)row * 8; w0[h] = __uint_as_float(pr[4]); w1[h] = __uint_as_float(pr[5]); s0 = pr[6]; s1 = pr[7]; }
#pragma unroll
            for (int j = 0; j < 4; ++j) { v[h][j] = bf4_f32(*(const u32x2*)(xr + 4 * lane + 256 * j));
                ya[h][j] = *(const u32x2*)(YO + (size_t)s0 * DM + 4 * lane + 256 * j); yb[h][j] = *(const u32x2*)(YO + (size_t)s1 * DM + 4 * lane + 256 * j); } }
#pragma unroll
        for (int h = 0; h < 2; ++h) { const int row = rows[h];
            const float* m5 = MOD + ((size_t)l * 5 + row_bsel(row)) * 6144 + 5 * 1024;
#pragma unroll
            for (int j = 0; j < 4; ++j) { const u32x2 y0 = ya[h][j], y1 = yb[h][j]; const f32x4 mm = *(const f32x4*)(m5 + 4 * lane + 256 * j);
                f32x4 f; f.x = w0[h] * bflo(y0.x) + w1[h] * bflo(y1.x); f.y = w0[h] * bfhi(y0.x) + w1[h] * bfhi(y1.x); f.z = w0[h] * bflo(y0.y) + w1[h] * bflo(y1.y); f.w = w0[h] * bfhi(y0.y) + w1[h] * bfhi(y1.y);
                v[h][j] = v[h][j] * ALPHA + mm * f; }
            ln_row(v[h], g, bta, lane); }
#pragma unroll
        for (int h = 0; h < 2; ++h) { const int row = rows[h];
            if (l == DEPTH - 1) {
#pragma unroll
                for (int j = 0; j < 4; ++j) *(f32x4*)(OUTo + (size_t)row * DM + 4 * lane + 256 * j) = v[h][j];
            } else {
#pragma unroll
                for (int j = 0; j < 4; ++j) *(u32x2*)(XFo + (size_t)row * DM + 4 * lane + 256 * j) = f32_bf4(v[h][j]);
                const float* m = MOD + ((size_t)(l + 1) * 5 + row_bsel(row)) * 6144;
                store_mod_row(v[h], m, m + 1024, U + (size_t)row * DM, lane);
                if (!dry) store_mod_row8(v[h], m, m + 1024, wsp<unsigned char>(F, WS_U8M) + (size_t)row * DM, lane);
            } }
    }
}

constexpr int NPHL = 12;
constexpr int NPH = 2 + NPHL * DEPTH;
__device__ __forceinline__ bool in_range(int k, int lo, int hi) { asm volatile("" : "+s"(k)); return lo <= k && k < hi; }
__global__ void __launch_bounds__(NTHREADS, 2) mk_fwd(Args args) {
    extern __shared__ __attribute__((aligned(16))) unsigned char lds_raw[];
    Frame F;
    F.lds = (LAS unsigned char*)lds_raw + LDS_CTL; F.ldsg = lds_raw + LDS_CTL; F.lds0 = (unsigned)(uintptr_t)(LAS unsigned char*)lds_raw;
    F.out = args.out; F.ws = args.ws; F.ws0 = args.ws; F.ctl = (unsigned*)(args.ws + WS_CTL);
    F.tid = threadIdx.x; F.lane = F.tid & 63; F.wave = __builtin_amdgcn_readfirstlane(F.tid >> 6); F.wave0 = F.wave; F.G = gridDim.x; F.bid = blockIdx.x; F.gw = blockIdx.x * NWAVES + F.wave; F.NGW = F.G * NWAVES;
    volatile LAS unsigned* lctl = (volatile LAS unsigned*)((LAS unsigned char*)lds_raw);
    if (F.tid < 16) lctl[F.tid] = 0u;
    __syncthreads();
    const int lo = args.ph_lo, hi = args.ph_hi; const bool one = (hi - lo) > 1;
    XcdBarrier bar = xcd_barrier_post(F.ctl + CW_BAR, lctl);
#ifndef MK_REP
#define MK_REP 0
#endif
#ifndef MK_ONLY
#define MK_ONLY -1
#endif
#define EN(j) (MK_ONLY < 0 || MK_ONLY == (j))
#ifndef MK_SUB
#define MK_SUB -1
#endif
#define EN2(j) (MK_SUB < 0 || MK_SUB == (j))
#define IN(k) in_range((k), lo, hi)
#define SEAM(k) do { if (IN(k) && IN((k) + 1)) { xcd_barrier(bar); if (MK_REP == 12) xcd_barrier(bar); } } while (0)
#define QNEXT(headw, dst) do { if (F.tid == 0) lctl[4] = __hip_atomic_fetch_add((headw), 1u, __ATOMIC_RELAXED, __HIP_MEMORY_SCOPE_AGENT); __syncthreads(); dst = __builtin_amdgcn_readfirstlane((int)lctl[4]); __syncthreads(); } while (0)

    if (IN(0) && EN(0)) { frame_tid(F); cvt_range(F, 0, 0, CVT_NMIX + CVT_NF_D, 0); __syncthreads(); p0_mod(F); p0_filters(F); if (MK_REP == 8) { __syncthreads(); p0_mod(F); } if (MK_REP == 14) { __syncthreads(); p0_filters(F); } }
    SEAM(0);
    if (IN(1) && EN(1)) { frame_tid(F); p0b_rows(F); if (MK_REP == 15) p0b_rows(F); }
    SEAM(1);

#pragma unroll 1
    for (int l = 0; l < DEPTH; ++l) {
        const int pb = 2 + NPHL * l; const bool need_ctx = l < DEPTH - 1; const int nrows = need_ctx ? T_ALL : T_LAT, nMr = nrows / 256; const bool moe = (l & 1) != 0;
        if (IN(pb + 0) && EN(2)) { frame_tid(F); pg8::Gemm g{DM, DM, 64, 128, 32768}; pg8::GSched S; S.init(T_ALL / 256, INW / 256, F.G, F.bid, wsp<bf16_t>(F, WS_U), 256u * DM * 2, wsp<bf16_t>(F, WS_WCAT), 256u * DM * 2);
            pg8::EpiPlain E{(GAS bf16_t*)wsp<bf16_t>(F, WS_ZG), ZGW, 1.0f};
            pg8::gemm_phase(F.lds, g, S, E, F.tid);
            if (MK_REP == 5) { __syncthreads(); pg8::gemm_phase(F.lds, g, S, E, F.tid); }
            if (MK_REP == 16) { __syncthreads(); pg8::gemm_phase(F.lds, g, S, pg8::EpiNull{}, F.tid); }
            if (MK_REP == 18 || MK_REP == 19) { __syncthreads(); pg8::GSched S2; S2.init(64, MK_REP == 18 ? 4 : 8, F.G, F.bid, wsp<bf16_t>(F, WS_U), 256u * DM * 2, wsp<bf16_t>(F, WS_WCAT), 256u * DM * 2); pg8::gemm_phase(F.lds, g, S2, pg8::EpiNull{}, F.tid); }
            if (MK_REP == 20) { __syncthreads(); pg8::Gemm g2{DM, 64, 64, 32768, 32768}; pg8::gemm_phase(F.lds, g2, S, pg8::EpiNull{}, F.tid); }
            if (MK_REP == 21) { __syncthreads(); pg8::GSched S2; S2.init(T_ALL / 256, INW / 256, F.G, F.bid, wsp<bf16_t>(F, WS_U), 0u, wsp<bf16_t>(F, WS_WCAT), 0u); pg8::gemm_phase(F.lds, g, S2, pg8::EpiNull{}, F.tid); }
            if (MK_REP == 22) { __syncthreads(); pg8::Gemm g2{2 * DM, DM, DM}; pg8::gemm_phase(F.lds, g2, S, pg8::EpiNull{}, F.tid); }
            if (MK_REP == 23) { __syncthreads(); pg8::Gemm g2{DM, DM, 64, 128, 32768}; pg8::gemm_phase(F.lds, g2, S, pg8::EpiNull{}, F.tid); }
            if (MK_REP == 24) { __syncthreads(); pg8::Gemm g2{DM, 64, DM, 32768, 128}; pg8::gemm_phase(F.lds, g2, S, pg8::EpiNull{}, F.tid); }
            if (MK_REP == 25) { for (int rr = 0; rr < 3; ++rr) { __syncthreads(); pg8::SameSched S2{S}; pg8::gemm_phase(F.lds, g, S2, pg8::EpiNull{}, F.tid); } }
            if (MK_REP == 26) { for (int rr = 0; rr < 3; ++rr) { __syncthreads(); pg8::gemm_phase(F.lds, g, S, pg8::EpiNull{}, F.tid); } }
            if (MK_REP == 27) { for (int rr = 0; rr < 3; ++rr) { __syncthreads(); pg8::gemm_phase(F.lds, g, S, E, F.tid); } }
            if (MK_REP == 28) { for (int rr = 0; rr < 3; ++rr) { __syncthreads(); pg8::gemm_phase<false, 1>(F.lds, g, S, pg8::EpiNull{}, F.tid); } }
            if (MK_REP == 29) { for (int rr = 0; rr < 3; ++rr) { __syncthreads(); pg8::gemm_phase<false, 2>(F.lds, g, S, pg8::EpiNull{}, F.tid); } }
            if (MK_REP == 30) { for (int rr = 0; rr < 3; ++rr) { __syncthreads(); pg8::gemm_phase<false, 3>(F.lds, g, S, pg8::EpiNull{}, F.tid); } }
            if (MK_REP == 31) { for (int rr = 0; rr < 3; ++rr) { __syncthreads(); pg8::EpiZGNoStore E2{F.tid == 1000 ? 2.0f : 1.0f}; pg8::gemm_phase(F.lds, g, S, E2, F.tid); } }
            if (MK_REP == 32) { for (int rr = 0; rr < 3; ++rr) { __syncthreads(); pg8::EpiContig E2{(GAS unsigned char*)wsp<unsigned char>(F, WS_Y), 1.0f}; pg8::gemm_phase(F.lds, g, S, E2, F.tid); } }
            if (MK_REP == 33) { __syncthreads(); pg8::EpiContig E2{(GAS unsigned char*)wsp<unsigned char>(F, WS_Y), 1.0f}; pg8::gemm_phase(F.lds, g, S, E2, F.tid); __syncthreads(); pg8::gemm_phase(F.lds, g, S, E2, F.tid); }
            if (MK_REP == 34) { __syncthreads(); pg8::gemm_phase(F.lds, g, S, E, F.tid); __syncthreads(); pg8::gemm_phase(F.lds, g, S, E, F.tid); }
            if (MK_REP == 17) { __syncthreads(); pg8::Gemm g2{DM / 2, DM, DM}; pg8::gemm_phase(F.lds, g2, S, pg8::EpiNull{}, F.tid); } }
        if (IN(pb + 0) && EN(2)) { frame_tid(F); cvt_ffn_share<0>(F, l, ((T_ALL / 256) * (INW / 256)) % 256); }
        SEAM(pb + 0);
        if (IN(pb + 1) && EN(3)) { frame_tid(F); ph2_tokens(F, l, need_ctx); ph2_htrans(F); if (MK_REP == 1) { ph2_tokens(F, l, need_ctx); ph2_htrans(F); } __syncthreads(); ph2_retkv(F, l); }
        SEAM(pb + 1);
        if (IN(pb + 2) && EN(4)) { frame_tid(F);
            { pg8::Gemm g{DM / 2, DM / 2, 64, 128, 32768}; pg8::GSched S; S.init(nMr, 16, F.G, F.bid, wsp<unsigned char>(F, WS_U8M), 256u * DM, wsp<unsigned char>(F, WS_WG8), 256u * DM);
              pg8::EpiShift E{pg8::EpiZG{(GAS bf16_t*)wsp<bf16_t>(F, WS_ZG), (const GAS float*)(inptr(I_BGATE) + (size_t)l * 4096), 1.0f / F8_WSCALE}};
              pg8::gemm_phase<true>(F.lds, g, S, E, F.tid); }
            frame_tid(F);
            const int xcd_ = F.bid & 7, j_ = F.bid >> 3, au_ = (xcd_ >> 1) * 64 + (2 * (xcd_ & 1) + (j_ >> 4)) * 16 + (j_ & 15);
            for (int k = 0; k < 2; ++k) { const int it = k == 0 ? au_ : ((need_ctx && F.bid >= 64 && F.bid < 80) ? 256 + (F.bid - 64) : -1); if (it < 0) break;
                const bf16_t *Q, *K, *V; bf16_t* O; int seq;
                if (it < 256) { const int b = it >> 6, h = (it >> 4) & 3, qb = it & 15;
                    Q = wsp<bf16_t>(F, WS_QP) + ((size_t)(b * 4 + h) * SEQ + qb * 256) * 128; K = wsp<bf16_t>(F, WS_KALL) + (size_t)(b * 2 + (h >> 1)) * 4352 * 128; V = wsp<bf16_t>(F, WS_VALL) + (size_t)(b * 2 + (h >> 1)) * 4352 * 128;
                    O = wsp<bf16_t>(F, WS_Y) + (size_t)(b * SEQ + qb * 256) * YW + 1536 + h * 128; seq = 4352; }
                else { const int r = it - 256, b = r >> 2, h = r & 3;
                    Q = wsp<bf16_t>(F, WS_QC) + (size_t)(b * 4 + h) * NCTX * 128; K = wsp<bf16_t>(F, WS_KALL) + ((size_t)(b * 2 + (h >> 1)) * 4352 + SEQ) * 128; V = wsp<bf16_t>(F, WS_VALL) + ((size_t)(b * 2 + (h >> 1)) * 4352 + SEQ) * 128;
                    O = wsp<bf16_t>(F, WS_Y) + (size_t)(T_LAT + b * NCTX) * YW + 1536 + h * 128; seq = 256; }
                attn::attn_dense_body(Q, K, V, O, YW, seq, (char*)F.ldsg, F.tid); }
            frame_tid(F);
            for (int k = 0; k < 2; ++k) hyena_item(F, l, F.bid + 256 * k, need_ctx);
            frame_tid(F);
            for (int k = 0; k < 2; ++k) { const int it = k == 0 ? (F.bid >= 64 ? F.bid - 64 : -1) : ((F.bid >= 80 && F.bid < 144) ? 192 + (F.bid - 80) : -1); if (it < 0) break; ret_scan_item(F, l, it); }
        }
        SEAM(pb + 2);
        if (IN(pb + 3) && EN(5)) { frame_tid(F);
            for (int rep = 0; rep < (MK_REP == 4 ? 2 : 1); ++rep) {
            ph3b_ytrans(F, need_ctx); __syncthreads();
            { int it = F.bid; while (it < NBATCH * 4 * NCH && !need_ctx && (it % NCH) < 2) it += F.G;
              if (it < NBATCH * 4 * NCH) { RetPre pre; ret_out_load(F, it, pre);
                for (;;) { int nx = it + F.G; while (nx < NBATCH * 4 * NCH && !need_ctx && (nx % NCH) < 2) nx += F.G; if (nx >= NBATCH * 4 * NCH) nx = -1;
                    ret_out_item(F, l, it, pre, nx); if (nx < 0) break; it = nx; } } } }
        }
        SEAM(pb + 3);
        if (IN(pb + 4) && EN(6)) { frame_tid(F); pg8::Gemm g{512, YW, 64, 128, 32768}; pg8::GSched S; S.init(nMr, 16, F.G, F.bid, wsp<bf16_t>(F, WS_Y), 256u * YW * 2, wsp<bf16_t>(F, WS_WB), 256u * 512 * 2, 2, 512u * 2);
            pg8::EpiGate E{(GAS bf16_t*)wsp<bf16_t>(F, WS_ZG)};
            pg8::gemm_phase(F.lds, g, S, E, F.tid); }
        if (IN(pb + 4) && EN(6)) { frame_tid(F); cvt_ffn_share<1>(F, l, need_ctx ? 64 : 0); }
        SEAM(pb + 4);
        if (IN(pb + 5) && EN(13)) { frame_tid(F); ph4b_sum(F, nrows); if (MK_REP == 13) ph4b_sum(F, nrows); }
        SEAM(pb + 5);
        if (IN(pb + 6) && EN(7)) { frame_tid(F); pg8::Gemm g{DM, DM, 64, 128, 32768}; pg8::GSched S; S.init(nMr, 4, F.G, F.bid, wsp<bf16_t>(F, WS_ZHT), 256u * DM * 2, wsp<bf16_t>(F, WS_WO4), 256u * DM * 2);
            pg8::EpiPlain E{(GAS bf16_t*)wsp<bf16_t>(F, WS_Y), DM, 1.0f};
            pg8::gemm_phase(F.lds, g, S, E, F.tid);
            cvt_ffn_share<2>(F, l, need_ctx ? 16 : 0);
            if (MK_REP == 9) { __syncthreads(); pg8::gemm_phase(F.lds, g, S, E, F.tid); } }
        SEAM(pb + 6);
        if (IN(pb + 7) && EN(8)) { frame_tid(F); if (MK_REP == 16) ph6_ln1(F, l, nrows, true); ph6_ln1(F, l, nrows); }
        SEAM(pb + 7);
        if (IN(pb + 8) && EN(9)) { frame_tid(F); if (moe) { ph7_gather(F, l, nrows); if (MK_REP == 11) ph7_gather(F, l, nrows); } }
        if (moe) SEAM(pb + 8);
        if (IN(pb + 9) && EN(10)) { frame_tid(F);
            const int FF = moe ? FFE : FFD;
            pg8::Gemm g{DM / 2, DM / 2, 64, 128, 32768}; pg8::MoeSched S; S.G = F.G; S.c = F.bid; S.nN = 2 * FF / 256; moe_tiles(F, l, moe, nMr, S.ts, S.ntiles);
            S.A = (const char*)(moe ? wsp<unsigned char>(F, WS_XG) : wsp<unsigned char>(F, WS_U)); S.B = (const char*)wsp<unsigned char>(F, moe ? WS_W13 : WS_W13D); S.a_tile = 256u * DM; S.b_tile = 256u * DM;
            pg8::EpiSwiglu E{(GAS unsigned char*)wsp<unsigned char>(F, WS_HID), FF, 1.0f / F8_WSCALE};
            pg8::gemm_phase<true>(F.lds, g, S, E, F.tid);
            if (MK_REP == 6) { __syncthreads(); pg8::gemm_phase<true>(F.lds, g, S, E, F.tid); }
        }
        SEAM(pb + 9);
        if (IN(pb + 10) && EN(11)) { frame_tid(F);
            const int FF = moe ? FFE : FFD;
            pg8::Gemm g{FF / 2, FF / 2, 64, 128, 32768}; pg8::MoeSched S; S.G = F.G; S.c = F.bid; S.nN = 4; moe_tiles(F, l, moe, nMr, S.ts, S.ntiles);
            S.A = (const char*)wsp<unsigned char>(F, WS_HID); S.B = (const char*)wsp<unsigned char>(F, moe ? WS_W2 : WS_W2D); S.a_tile = 256u * (unsigned)FF; S.b_tile = 256u * (unsigned)FF;
            pg8::EpiPlain E{(GAS bf16_t*)wsp<bf16_t>(F, WS_YO), DM, 1.0f / F8_WSCALE};
            pg8::gemm_phase<true>(F.lds, g, S, E, F.tid);
            if (MK_REP == 10) { __syncthreads(); pg8::gemm_phase<true>(F.lds, g, S, E, F.tid); }
        }
        if (IN(pb + 10) && EN(11) && l + 1 < DEPTH) { frame_tid(F); int ts_[NEXP], nt_; moe_tiles(F, l, moe, nMr, ts_, nt_);
            cvt_range(F, l + 1, 0, CVT_NMIX + cvt_e1(l + 1), (nt_ * 4) & 255); }
        SEAM(pb + 10);
        if (IN(pb + 11) && EN(12)) { frame_tid(F); if (MK_REP == 17) ph10_ln2(F, l, nrows, true); ph10_ln2(F, l, nrows); }
        if (l + 1 < DEPTH) SEAM(pb + 11);
    }
#undef IN
#undef SEAM
#undef QNEXT
}

#ifndef MK_PER_PHASE
#define MK_PER_PHASE 0
#endif
extern "C" void kernel_launch(void* const* d_in, const int* in_sizes, int n_in, void* d_out, int out_size, void* d_ws, size_t ws_size, hipStream_t stream) {
    static int grid = 0;
    if (grid == 0) {
        if (n_in != N_IN || out_size != T_LAT * DM || ws_size < WS_END) { fprintf(stderr, "kernel_launch: unexpected shapes: n_in %d out %d ws %zu (need %zu)\n", n_in, out_size, ws_size, (size_t)WS_END); grid = -1; return; }
        int dev = 0, cus = 0, per_cu = 0;
        if (hipGetDevice(&dev) != hipSuccess || hipDeviceGetAttribute(&cus, hipDeviceAttributeMultiprocessorCount, dev) != hipSuccess) { grid = -1; return; }
        if (hipFuncSetAttribute((const void*)mk_fwd, hipFuncAttributeMaxDynamicSharedMemorySize, LDS_BYTES) != hipSuccess) { fprintf(stderr, "kernel_launch: hipFuncSetAttribute failed\n"); grid = -1; return; }
        if (hipOccupancyMaxActiveBlocksPerMultiprocessor(&per_cu, (const void*)mk_fwd, NTHREADS, LDS_BYTES) != hipSuccess || per_cu < 1) { fprintf(stderr, "kernel_launch: occupancy query says %d\n", per_cu); }
        (void)hipGetLastError();
        grid = cus;
        if (grid != 256) { fprintf(stderr, "kernel_launch: built for 256 CUs, got %d\n", grid); grid = -1; return; }
    }
    if (grid < 0) return;
    (void)hipMemsetAsync((char*)d_ws + WS_CTL, 0, CTL_BYTES, stream);
    Args a{};
    for (int i = 0; i < N_IN; ++i) a.in[i] = (const float*)d_in[i];
    a.out = (float*)d_out; a.ws = (unsigned char*)d_ws;
#if MK_PER_PHASE
    for (int p = 0; p < NPH; ++p) { a.ph_lo = p; a.ph_hi = p + 1; hipLaunchKernelGGL(mk_fwd, dim3(grid), dim3(NTHREADS), LDS_BYTES, stream, a); }
#else
    a.ph_lo = 0; a.ph_hi = NPH; hipLaunchKernelGGL(mk_fwd, dim3(grid), dim3(NTHREADS), LDS_BYTES, stream, a);
#endif
    const hipError_t le = hipPeekAtLastError();
    if (le != hipSuccess) fprintf(stderr, "kernel_launch: launch failed: %s\n", hipGetErrorName(le));
}
```

```cpp
#include <hip/hip_runtime.h>
#include <cstdio>
#include <cstdint>

#define LAS __attribute__((address_space(3)))
#define GAS __attribute__((address_space(1)))
typedef unsigned short bf16_t;
typedef short bf16x8 __attribute__((ext_vector_type(8)));
typedef short s16x4 __attribute__((ext_vector_type(4)));
typedef float f32x2 __attribute__((ext_vector_type(2)));
typedef float f32x4 __attribute__((ext_vector_type(4)));
typedef float f32x8 __attribute__((ext_vector_type(8)));
typedef float f32x16 __attribute__((ext_vector_type(16)));
typedef unsigned u32x2 __attribute__((ext_vector_type(2)));
typedef unsigned u32x4 __attribute__((ext_vector_type(4)));
typedef int i32x4 __attribute__((ext_vector_type(4)));
typedef int i32x8 __attribute__((ext_vector_type(8)));

constexpr int DM = 1024, NBATCH = 4, SEQ = 4096, DEPTH = 4, NCTX = 256;
constexpr int T_LAT = NBATCH * SEQ, T_CTX = NBATCH * NCTX, T_ALL = T_LAT + T_CTX;
constexpr int INW = 6144, ZGW = 10240, FFD = 2816, FFE = 3584, NEXP = 8;
constexpr int OFF_R = 1536, OFF_H = 3584, OFF_D = 5120, OFF_G = 6144;
constexpr int YW = 2048;
constexpr int NCH = 34;
constexpr int SLOT_MAX = 144 * 256;
constexpr float ALPHA = 1.681792830507429f;
constexpr float LN_EPS = 1e-6f;
constexpr int NTHREADS = 512, NWAVES = 8;

enum { I_X = 0, I_C, I_CTX, I_CCTX, I_WMOD, I_BMOD, I_WIN, I_CAW, I_CAB, I_RDEC, I_HCW, I_HCB, I_HW1, I_HB1, I_HW2, I_HB2, I_HW3, I_HFREQ, I_HSKIP,
       I_QN, I_KN, I_WGATE, I_BGATE, I_WBR, I_WO, I_LNG, I_LNB, I_FW1, I_FW3, I_FW2, I_ROUTER, I_MW1, I_MW3, I_MW2, N_IN };

constexpr size_t al256(size_t x) { return (x + 255) / 256 * 256; }
constexpr size_t WS_CTL   = 0;
constexpr size_t CTL_BYTES = 128 * 1024;
constexpr size_t WS_MOD   = WS_CTL + CTL_BYTES;
constexpr size_t WS_ROPE  = al256(WS_MOD + (size_t)DEPTH * 5 * 6144 * 4);
constexpr size_t WS_GF    = al256(WS_ROPE + 2 * 64 * 32 * 4);
constexpr size_t WS_GC    = al256(WS_GF + (size_t)DEPTH * 2 * 512 * 8192 * 2);
constexpr size_t WS_WCAT  = al256(WS_GC + (size_t)DEPTH * 2 * 512 * 512 * 4);
constexpr size_t WS_WB    = al256(WS_WCAT + (size_t)ZGW * DM * 2);
constexpr size_t WS_WO4   = al256(WS_WB + (size_t)4096 * 512 * 2);
constexpr size_t WS_W13   = al256(WS_WO4 + (size_t)1024 * 4096 * 2);
constexpr size_t WS_W13D  = WS_W13 + (size_t)NEXP * 2 * FFE * DM;
constexpr size_t WS_W2D   = WS_W13D + (size_t)2 * FFD * DM;
static_assert(WS_W2D + (size_t)DM * FFD <= WS_W13 + (size_t)NEXP * 2 * FFE * DM * 2, "dense FFN weights must fit in the W13 region");
constexpr size_t WS_W2    = al256(WS_W13 + (size_t)NEXP * 2 * FFE * DM * 2);
constexpr size_t WS_XF    = al256(WS_W2 + (size_t)NEXP * DM * FFE * 2);
constexpr size_t WS_U     = al256(WS_XF + (size_t)T_ALL * DM * 4);
constexpr size_t WS_ZG    = al256(WS_U + (size_t)T_ALL * DM * 2);
constexpr size_t WS_HID   = WS_ZG;
constexpr size_t WS_XG    = al256(WS_HID + (size_t)SLOT_MAX * FFE * 2);
constexpr size_t WS_Y     = al256(WS_ZG + (size_t)T_ALL * ZGW * 2);
constexpr size_t WS_YO    = WS_Y;
constexpr size_t WS_ZHT   = al256(WS_Y + (size_t)T_ALL * YW * 2);
constexpr size_t WS_ZHTC  = al256(WS_ZHT + (size_t)NBATCH * 1536 * SEQ * 2);
constexpr size_t WS_YHT   = al256(WS_ZHTC + (size_t)NBATCH * 1536 * NCTX * 2);
constexpr size_t WS_YHTC  = al256(WS_YHT + (size_t)NBATCH * 512 * SEQ * 2);
constexpr size_t WS_QP    = al256(WS_YHTC + (size_t)NBATCH * 512 * NCTX * 2);
constexpr size_t WS_QC    = al256(WS_QP + (size_t)NBATCH * 4 * SEQ * 128 * 2);
constexpr size_t WS_KALL  = al256(WS_QC + (size_t)NBATCH * 4 * NCTX * 128 * 2);
constexpr size_t WS_VALL  = al256(WS_KALL + (size_t)NBATCH * 2 * 4352 * 128 * 2);
constexpr size_t WS_KVS   = al256(WS_VALL + (size_t)NBATCH * 2 * 4352 * 128 * 2);
constexpr size_t WS_PAIR  = al256(WS_KVS + (size_t)NBATCH * 4 * 2 * NCH * 16384 * 4);
constexpr size_t WS_U8M   = al256(WS_PAIR + (size_t)T_ALL * 32);
constexpr size_t WS_WG8   = al256(WS_U8M + (size_t)T_ALL * DM);
constexpr size_t WS_END   = al256(WS_WG8 + (size_t)4096 * DM);
static_assert(WS_XG + (size_t)SLOT_MAX * DM * 2 <= WS_Y, "H + XG must fit inside the ZG region");
static_assert(WS_YO + (size_t)SLOT_MAX * DM * 2 <= WS_ZHTC, "YO must fit inside Y + ZHT");

constexpr int CW_BAR = 0;
constexpr int CW_QHEAD = 4096;
constexpr int CW_MOE = 8192;

__device__ __forceinline__ unsigned pk2(float lo, float hi) { unsigned r; asm("v_cvt_pk_bf16_f32 %0, %1, %2" : "=v"(r) : "v"(lo), "v"(hi)); return r; }
__device__ __forceinline__ bf16_t f2bf(float f) { return (bf16_t)(pk2(f, 0.f) & 0xffffu); }
__device__ __forceinline__ float bflo(unsigned w) { return __uint_as_float(w << 16); }
__device__ __forceinline__ float bfhi(unsigned w) { return __uint_as_float(w & 0xffff0000u); }
__device__ __forceinline__ f32x4 bf4_f32(u32x2 w) { f32x4 f; f.x = bflo(w.x); f.y = bfhi(w.x); f.z = bflo(w.y); f.w = bfhi(w.y); return f; }
__device__ __forceinline__ u32x2 f32_bf4(f32x4 v) { u32x2 w; w.x = pk2(v.x, v.y); w.y = pk2(v.z, v.w); return w; }
__device__ __forceinline__ float bf1(bf16_t h) { return __uint_as_float(((unsigned)h) << 16); }
__device__ __forceinline__ void unpack8(u32x4 w, float* f) { f[0] = bflo(w.x); f[1] = bfhi(w.x); f[2] = bflo(w.y); f[3] = bfhi(w.y); f[4] = bflo(w.z); f[5] = bfhi(w.z); f[6] = bflo(w.w); f[7] = bfhi(w.w); }
__device__ __forceinline__ u32x4 pack8(const float* f) { u32x4 w; w.x = pk2(f[0], f[1]); w.y = pk2(f[2], f[3]); w.z = pk2(f[4], f[5]); w.w = pk2(f[6], f[7]); return w; }
__device__ __forceinline__ float shfl_xor_l(float v, int o, int lane) { return __int_as_float(__builtin_amdgcn_ds_bpermute((lane ^ o) << 2, __float_as_int(v))); }
__device__ __forceinline__ float wave_sum(float v, int lane) {
#pragma unroll
    for (int o = 1; o < 64; o <<= 1) v += shfl_xor_l(v, o, lane);
    return v;
}
__device__ __forceinline__ float sigmoidf_(float x) { return __builtin_amdgcn_rcpf(1.f + __expf(-x)); }
__device__ __forceinline__ float siluf_(float x) { return x * sigmoidf_(x); }
__device__ __forceinline__ int crow(int r, int hi) { return (r & 3) + 8 * (r >> 2) + 4 * hi; }
#define LDS_WAIT() asm volatile("s_waitcnt lgkmcnt(0)" ::: "memory")
constexpr float F8_WSCALE = 64.0f;
__device__ __forceinline__ float clamp448(float x) { return __builtin_amdgcn_fmed3f(x, -448.f, 448.f); }
__device__ __forceinline__ unsigned pk4_fp8(float a, float b, float c, float d) {
    int w = __builtin_amdgcn_cvt_pk_fp8_f32(clamp448(a), clamp448(b), 0, false); w = __builtin_amdgcn_cvt_pk_fp8_f32(clamp448(c), clamp448(d), w, true); return (unsigned)w; }

#define XB_TMO      128
#define XB_XCNT(j)  (256  + 64 * (j))
#define XB_XSUB(j)  (1280 + 64 * (j))
#define XB_XGEN(j)  (2304 + 64 * (j))
#define XB_TOP      3328
#define XB_TOPGEN   3392
#define XCD_BAR_WORDS 3456
#define XB_SPIN_CAP (1u << 22)

__device__ __forceinline__ unsigned xb_ld(unsigned* p)              { return __hip_atomic_load(p, __ATOMIC_RELAXED, __HIP_MEMORY_SCOPE_AGENT); }
__device__ __forceinline__ unsigned xb_add(unsigned* p, unsigned v) { return __hip_atomic_fetch_add(p, v, __ATOMIC_RELAXED, __HIP_MEMORY_SCOPE_AGENT); }
__device__ __forceinline__ unsigned xb_xcc_id() { return (unsigned)__builtin_amdgcn_s_getreg((3 << 11) | 20) & 0xFu; }
#define XB_SPIN(cond, bar) do { unsigned _sp = 0; while (cond) { __builtin_amdgcn_s_sleep(1); \
    if ((++_sp & 255u) == 0u) { if (xb_ld(&(bar)[XB_TMO])) break; if (_sp > XB_SPIN_CAP) { atomicAdd(&(bar)[XB_TMO], 1u); break; } } } } while (0)

struct XcdBarrier { unsigned* bar; unsigned x; volatile LAS unsigned* st; };

__device__ __forceinline__ XcdBarrier xcd_barrier_post(unsigned* bar, volatile LAS unsigned* st) {
    XcdBarrier b; b.bar = bar; b.x = xb_xcc_id(); b.st = st;
    if (threadIdx.x == 0) (void)xb_add(&bar[XB_XCNT(b.x)], 1u);
    return b;
}
__device__ __forceinline__ void xcd_barrier_complete(unsigned* bar, unsigned x, unsigned& nloc, unsigned& nx) {
    const unsigned G = gridDim.x * gridDim.y * gridDim.z;
    unsigned sum, cnt, mine, sp = 0u;
    for (;;) {
        sum = 0u; cnt = 0u; mine = 0u;
#pragma unroll
        for (unsigned j = 0; j < 16; ++j) { const unsigned c = xb_ld(&bar[XB_XCNT(j)]); sum += c; cnt += (c > 0u) ? 1u : 0u; mine = (j == x) ? c : mine; }
        if (sum == G) break;
        __builtin_amdgcn_s_sleep(1);
        if ((++sp & 255u) == 0u) { if (xb_ld(&bar[XB_TMO])) break; if (sp > XB_SPIN_CAP) { atomicAdd(&bar[XB_TMO], 1u); break; } }
    }
    nloc = mine > 0u ? mine : 1u; nx = cnt > 0u ? cnt : 1u;
}
__device__ __forceinline__ void xcd_barrier(const XcdBarrier& b) {
    asm volatile("s_waitcnt vmcnt(0)" ::: "memory");
    __syncthreads();
    int t0_ = threadIdx.x; asm volatile("" : "+v"(t0_));
    if (t0_ == 0) {
        unsigned* bar = b.bar; unsigned bx = b.x;
        asm volatile("" : "+s"(bar), "+s"(bx));
        __builtin_amdgcn_s_waitcnt(0);
        unsigned nloc = b.st[0], nx = b.st[1];
        if (nloc == 0u) { xcd_barrier_complete(bar, bx, nloc, nx); b.st[0] = nloc; b.st[1] = nx; }
        const unsigned old = xb_add(&bar[XB_XSUB(bx)], 1u);
        const unsigned gen = old / nloc;
        if (old + 1u == (gen + 1u) * nloc) {
            __builtin_amdgcn_fence(__ATOMIC_RELEASE, "agent");
            asm volatile("s_waitcnt vmcnt(0)" ::: "memory");
            const unsigned og = xb_add(&bar[XB_TOP], 1u);
            const unsigned tg = og / nx;
            if (og + 1u == (tg + 1u) * nx) xb_add(&bar[XB_TOPGEN], 1u);
            else XB_SPIN(xb_ld(&bar[XB_TOPGEN]) == tg, bar);
            __builtin_amdgcn_fence(__ATOMIC_ACQUIRE, "agent");
            xb_add(&bar[XB_XGEN(bx)], 1u);
            asm volatile("s_waitcnt vmcnt(0)" ::: "memory");
        } else {
            XB_SPIN(xb_ld(&bar[XB_XGEN(bx)]) == gen, bar);
            __builtin_amdgcn_fence(__ATOMIC_ACQUIRE, "agent");
            asm volatile("s_waitcnt vmcnt(0)" ::: "memory");
        }
    }
    __syncthreads();
}

namespace pg8 {
constexpr int BM = 256, BK = 64, HALF = 128, HTB = HALF * BK * 2, STAGE_BYTES = 8 * HTB, NXCD = 8, WGM = 8;
__device__ __forceinline__ int lds_byte(int r, int c) { const int st = (r >> 4) * 2 + (c >> 5), rr = r & 15, cc = c & 31, ob = rr * 64 + cc * 2; return st * 1024 + (ob ^ (((ob >> 9) & 1) << 5)); }
__device__ __forceinline__ void stage_rc(int b, int& R, int& C) { const int st = b / 1024, sb = b % 1024, swz = sb ^ (((sb >> 9) & 1) << 5); R = (st >> 1) * 16 + swz / 64; C = (st & 1) * 32 + (swz % 64) / 2; }
__device__ __forceinline__ int perm32(int rho) { const int n = rho >> 4, i = rho & 15; return 8 * (i >> 2) + 4 * n + (i & 3); }

struct Unit { const char* A; const char* B; int pm, pn, e, pad; };
struct Gemm { int K, lda, ldb; int kstep = BK * 2, kstepb = BK * 2; };

struct GSched {
    int nM, nN, nwg, G, c;
    const char* A; const char* B; unsigned a_tile, b_tile, a_col; int a_sh;
    __device__ void init(int nM_, int nN_, int G_, int c_, const void* A_, unsigned a_tile_, const void* B_, unsigned b_tile_, int a_sh_ = 30, unsigned a_col_ = 0) {
        nM = nM_; nN = nN_; nwg = nM * nN; G = G_; c = c_; A = (const char*)A_; B = (const char*)B_; a_tile = a_tile_; b_tile = b_tile_; a_sh = a_sh_; a_col = a_col_; }
    __device__ __forceinline__ bool next(int i, Unit& u) const {
        const int L = i * G + c; if (L >= nwg) return false;
        int wgid = L; { const int q = nwg / NXCD, r = nwg % NXCD, xcd = wgid % NXCD, off = wgid / NXCD; wgid = (xcd < r ? xcd * (q + 1) : r * (q + 1) + (xcd - r) * q) + off; }
        const int nig = WGM * nN, gid = wgid / nig, fm = gid * WGM, gsz = (nM - fm) < WGM ? (nM - fm) : WGM;
        u.pm = fm + ((wgid % nig) % gsz); u.pn = (wgid % nig) / gsz; u.e = 0; u.pad = 0;
        u.A = A + (size_t)((unsigned)u.pm * a_tile + (unsigned)(u.pn >> a_sh) * a_col); u.B = B + (size_t)((unsigned)u.pn * b_tile); return true;
    }
};
struct SameSched { GSched s; __device__ __forceinline__ bool next(int i, Unit& u) const { Unit t; if (!s.next(i, t)) return false; s.next(0, u); return true; } };
struct MoeSched {
    int G, c, nN, ntiles; int ts[NEXP];
    const char* A; const char* B; unsigned a_tile, b_tile;
    __device__ __forceinline__ bool next(int i, Unit& u) const {
        const int L = i * G + c; if (L >= ntiles * nN) return false;
        const int rt = L / nN, pn = L % nN; int e = 0;
#pragma unroll
        for (int k = 1; k < NEXP; ++k) e += (rt >= ts[k]) ? 1 : 0;
        u.pm = rt; u.pn = pn; u.e = e; u.pad = 0; u.A = A + (size_t)((unsigned)rt * a_tile); u.B = B + (size_t)((unsigned)(e * nN + pn) * b_tile); return true;
    }
};

__device__ __forceinline__ unsigned cvt_pk_bf16(float lo, float hi) { return pk2(lo, hi); }

template <bool F8 = false, int PROBE = 0, class Epi, class Sched>
__device__ __forceinline__ void gemm_phase(LAS unsigned char* lds, const Gemm g, const Sched& S, const Epi& E, const int tid) {
    const int wid = __builtin_amdgcn_readfirstlane(tid >> 6), lane = tid & 63, wr = wid >> 2, wc = wid & 3, fr = lane & 15, fq = lane >> 4;
    const int K = g.K, nt = K / BK;
    unsigned voffA[2], voffB[2];
#pragma unroll
    for (int i = 0; i < 2; ++i) { int R, C; stage_rc(tid * 16 + i * 8192, R, C); const int Rb = Epi::PERM ? ((R & ~31) + perm32(R & 31)) : R;
        voffA[i] = (unsigned)(R * g.lda + C) * 2u; voffB[i] = (unsigned)(Rb * g.ldb + C) * 2u; }
    const size_t kstep = (size_t)g.kstep, kstepb = (size_t)g.kstepb;
    const size_t hstepA = (size_t)HALF * g.lda * 2, hstepB = (size_t)HALF * g.ldb * 2;
    const unsigned ldsw = (unsigned)wid * 1024u;
    const int aoff = lds_byte(wr * 64 + fr, fq * 8), boff = lds_byte(wc * 32 + fr, fq * 8);
#define PG8_SA(b, h) (((b) * 2 + (h)) * HTB)
#define PG8_SB(b, h) ((4 + (b) * 2 + (h)) * HTB)
#define PG8_STAGE(bufoff, gbase, voff) do { if constexpr (PROBE == 1 || PROBE == 3) break; _Pragma("unroll") for (int _i = 0; _i < 2; ++_i) { unsigned _vo = (voff)[_i]; if constexpr (F8) asm volatile("" : "+v"(_vo));     \
        __builtin_amdgcn_global_load_lds((const unsigned*)((const char*)(gbase) + _vo), (LAS unsigned*)(lds + (bufoff) + ldsw + _i * 8192), 16, 0, 0); } } while (0)
#define PG8_CAT(x0, x1) __builtin_shufflevector(__builtin_bit_cast(i32x4, x0), __builtin_bit_cast(i32x4, x1), 0, 1, 2, 3, 4, 5, 6, 7)
#define PG8_LDA(dst, b, h) do { if constexpr (PROBE == 3) { _Pragma("unroll") for (int m = 0; m < 4; ++m) asm volatile("" : "+v"(dst[m][0]), "+v"(dst[m][1])); break; } _Pragma("unroll") for (int m = 0; m < 4; ++m) { const bf16x8 _x0 = *(const LAS bf16x8*)(lds + PG8_SA(b, h) + aoff + m * 2048), _x1 = *(const LAS bf16x8*)(lds + PG8_SA(b, h) + aoff + m * 2048 + 1024); \
        if constexpr (F8) dst##8[m] = PG8_CAT(_x0, _x1); else { dst[m][0] = _x0; dst[m][1] = _x1; } } } while (0)
#define PG8_LDB(dst, b, h) do { if constexpr (PROBE == 3) { _Pragma("unroll") for (int n = 0; n < 2; ++n) asm volatile("" : "+v"(dst[n][0]), "+v"(dst[n][1])); break; } _Pragma("unroll") for (int n = 0; n < 2; ++n) { const bf16x8 _x0 = *(const LAS bf16x8*)(lds + PG8_SB(b, h) + boff + n * 2048), _x1 = *(const LAS bf16x8*)(lds + PG8_SB(b, h) + boff + n * 2048 + 1024); \
        if constexpr (F8) dst##8[n] = PG8_CAT(_x0, _x1); else { dst[n][0] = _x0; dst[n][1] = _x1; } } } while (0)
#define PG8_MMA(ai, bj, At, Bt) do { if constexpr (PROBE == 2) { _Pragma("unroll") for (int m = 0; m < 4; ++m) asm volatile("" :: "v"(At[m][0]), "v"(At[m][1])); _Pragma("unroll") for (int n = 0; n < 2; ++n) asm volatile("" :: "v"(Bt[n][0]), "v"(Bt[n][1])); break; } __builtin_amdgcn_s_setprio(1); _Pragma("unroll") for (int m = 0; m < 4; ++m) _Pragma("unroll") for (int n = 0; n < 2; ++n) { \
        if constexpr (F8) asm volatile("v_mfma_f32_16x16x128_f8f6f4 %0, %1, %2, %0" : "+v"(acc[ai][bj][m][n]) : "v"(Bt##8[n]), "v"(At##8[m]));     \
        else { _Pragma("unroll") for (int k = 0; k < 2; ++k) acc[ai][bj][m][n] = __builtin_amdgcn_mfma_f32_16x16x32_bf16(Bt[n][k], At[m][k], acc[ai][bj][m][n], 0, 0, 0); } } __builtin_amdgcn_s_setprio(0); } while (0)
#define PG8_WAIT_V(n) asm volatile("s_waitcnt vmcnt(" #n ")" ::: "memory")
#define PG8_WAIT_L(n) asm volatile("s_waitcnt lgkmcnt(" #n ")" ::: "memory")
#define PG8_BAR __builtin_amdgcn_s_barrier()
#define PG8_SCHED __builtin_amdgcn_sched_barrier(0)
    Unit cur, nxt; int ui = 0;
    if (!S.next(0, cur)) return;
    f32x4 acc[2][2][4][2];
    float zero_ = 0.f; asm volatile("" : "+v"(zero_));
#pragma unroll
    for (int a = 0; a < 2; ++a)
#pragma unroll
        for (int b = 0; b < 2; ++b)
#pragma unroll
            for (int m = 0; m < 4; ++m)
#pragma unroll
                for (int n = 0; n < 2; ++n) acc[a][b][m][n] = (f32x4){zero_, zero_, zero_, zero_};
    bf16x8 At[4][2], B0[2][2], B1[2][2]; i32x8 At8[4], B08[2], B18[2];
    if constexpr (PROBE == 3) { _Pragma("unroll") for (int m = 0; m < 4; ++m) { At[m][0] = (bf16x8)0; At[m][1] = (bf16x8)0; } _Pragma("unroll") for (int n = 0; n < 2; ++n) { B0[n][0] = (bf16x8)0; B0[n][1] = (bf16x8)0; B1[n][0] = (bf16x8)0; B1[n][1] = (bf16x8)0; } }
    const char* cA = cur.A; const char* cB = cur.B;
    PG8_STAGE(PG8_SB(0, 0), cB, voffB); PG8_STAGE(PG8_SA(0, 0), cA, voffA); PG8_STAGE(PG8_SB(0, 1), cB + hstepB, voffB); PG8_STAGE(PG8_SA(0, 1), cA + hstepA, voffA);
    if (wr == 1) PG8_BAR;
    PG8_WAIT_V(4); PG8_BAR;
    PG8_STAGE(PG8_SB(1, 0), cB + kstepb, voffB); PG8_STAGE(PG8_SA(1, 0), cA + kstep, voffA); PG8_STAGE(PG8_SB(1, 1), cB + hstepB + kstepb, voffB); PG8_STAGE(PG8_SA(1, 1), cA + hstepA + kstep, voffA);
    PG8_WAIT_V(8); PG8_BAR;
    for (;;) {
        const bool has_next = S.next(ui + 1, nxt);
        const char* nA = has_next ? nxt.A : cA; const char* nB = has_next ? nxt.B : cB;
#pragma clang loop unroll(disable)
        for (int t = 0; t < nt; t += 2) {
            const bool last = (t == nt - 2), first = (t == 0);
            const char* a1 = cA + (size_t)(t + 1) * kstep;
            const char* a2 = last ? nA : cA + (size_t)(t + 2) * kstep; const char* b2 = last ? nB : cB + (size_t)(t + 2) * kstepb;
            const char* a3 = a2 + kstep; const char* b3 = b2 + kstepb;
            PG8_LDB(B0, 0, 0); PG8_SCHED; PG8_LDA(At, 0, 0); if (!first) PG8_STAGE(PG8_SA(1, 1), a1 + hstepA, voffA);
            PG8_WAIT_L(8); PG8_BAR; PG8_WAIT_L(0); PG8_MMA(0, 0, At, B0); PG8_BAR; PG8_SCHED;
            PG8_LDB(B1, 0, 1); PG8_STAGE(PG8_SB(0, 0), b2, voffB);
            PG8_BAR; PG8_WAIT_L(0); PG8_MMA(0, 1, At, B1); PG8_BAR;
            PG8_LDA(At, 0, 1); PG8_STAGE(PG8_SA(0, 0), a2, voffA);
            PG8_BAR; PG8_WAIT_L(0); PG8_MMA(1, 0, At, B0); PG8_BAR; PG8_SCHED;
            PG8_STAGE(PG8_SB(0, 1), b2 + hstepB, voffB);
            if (first && ui > 0) { if constexpr (Epi::NST == 16) PG8_WAIT_V(22); else if constexpr (Epi::NST == 8) PG8_WAIT_V(14); else PG8_WAIT_V(6); }
            else PG8_WAIT_V(6);
            PG8_BAR; PG8_MMA(1, 1, At, B1); PG8_BAR;
            PG8_LDB(B0, 1, 0); PG8_SCHED; PG8_LDA(At, 1, 0); PG8_STAGE(PG8_SA(0, 1), a2 + hstepA, voffA);
            PG8_WAIT_L(8); PG8_BAR; PG8_WAIT_L(0); PG8_MMA(0, 0, At, B0); PG8_BAR; PG8_SCHED;
            PG8_LDB(B1, 1, 1); PG8_STAGE(PG8_SB(1, 0), b3, voffB);
            PG8_BAR; PG8_WAIT_L(0); PG8_MMA(0, 1, At, B1); PG8_BAR;
            PG8_LDA(At, 1, 1); PG8_STAGE(PG8_SA(1, 0), a3, voffA);
            PG8_BAR; PG8_WAIT_L(0); PG8_MMA(1, 0, At, B0); PG8_BAR; PG8_SCHED;
            PG8_STAGE(PG8_SB(1, 1), b3 + hstepB, voffB);
            PG8_WAIT_V(6); PG8_BAR; PG8_MMA(1, 1, At, B1); PG8_BAR;
        }
        const auto epre = E.pre(cur, wr, wc, fr, fq); asm volatile("" ::: "memory");
        PG8_STAGE(PG8_SA(1, 1), nA + kstep + hstepA, voffA); asm volatile("" ::: "memory");
        if constexpr (F8) asm volatile("s_nop 15\n\ts_nop 15" ::: "memory");
        E(acc, cur, wr, wc, fr, fq, epre);
        if (!has_next) break;
        asm volatile("" : "+v"(zero_));
#pragma unroll
        for (int a = 0; a < 2; ++a)
#pragma unroll
            for (int b = 0; b < 2; ++b)
#pragma unroll
                for (int m = 0; m < 4; ++m)
#pragma unroll
                    for (int n = 0; n < 2; ++n) acc[a][b][m][n] = (f32x4){zero_, zero_, zero_, zero_};
        cur = nxt; cA = nA; cB = nB; ++ui;
    }
    PG8_WAIT_V(0);
    if (wr == 0) PG8_BAR;
    PG8_BAR;
#undef PG8_SA
#undef PG8_SB
#undef PG8_STAGE
#undef PG8_LDA
#undef PG8_LDB
#undef PG8_MMA
#undef PG8_CAT
#undef PG8_WAIT_V
#undef PG8_WAIT_L
#undef PG8_BAR
#undef PG8_SCHED
}

typedef f32x4 Acc[2][2][4][2];

struct EpiPreNone {};
struct EpiZG { static constexpr bool PERM = true; static constexpr int NST = 16;
    GAS bf16_t* ZG; const GAS float* bgate; float sc;
    struct Pre { f32x4 bv[2][2]; };
    __device__ __forceinline__ Pre pre(const Unit& u, int wr, int wc, int fr, int fq) const {
        const int col0 = u.pn * BM + wc * 32 + 8 * fq; const bool gate = (u.pn >= 24); Pre p;
#pragma unroll
        for (int bj = 0; bj < 2; ++bj)
#pragma unroll
            for (int n = 0; n < 2; ++n) p.bv[bj][n] = gate ? *(const GAS f32x4*)(bgate + (col0 - OFF_G) + bj * HALF + 4 * n) : (f32x4){0.f, 0.f, 0.f, 0.f};
        return p; }
    __device__ __forceinline__ void operator()(const Acc& acc, const Unit& u, int wr, int wc, int fr, int fq, const Pre& p) const {
        const int row0 = u.pm * BM + wr * 64 + fr, col0 = u.pn * BM + wc * 32 + 8 * fq; const bool gate = (u.pn >= 24);
#pragma unroll
        for (int ai = 0; ai < 2; ++ai)
#pragma unroll
            for (int m = 0; m < 4; ++m) { GAS bf16_t* rowp = ZG + (size_t)(row0 + ai * HALF + m * 16) * ZGW + col0;
#pragma unroll
                for (int bj = 0; bj < 2; ++bj) { f32x4 v0 = acc[ai][bj][m][0] * sc + p.bv[bj][0], v1 = acc[ai][bj][m][1] * sc + p.bv[bj][1];
                    if (gate) {
#pragma unroll
                        for (int j = 0; j < 4; ++j) { v0[j] = sigmoidf_(v0[j]); v1[j] = sigmoidf_(v1[j]); } }
                    u32x4 w; w.x = pk2(v0[0], v0[1]); w.y = pk2(v0[2], v0[3]); w.z = pk2(v1[0], v1[1]); w.w = pk2(v1[2], v1[3]);
                    *(GAS u32x4*)(rowp + bj * HALF) = w; } }
    }
};
struct EpiShift { static constexpr bool PERM = true; static constexpr int NST = 16; EpiZG e;
    typedef EpiZG::Pre Pre;
    __device__ __forceinline__ Pre pre(const Unit& u, int wr, int wc, int fr, int fq) const { Unit u2 = u; u2.pn += 24; return e.pre(u2, wr, wc, fr, fq); }
    __device__ __forceinline__ void operator()(const Acc& acc, const Unit& u, int wr, int wc, int fr, int fq, const Pre& p) const { Unit u2 = u; u2.pn += 24; e(acc, u2, wr, wc, fr, fq, p); } };
struct EpiGate { static constexpr bool PERM = true; static constexpr int NST = 16;
    GAS bf16_t* ZG;
    struct Pre { u32x4 gw[2][4][2]; };
    __device__ __forceinline__ Pre pre(const Unit& u, int wr, int wc, int fr, int fq) const {
        const int row0 = u.pm * BM + wr * 64 + fr, col0 = OFF_G + u.pn * BM + wc * 32 + 8 * fq;
        GAS bf16_t* base = ZG + (size_t)row0 * ZGW + col0; Pre p;
#pragma unroll
        for (int ai = 0; ai < 2; ++ai)
#pragma unroll
            for (int m = 0; m < 4; ++m)
#pragma unroll
                for (int bj = 0; bj < 2; ++bj) p.gw[ai][m][bj] = *(const GAS u32x4*)(base + (size_t)(ai * HALF + m * 16) * ZGW + bj * HALF);
        return p; }
    __device__ __forceinline__ void operator()(const Acc& acc, const Unit& u, int wr, int wc, int fr, int fq, const Pre& p) const {
        const int row0 = u.pm * BM + wr * 64 + fr, col0 = OFF_G + u.pn * BM + wc * 32 + 8 * fq;
        GAS bf16_t* base = ZG + (size_t)row0 * ZGW + col0;
#pragma unroll
        for (int ai = 0; ai < 2; ++ai)
#pragma unroll
            for (int m = 0; m < 4; ++m)
#pragma unroll
                for (int bj = 0; bj < 2; ++bj) { float gf[8]; unpack8(p.gw[ai][m][bj], gf);
                    const f32x4 v0 = acc[ai][bj][m][0], v1 = acc[ai][bj][m][1];
                    u32x4 w; w.x = pk2(v0[0] * gf[0], v0[1] * gf[1]); w.y = pk2(v0[2] * gf[2], v0[3] * gf[3]); w.z = pk2(v1[0] * gf[4], v1[1] * gf[5]); w.w = pk2(v1[2] * gf[6], v1[3] * gf[7]);
                    *(GAS u32x4*)(base + (size_t)(ai * HALF + m * 16) * ZGW + bj * HALF) = w; }
    }
};
struct EpiSwiglu { static constexpr bool PERM = true; static constexpr int NST = 8;
    GAS unsigned char* H; int ldh; float sc;
    typedef EpiPreNone Pre; __device__ __forceinline__ Pre pre(const Unit&, int, int, int, int) const { return Pre{}; }
    __device__ __forceinline__ void operator()(const Acc& acc, const Unit& u, int wr, int wc, int fr, int fq, const Pre&) const {
        const int row0 = u.pm * BM + wr * 64 + fr, col0 = u.pn * HALF + wc * 32 + 8 * fq;
#pragma unroll
        for (int ai = 0; ai < 2; ++ai)
#pragma unroll
            for (int m = 0; m < 4; ++m) { GAS unsigned char* rowp = H + (size_t)(row0 + ai * HALF + m * 16) * ldh + col0;
                const f32x4 a0 = acc[ai][0][m][0] * sc, a1 = acc[ai][0][m][1] * sc, b0 = acc[ai][1][m][0] * sc, b1 = acc[ai][1][m][1] * sc;
                float h[8];
#pragma unroll
                for (int j = 0; j < 4; ++j) { h[j] = siluf_(a0[j]) * b0[j]; h[4 + j] = siluf_(a1[j]) * b1[j]; }
                u32x2 w; w.x = pk4_fp8(h[0], h[1], h[2], h[3]); w.y = pk4_fp8(h[4], h[5], h[6], h[7]); *(GAS u32x2*)rowp = w; }
    }
};
struct EpiPlain { static constexpr bool PERM = true; static constexpr int NST = 16;
    GAS bf16_t* O; int ldo; float sc;
    typedef EpiPreNone Pre; __device__ __forceinline__ Pre pre(const Unit&, int, int, int, int) const { return Pre{}; }
    __device__ __forceinline__ void operator()(const Acc& acc, const Unit& u, int wr, int wc, int fr, int fq, const Pre&) const {
        const int row0 = u.pm * BM + wr * 64 + fr, col0 = u.pn * BM + wc * 32 + 8 * fq;
#pragma unroll
        for (int ai = 0; ai < 2; ++ai)
#pragma unroll
            for (int m = 0; m < 4; ++m) { GAS bf16_t* rowp = O + (size_t)(row0 + ai * HALF + m * 16) * ldo + col0;
#pragma unroll
                for (int bj = 0; bj < 2; ++bj) { const f32x4 v0 = acc[ai][bj][m][0] * sc, v1 = acc[ai][bj][m][1] * sc;
                    u32x4 w; w.x = pk2(v0[0], v0[1]); w.y = pk2(v0[2], v0[3]); w.z = pk2(v1[0], v1[1]); w.w = pk2(v1[2], v1[3]);
                    *(GAS u32x4*)(rowp + bj * HALF) = w; } }
    }
};
struct EpiZGNoStore { static constexpr bool PERM = true; static constexpr int NST = 0; float sc;
    typedef EpiPreNone Pre; __device__ __forceinline__ Pre pre(const Unit&, int, int, int, int) const { return Pre{}; }
    __device__ __forceinline__ void operator()(const Acc& acc, const Unit& u, int wr, int wc, int fr, int fq, const Pre&) const {
#pragma unroll
        for (int ai = 0; ai < 2; ++ai)
#pragma unroll
            for (int m = 0; m < 4; ++m)
#pragma unroll
                for (int bj = 0; bj < 2; ++bj) { f32x4 v0 = acc[ai][bj][m][0] * sc, v1 = acc[ai][bj][m][1] * sc;
                    u32x4 w; w.x = pk2(v0[0], v0[1]); w.y = pk2(v0[2], v0[3]); w.z = pk2(v1[0], v1[1]); w.w = pk2(v1[2], v1[3]);
                    asm volatile("" :: "v"(w)); }
    }
};
struct EpiContig { static constexpr bool PERM = true; static constexpr int NST = 16; GAS unsigned char* O; float sc;
    typedef EpiPreNone Pre; __device__ __forceinline__ Pre pre(const Unit&, int, int, int, int) const { return Pre{}; }
    __device__ __forceinline__ void operator()(const Acc& acc, const Unit& u, int wr, int wc, int fr, int fq, const Pre&) const {
        GAS unsigned char* base = O + (size_t)((u.pm * 24 + u.pn) & 511) * 131072u + (size_t)((wr * 4 + wc) * 1024 + (fq * 16 + fr) * 16);
#pragma unroll
        for (int ai = 0; ai < 2; ++ai)
#pragma unroll
            for (int m = 0; m < 4; ++m)
#pragma unroll
                for (int bj = 0; bj < 2; ++bj) { f32x4 v0 = acc[ai][bj][m][0] * sc, v1 = acc[ai][bj][m][1] * sc;
                    u32x4 w; w.x = pk2(v0[0], v0[1]); w.y = pk2(v0[2], v0[3]); w.z = pk2(v1[0], v1[1]); w.w = pk2(v1[2], v1[3]);
                    *(GAS u32x4*)(base + ((ai * 4 + m) * 2 + bj) * 8192) = w; }
    }
};
struct EpiNull { static constexpr bool PERM = true; static constexpr int NST = 0;
    typedef EpiPreNone Pre; __device__ __forceinline__ Pre pre(const Unit&, int, int, int, int) const { return Pre{}; }
    __device__ __forceinline__ void operator()(const Acc& acc, const Unit& u, int wr, int wc, int fr, int fq, const Pre&) const {
#pragma unroll
        for (int ai = 0; ai < 2; ++ai)
#pragma unroll
            for (int bj = 0; bj < 2; ++bj)
#pragma unroll
                for (int m = 0; m < 4; ++m)
#pragma unroll
                    for (int n = 0; n < 2; ++n) asm volatile("" :: "v"(acc[ai][bj][m][n]));
    }
};
}

namespace attn {
constexpr int D = 128, NW = 8, QBLK = 32, KVBLK = 64;
constexpr float SCALE = 0.088388347648318440f;
constexpr float THR = 8.f;
constexpr int LDQ = 128, LDK = 128;
constexpr size_t SHM_V = KVBLK * D * 2, SHM_K = KVBLK * D * 2, SHM_ATTN = 2 * SHM_V + 2 * SHM_K + NW * 64 * 4;
#define KSWZ(row, colB) ((row) * 256 + ((colB) ^ (((row) & 7) << 4)))
#define SBAR() __builtin_amdgcn_sched_barrier(0)
__device__ __forceinline__ unsigned cvtpk(float lo, float hi) { unsigned r; asm volatile("v_cvt_pk_bf16_f32 %0, %1, %2" : "=v"(r) : "v"(lo), "v"(hi)); return r; }
__device__ __forceinline__ bf16x8 ld8(const bf16_t* p) { return *reinterpret_cast<const bf16x8*>(p); }

__device__ __forceinline__ void partialSM(f32x16& p0, f32x16& p1, float& m_reg, float& mn, float& alpha) {
  constexpr float C = SCALE * 1.4426950408889634f;
  float pmax = p0[0]; for (int r = 1; r < 16; ++r) pmax = fmaxf(pmax, p0[r]); for (int r = 0; r < 16; ++r) pmax = fmaxf(pmax, p1[r]);
  { auto rr = __builtin_amdgcn_permlane32_swap(__float_as_uint(pmax), __float_as_uint(pmax), false, false);
    pmax = fmaxf(__uint_as_float(rr[0]), __uint_as_float(rr[1])); }
  if (__builtin_expect(__all(pmax - m_reg <= THR / SCALE), 1)) { mn = m_reg; alpha = 1.f; }
  else { mn = fmaxf(m_reg, pmax); alpha = __builtin_amdgcn_exp2f((m_reg - mn) * C); m_reg = mn; }
  float mnC = -mn * C;
  for (int r = 0; r < 16; ++r) p0[r] = fmaf(p0[r], C, mnC); for (int r = 0; r < 16; ++r) p1[r] = fmaf(p1[r], C, mnC);
  for (int r = 0; r < 16; ++r) p0[r] = __builtin_amdgcn_exp2f(p0[r]);
}
__device__ __forceinline__ void finishSM(f32x16& p0, f32x16& p1, float alpha, float& l_reg, bf16x8& pa0, bf16x8& pa1, bf16x8& pa2, bf16x8& pa3) {
  for (int r = 0; r < 16; ++r) p1[r] = __builtin_amdgcn_exp2f(p1[r]);
  float ps = 0; for (int r = 0; r < 16; ++r) ps += p0[r]; for (int r = 0; r < 16; ++r) ps += p1[r];
  { auto rr = __builtin_amdgcn_permlane32_swap(__float_as_uint(ps), __float_as_uint(ps), false, false);
    ps = __uint_as_float(rr[0]) + __uint_as_float(rr[1]); }
  l_reg = l_reg * alpha + ps;
#define PK4(P, BASE, OUT) do { unsigned a0 = cvtpk(P[BASE + 0], P[BASE + 1]), a1 = cvtpk(P[BASE + 2], P[BASE + 3]);   \
    unsigned b0 = cvtpk(P[BASE + 4], P[BASE + 5]), b1 = cvtpk(P[BASE + 6], P[BASE + 7]);                              \
    auto r0 = __builtin_amdgcn_permlane32_swap(a0, b0, false, false); auto r1 = __builtin_amdgcn_permlane32_swap(a1, b1, false, false); \
    u32x4 w = {r0[0], r1[0], r0[1], r1[1]}; OUT = *reinterpret_cast<bf16x8*>(&w); } while (0)
  PK4(p0, 0, pa0); PK4(p0, 8, pa1); PK4(p1, 0, pa2); PK4(p1, 8, pa3);
#undef PK4
}
__device__ __forceinline__ void qkt(f32x16& p0, f32x16& p1, const bf16_t* Ks, const bf16x8* qr, int r32, int hi) {
  p0 = f32x16{}; p1 = f32x16{};
  for (int d0 = 0; d0 < 8; ++d0) { int cb = (d0 * 16 + hi * 8) * 2;
    bf16x8 b0 = *reinterpret_cast<const bf16x8*>((const char*)Ks + KSWZ(r32, cb));
    bf16x8 b1 = *reinterpret_cast<const bf16x8*>((const char*)Ks + KSWZ(32 + r32, cb));
    p0 = __builtin_amdgcn_mfma_f32_32x32x16_bf16(b0, qr[d0], p0, 0, 0, 0);
    p1 = __builtin_amdgcn_mfma_f32_32x32x16_bf16(b1, qr[d0], p1, 0, 0, 0); }
}
__device__ __forceinline__ int v_st(int k, int c) { const int kk = (k & ~0xC) | ((k & 4) << 1) | ((k & 8) >> 1); return ((kk >> 3) * 4 + (c >> 5)) * 512 + ((kk & 7) * 32 + (c & 31)) * 2; }
__device__ __forceinline__ int v_rd_base(int lane) { return ((lane & 3) << 3) | (((lane >> 2) & 3) << 6) | (((lane >> 4) & 1) << 5) | (((lane >> 5) & 1) << 8); }
constexpr int v_rd_off(int d0, int ks, int half) { return d0 * 512 + ks * 4096 + half * 2048; }
template <int OFF> __device__ __forceinline__ s16x4 tr_read(int vb) {
  s16x4 r; asm volatile("ds_read_b64_tr_b16 %0, %1 offset:%2" : "=&v"(r) : "v"(vb), "i"(OFF) : "memory"); return r;
}
template <int D0> __device__ __forceinline__ void pv_one(f32x16& od, int vb, bf16x8 pa0, bf16x8 pa1, bf16x8 pa2, bf16x8 pa3) {
  const s16x4 l0 = tr_read<v_rd_off(D0, 0, 0)>(vb), h0 = tr_read<v_rd_off(D0, 0, 1)>(vb), l1 = tr_read<v_rd_off(D0, 1, 0)>(vb), h1 = tr_read<v_rd_off(D0, 1, 1)>(vb);
  const s16x4 l2 = tr_read<v_rd_off(D0, 2, 0)>(vb), h2 = tr_read<v_rd_off(D0, 2, 1)>(vb), l3 = tr_read<v_rd_off(D0, 3, 0)>(vb), h3 = tr_read<v_rd_off(D0, 3, 1)>(vb);
  asm volatile("s_waitcnt lgkmcnt(0)" ::: "memory"); SBAR();
#define PK(L, H) (bf16x8){L[0], L[1], L[2], L[3], H[0], H[1], H[2], H[3]}
  od = __builtin_amdgcn_mfma_f32_32x32x16_bf16(pa0, PK(l0, h0), od, 0, 0, 0);
  od = __builtin_amdgcn_mfma_f32_32x32x16_bf16(pa1, PK(l1, h1), od, 0, 0, 0);
  od = __builtin_amdgcn_mfma_f32_32x32x16_bf16(pa2, PK(l2, h2), od, 0, 0, 0);
  od = __builtin_amdgcn_mfma_f32_32x32x16_bf16(pa3, PK(l3, h3), od, 0, 0, 0);
#undef PK
}
__device__ __forceinline__ void pv_d0(f32x16* o, int vb, bf16x8 pa0, bf16x8 pa1, bf16x8 pa2, bf16x8 pa3) {
  pv_one<0>(o[0], vb, pa0, pa1, pa2, pa3); pv_one<1>(o[1], vb, pa0, pa1, pa2, pa3); pv_one<2>(o[2], vb, pa0, pa1, pa2, pa3); pv_one<3>(o[3], vb, pa0, pa1, pa2, pa3);
}
__device__ __forceinline__ void attn_dense_body(const bf16_t* __restrict__ Qb, const bf16_t* __restrict__ Kh, const bf16_t* __restrict__ Vh,
                                                bf16_t* __restrict__ Ob, int ldo, int seq, char* lds, const int tid) {
  const int wid = tid >> 6, lane = tid & 63, r32 = lane & 31, hi = lane >> 5;
  bf16_t* V_lds = (bf16_t*)lds; bf16_t* K_lds = (bf16_t*)(lds + 2 * SHM_V);
  float* ws = (float*)(lds + 2 * SHM_V + 2 * SHM_K) + wid * 64; float* li_l = ws; float* al_l = ws + 32;
  float m_reg = -1e30f, l_reg = 0; f32x16 o[4] = {}; bf16x8 qr[8];
  const bf16_t* Qw = Qb + (long)(wid * QBLK + r32) * LDQ + hi * 8;
#pragma unroll
  for (int d0 = 0; d0 < 8; ++d0) qr[d0] = ld8(Qw + d0 * 16);
  const int sr = tid >> 4, sc = (tid & 15) * 8, vst0 = v_st(sr, sc), vst1 = v_st(32 + sr, sc);
  const int vb0 = (int)(uintptr_t)V_lds + v_rd_base(lane);
  struct { bf16x8 vs0, vs1, ks0, ks1; } sr_[2];
#define SLOAD(i, k0) do { sr_[i].vs0 = ld8(&Vh[(long)((k0) + sr) * LDK + sc]); sr_[i].vs1 = ld8(&Vh[(long)((k0) + 32 + sr) * LDK + sc]); \
    sr_[i].ks0 = ld8(&Kh[(long)((k0) + sr) * LDK + sc]); sr_[i].ks1 = ld8(&Kh[(long)((k0) + 32 + sr) * LDK + sc]); } while (0)
#define SWRITE(b, i) do { *(bf16x8*)((char*)V_lds + (b) * SHM_V + vst0) = sr_[i].vs0;          \
    *(bf16x8*)((char*)V_lds + (b) * SHM_V + vst1) = sr_[i].vs1; int kc = sc * 2;               \
    *(bf16x8*)((char*)K_lds + (b) * SHM_K + KSWZ(sr, kc)) = sr_[i].ks0;                       \
    *(bf16x8*)((char*)K_lds + (b) * SHM_K + KSWZ(32 + sr, kc)) = sr_[i].ks1; } while (0)
#define SWAIT() asm volatile("s_waitcnt vmcnt(4)" ::: "memory")
#define RESC(a) do { if (__any((a) < 1.f)) { if (hi == 0) al_l[r32] = (a); asm volatile("s_waitcnt lgkmcnt(0)" ::: "memory"); \
    for (int d = 0; d < 4; ++d) for (int r = 0; r < 16; ++r) o[d][r] *= al_l[crow(r, hi)]; } } while (0)
  f32x16 pA0, pA1, pB0, pB1; float mnA, mnB, alA, alB; bf16x8 pa0, pa1, pa2, pa3; const int NT = seq / KVBLK;
  constexpr int SE = 0, SO = 1;
  SLOAD(SE, 0); asm volatile("s_waitcnt vmcnt(0)" ::: "memory"); SWRITE(0, SE); __syncthreads();
  qkt(pA0, pA1, K_lds, qr, r32, hi); partialSM(pA0, pA1, m_reg, mnA, alA);
  SLOAD(SO, KVBLK); if (2 < NT) SLOAD(SE, 2 * KVBLK);
  SWAIT(); SWRITE(1, SO); __syncthreads();
  for (int j = 1; j + 1 < NT; j += 2) {
    SBAR(); qkt(pB0, pB1, (bf16_t*)((char*)K_lds + SHM_K), qr, r32, hi);
    finishSM(pA0, pA1, alA, l_reg, pa0, pa1, pa2, pa3); SBAR();
    SLOAD(SO, (j + 2) * KVBLK); SBAR();
    pv_d0(o, vb0, pa0, pa1, pa2, pa3); partialSM(pB0, pB1, m_reg, mnB, alB);
    __syncthreads(); SWAIT(); SWRITE(0, SE);
    RESC(alB); __syncthreads();
    SBAR(); qkt(pA0, pA1, K_lds, qr, r32, hi);
    finishSM(pB0, pB1, alB, l_reg, pa0, pa1, pa2, pa3); SBAR();
    if (j + 3 < NT) SLOAD(SE, (j + 3) * KVBLK); SBAR();
    pv_d0(o, vb0 + (int)SHM_V, pa0, pa1, pa2, pa3); partialSM(pA0, pA1, m_reg, mnA, alA);
    __syncthreads(); SWAIT(); SWRITE(1, SO);
    RESC(alA); __syncthreads();
  }
  SBAR(); qkt(pB0, pB1, (bf16_t*)((char*)K_lds + SHM_K), qr, r32, hi);
  finishSM(pA0, pA1, alA, l_reg, pa0, pa1, pa2, pa3); SBAR();
  pv_d0(o, vb0, pa0, pa1, pa2, pa3); partialSM(pB0, pB1, m_reg, mnB, alB);
  __syncthreads(); RESC(alB);
  finishSM(pB0, pB1, alB, l_reg, pa0, pa1, pa2, pa3); SBAR();
  pv_d0(o, vb0 + (int)SHM_V, pa0, pa1, pa2, pa3);
  if (hi == 0) li_l[r32] = l_reg; asm volatile("s_waitcnt lgkmcnt(0)" ::: "memory");
  float rli[16];
#pragma unroll
  for (int r = 0; r < 16; ++r) rli[r] = __builtin_amdgcn_rcpf(li_l[crow(r, hi)]);
  int wid_o = __builtin_amdgcn_readfirstlane(wid); asm volatile("" : "+s"(wid_o));
  bf16_t* Ow = Ob + (long)(wid_o * QBLK) * ldo;
  int lane_o = lane; asm volatile("" : "+v"(lane_o)); const int r32o = lane_o & 31, hio = lane_o >> 5;
#pragma unroll
  for (int r = 0; r < 16; ++r) { int orow = crow(r, hio);
    for (int d0 = 0; d0 < 4; ++d0) Ow[(long)orow * ldo + d0 * 32 + r32o] = f2bf(o[d0][r] * rli[r]); }
  __syncthreads();
#undef SLOAD
#undef SWRITE
#undef SWAIT
#undef RESC
}
}

struct Args { const float* in[N_IN]; float* out; unsigned char* ws; int ph_lo, ph_hi; };
struct Frame {
    LAS unsigned char* lds;
    unsigned char* ldsg;
    float* out; unsigned char* ws; unsigned* ctl;
    unsigned char* ws0; unsigned lds0;
    int tid, lane, wave, G, gw, NGW, bid;
    int wave0;
};
#define CAS __attribute__((address_space(4)))
__device__ __forceinline__ const float* inptr(int i) { const CAS char* k = (const CAS char*)__builtin_amdgcn_kernarg_segment_ptr(); return *(const float* const volatile CAS*)(k + 8 * i); }
constexpr int LDS_CTL = 64;
constexpr int LDS_REGION = 156 * 1024;
constexpr int LDS_BYTES = LDS_CTL + LDS_REGION;

__device__ __forceinline__ void frame_tid(Frame& F) { int t = F.wave0 * 64 + (int)__builtin_amdgcn_mbcnt_hi(~0u, __builtin_amdgcn_mbcnt_lo(~0u, 0u)); asm volatile("" : "+v"(t)); F.tid = t; F.lane = t & 63; F.wave = __builtin_amdgcn_readfirstlane(t >> 6);
    int bid = blockIdx.x; asm volatile("" : "+s"(bid)); F.bid = bid; F.gw = bid * NWAVES + F.wave;
    unsigned char* w = F.ws0; unsigned lb = F.lds0; asm volatile("" : "+s"(w), "+s"(lb));
    F.ws = w; F.ctl = (unsigned*)(w + WS_CTL); F.lds = (LAS unsigned char*)(uintptr_t)lb + LDS_CTL; F.ldsg = (unsigned char*)F.lds; }
template <typename T> __device__ __forceinline__ T* wsp(const Frame& F, size_t off) { return (T*)(F.ws + off); }

struct CvtItem { const float* src; unsigned ld_src; int f8; unsigned char* dst; };
__device__ __forceinline__ size_t wtile_off(int n, int kbyte, int kb) { return (size_t)(n >> 8) * 256u * (size_t)kb + (size_t)(kbyte >> 7) * 32768u + (size_t)(n & 255) * 128u + (size_t)(kbyte & 127); }
__device__ __forceinline__ void cvt_load(const CvtItem& c, f32x4* v, int lane) {
    const int r4 = lane >> 4, c4 = (lane & 15) * 4;
#pragma unroll
    for (int i = 0; i < 16; ++i) v[i] = __builtin_nontemporal_load((const f32x4*)(c.src + (size_t)(4 * i + r4) * c.ld_src + c4));
}
__device__ __forceinline__ void cvt_store(const CvtItem& c, const f32x4* v, LAS float* scr, int lane) {
    const int r4 = lane >> 4, c4 = (lane & 15) * 4;
#pragma unroll
    for (int i = 0; i < 16; ++i) { LAS float* q = scr + (4 * i + r4) * 65 + c4; q[0] = v[i].x; q[1] = v[i].y; q[2] = v[i].z; q[3] = v[i].w; }
    LDS_WAIT();
    const int cc = lane & 7;
    if (c.f8) {
#pragma unroll
        for (int j = 0; j < 8; ++j) { const int n = (lane >> 3) + 8 * j; const LAS float* t = scr + (8 * cc) * 65 + n;
            u32x2 o; o.x = pk4_fp8(t[0 * 65] * F8_WSCALE, t[1 * 65] * F8_WSCALE, t[2 * 65] * F8_WSCALE, t[3 * 65] * F8_WSCALE); o.y = pk4_fp8(t[4 * 65] * F8_WSCALE, t[5 * 65] * F8_WSCALE, t[6 * 65] * F8_WSCALE, t[7 * 65] * F8_WSCALE);
            __builtin_nontemporal_store(o, (u32x2*)(c.dst + (size_t)n * 128 + 8 * cc)); }
    } else {
#pragma unroll
        for (int j = 0; j < 8; ++j) { const int n = (lane >> 3) + 8 * j; const LAS float* t = scr + (8 * cc) * 65 + n;
            u32x4 o; o.x = pk2(t[0 * 65], t[1 * 65]); o.y = pk2(t[2 * 65], t[3 * 65]); o.z = pk2(t[4 * 65], t[5 * 65]); o.w = pk2(t[6 * 65], t[7 * 65]);
            __builtin_nontemporal_store(o, (u32x4*)(c.dst + (size_t)n * 128 + 16 * cc)); }
    }
    LDS_WAIT();
}
constexpr int TR_SCR = 64 * 65;
constexpr int CVT_NMIX = 16 * 96 + 4 * 16 * 16 + 4 * 8 * 16 + 16 * 16;
__device__ __forceinline__ int cvt_count(int l) { return CVT_NMIX + (((l & 1) == 0) ? (2 * 16 * 44 + 44 * 16) : NEXP * (2 * 16 * 56 + 56 * 16)); }
__device__ __forceinline__ CvtItem cvt_item(const Frame& F, int l, int r) {
    CvtItem c; constexpr int N1 = 16 * 96, N2 = 4 * 16 * 16, N3 = 4 * 8 * 16, N4 = 16 * 16;
    if (r < N1) { const int kb = r / 96, nb = r % 96; c.src = inptr(I_WIN) + (size_t)l * DM * INW + (size_t)(64 * kb) * INW + 64 * nb; c.ld_src = INW; c.f8 = 0; c.dst = wsp<unsigned char>(F, WS_WCAT) + wtile_off(64 * nb, 128 * kb, 2 * DM); return c; } r -= N1;
    if (r < N2) { const int i = r / 256, r2 = r % 256, kb = r2 / 16, nb = r2 % 16; c.src = inptr(I_WGATE) + (size_t)l * 4 * DM * DM + (size_t)i * DM * DM + (size_t)(64 * kb) * DM + 64 * nb; c.ld_src = DM; c.f8 = 1;
        c.dst = wsp<unsigned char>(F, WS_WG8) + wtile_off(i * 1024 + 64 * nb, 64 * kb, DM); return c; } r -= N2;
    if (r < N3) { const int i = r / 128, r2 = r % 128, kb = r2 / 16, nb = r2 % 16; c.src = inptr(I_WBR) + (size_t)l * 4 * 512 * DM + (size_t)i * 512 * DM + (size_t)(64 * kb) * DM + 64 * nb; c.ld_src = DM; c.f8 = 0;
        c.dst = wsp<unsigned char>(F, WS_WB) + wtile_off(i * 1024 + 64 * nb, 128 * kb, 1024); return c; } r -= N3;
    if (r < N4) { const int kb = r / 16, nb = r % 16; c.src = inptr(I_WO) + (size_t)l * DM * DM + (size_t)(64 * kb) * DM + 64 * nb; c.ld_src = DM; c.f8 = 0; c.dst = wsp<unsigned char>(F, WS_WO4) + wtile_off(64 * nb, 128 * kb, 2 * DM); return c; } r -= N4;
    unsigned char* W13 = wsp<unsigned char>(F, (l & 1) ? WS_W13 : WS_W13D); unsigned char* W2 = wsp<unsigned char>(F, (l & 1) ? WS_W2 : WS_W2D);
    const int i = l >> 1; c.f8 = 1;
    if ((l & 1) == 0) { constexpr int NA = 16 * 44;
        if (r < 2 * NA) { const int which = r / NA; r %= NA; const int kb = r / 44, nb = r % 44, n0 = 64 * nb, drow = (n0 >> 7) * 256 + (n0 & 127) + which * 128;
            c.src = inptr(which ? I_FW3 : I_FW1) + (size_t)i * DM * FFD + (size_t)(64 * kb) * FFD + n0; c.ld_src = FFD; c.dst = W13 + wtile_off(drow, 64 * kb, DM); return c; } r -= 2 * NA;
        { const int kb = r / 16, nb = r % 16; c.src = inptr(I_FW2) + (size_t)i * FFD * DM + (size_t)(64 * kb) * DM + 64 * nb; c.ld_src = DM; c.dst = W2 + wtile_off(64 * nb, 64 * kb, FFD); return c; }
    } else { constexpr int NA = 16 * 56, NC = 56 * 16;
        if (r < NEXP * 2 * NA) { const int e = r / (2 * NA); r %= 2 * NA; const int which = r / NA; r %= NA; const int kb = r / 56, nb = r % 56, n0 = 64 * nb, drow = e * 2 * FFE + (n0 >> 7) * 256 + (n0 & 127) + which * 128;
            c.src = inptr(which ? I_MW3 : I_MW1) + (size_t)(i * NEXP + e) * DM * FFE + (size_t)(64 * kb) * FFE + n0; c.ld_src = FFE; c.dst = W13 + wtile_off(drow, 64 * kb, DM); return c; } r -= NEXP * 2 * NA;
        { const int e = r / NC; r %= NC; const int kb = r / 16, nb = r % 16; c.src = inptr(I_MW2) + (size_t)(i * NEXP + e) * FFE * DM + (size_t)(64 * kb) * DM + 64 * nb; c.ld_src = DM; c.dst = W2 + wtile_off(e * DM + 64 * nb, 64 * kb, FFE); return c; }
    }
}
__device__ __forceinline__ void cvt_range(const Frame& F, int l, int i0, int i1, int b0) {
    if (F.bid < b0) return;
    LAS float* scr = (LAS float*)(F.lds) + F.wave * TR_SCR;
    const int stride = (256 - b0) * NWAVES; int it = i0 + (F.bid - b0) * NWAVES + F.wave; if (it >= i1) return;
    CvtItem cur = cvt_item(F, l, it); f32x4 v[16]; cvt_load(cur, v, F.lane);
    for (;;) {
        const int nx = it + stride; const bool has = nx < i1; CvtItem nxt = cur; f32x4 vn[16];
        if (has) { nxt = cvt_item(F, l, nx); cvt_load(nxt, vn, F.lane); }
        cvt_store(cur, v, scr, F.lane);
        if (!has) break;
        cur = nxt; it = nx;
#pragma unroll
        for (int i = 0; i < 16; ++i) v[i] = vn[i];
    }
}
constexpr int CVT_NF_D = 2 * 16 * 44 + 44 * 16, CVT_NF_M = NEXP * (2 * 16 * 56 + 56 * 16), CVT_D1 = 5000, CVT_A1 = 11000, CVT_B1 = 14800;
template <int K> __device__ __forceinline__ void cvt_ffn_share(const Frame& F, int l, int b0) {
    if ((l & 1) || l + 1 >= DEPTH) return;
    const int lo = K == 0 ? CVT_D1 : (K == 1 ? CVT_A1 : CVT_B1), hi = K == 0 ? CVT_A1 : (K == 1 ? CVT_B1 : CVT_NF_M);
    cvt_range(F, l + 1, CVT_NMIX + lo, CVT_NMIX + hi, b0);
}
__device__ __forceinline__ int cvt_e1(int l) { return (l & 1) ? CVT_D1 : CVT_NF_D; }

__device__ __forceinline__ void p0_mod(const Frame& F) {
    LAS float* act = (LAS float*)(F.lds);
    LAS float* red = act + 5 * 1024;
    const float* c = inptr(I_C); const float* cc = inptr(I_CCTX);
    for (int i = F.tid; i < 5 * 1024; i += NTHREADS) { const float v = (i < 4096) ? c[i] : cc[i - 4096]; act[i] = siluf_(v); }
    __syncthreads();
    float* MOD = wsp<float>(F, WS_MOD);
    for (int u = F.bid; u < DEPTH * 96; u += F.G) {
        const int l = u / 96, cg = u % 96, cl = F.tid & 63, ks = F.tid >> 6, col = cg * 64 + cl;
        const float* w = inptr(I_WMOD) + (size_t)l * DM * 6144 + col;
        float a0 = 0.f, a1 = 0.f, a2 = 0.f, a3 = 0.f, a4 = 0.f;
#pragma unroll 16
        for (int k = ks * 128; k < ks * 128 + 128; ++k) { const float wv = w[(size_t)k * 6144];
            a0 += act[k] * wv; a1 += act[1024 + k] * wv; a2 += act[2048 + k] * wv; a3 += act[3072 + k] * wv; a4 += act[4096 + k] * wv; }
        red[(ks * 5 + 0) * 64 + cl] = a0; red[(ks * 5 + 1) * 64 + cl] = a1; red[(ks * 5 + 2) * 64 + cl] = a2; red[(ks * 5 + 3) * 64 + cl] = a3; red[(ks * 5 + 4) * 64 + cl] = a4;
        __syncthreads();
        if (F.tid < 320) { const int j = F.tid >> 6, c2 = F.tid & 63; float s = inptr(I_BMOD)[(size_t)l * 6144 + cg * 64 + c2];
#pragma unroll
            for (int k2 = 0; k2 < 8; ++k2) s += red[(k2 * 5 + j) * 64 + c2];
            MOD[((size_t)l * 5 + j) * 6144 + cg * 64 + c2] = s; }
        __syncthreads();
    }
}

__device__ __forceinline__ void p0_filters(const Frame& F) {
    constexpr int NR = 96, HLD = 72;
    LAS float* FT = (LAS float*)(F.lds);
    LAS float* H1 = FT + NR * 33;
    LAS bf16_t* H2 = (LAS bf16_t*)(H1 + NR * 64);
    LAS float* W1 = (LAS float*)(H2 + 98 * HLD);
    LAS float* W2 = W1 + 33 * 64;
    LAS bf16_t* W3T = (LAS bf16_t*)(W2 + 64 * 64);
    bf16_t* GF = wsp<bf16_t>(F, WS_GF); float* GC = wsp<float>(F, WS_GC);
    const float min_decay = -3.0701134573253944f, max_decay = -15.350567286626972f;
    const int lane = F.lane, r32 = lane & 31, hi = lane >> 5;
    for (int u = F.bid; u < DEPTH * 64; u += F.G) {
        const int l = u / 64, q = u % 64; const bool hasctx = q < 16;
        const float* w1 = inptr(I_HW1) + (size_t)l * 33 * 64; const float* b1 = inptr(I_HB1) + l * 64; const float* w2 = inptr(I_HW2) + (size_t)l * 64 * 64; const float* b2 = inptr(I_HB2) + l * 64;
        const float* w3 = inptr(I_HW3) + (size_t)l * 64 * 2048; const float* fr0 = inptr(I_HFREQ) + l * 128; const float* fr1 = fr0 + 64;
        for (int i = F.tid; i < 33 * 64; i += NTHREADS) W1[i] = w1[i];
        for (int i = F.tid; i < 64 * 64; i += NTHREADS) W2[i] = w2[i];
        for (int idx = F.tid; idx < NR * 33; idx += NTHREADS) { const int R = idx / 33, f = idx % 33; const bool isctx = R >= 68;
            const int L = isctx ? NCTX : SEQ, p = isctx ? 16 * q + R - 68 : 64 * q + R;
            const float t = (float)p / (float)(L - 1); float v;
            if (f == 0) v = t; else { const int k = (f - 1) & 15; const float fk = 1e-4f + (float)k * ((15.0f - 1e-4f) / 15.0f); float qq = (float)p * fk / (float)L; qq -= floorf(qq);
                v = (f <= 16) ? __builtin_amdgcn_cosf(qq) : -__builtin_amdgcn_sinf(qq); }
            FT[idx] = v; }
        __syncthreads();
        for (int idx = F.tid; idx < NR * 64; idx += NTHREADS) { const int R = idx >> 6, jj = idx & 63; float sacc = b1[jj];
#pragma unroll 11
            for (int f = 0; f < 33; ++f) sacc += FT[R * 33 + f] * W1[f * 64 + jj];
            H1[idx] = __builtin_amdgcn_sinf(fr0[jj] * sacc * 0.15915494309189535f); }
        __syncthreads();
        for (int idx = F.tid; idx < NR * 64; idx += NTHREADS) { const int R = idx >> 6, jj = idx & 63; float sacc = b2[jj];
#pragma unroll 16
            for (int k = 0; k < 64; ++k) sacc += H1[R * 64 + k] * W2[k * 64 + jj];
            H2[R * HLD + jj] = f2bf(__builtin_amdgcn_sinf(fr1[jj] * sacc * 0.15915494309189535f)); }
        if (F.tid < 64) H2[NR * HLD + F.tid] = 0;
        __syncthreads();
#pragma unroll 1
        for (int r = 0; r < 4; ++r) {
            const int o = r >> 1, dir = r & 1;
            { const int j = F.tid + 512 * r; float wc[64];
#pragma unroll
              for (int k = 0; k < 64; ++k) wc[k] = w3[(size_t)k * 2048 + j];
#pragma unroll
              for (int k = 0; k < 64; k += 8) *(LAS u32x4*)(W3T + F.tid * HLD + k) = pack8(wc + k); }
            __syncthreads();
#pragma unroll 1
            for (int t2 = 0; t2 < 2; ++t2) {
                const int n0 = 32 * (2 * F.wave + t2), ch = n0 + r32, j = ch + 512 * r;
                f32x16 acc[3] = {};
                const LAS bf16_t* ap = H2 + (r32 + dir) * HLD + 8 * hi; const LAS bf16_t* bp = W3T + (n0 + r32) * HLD + 8 * hi;
#pragma unroll
                for (int k0 = 0; k0 < 64; k0 += 16) { const bf16x8 bv = *(const LAS bf16x8*)(bp + k0);
#pragma unroll
                    for (int mt = 0; mt < 3; ++mt) acc[mt] = __builtin_amdgcn_mfma_f32_32x32x16_bf16(*(const LAS bf16x8*)(ap + mt * 32 * HLD + k0), bv, acc[mt], 0, 0, 0); }
                const float adelta = fabsf(min_decay + (float)j * ((max_decay - min_decay) / 2047.0f));
                bf16_t* grow = GF + (((size_t)l * 2 + o) * 512 + ch) * 8192; float* crow_ = GC + (((size_t)l * 2 + o) * 512 + ch) * 512;
#pragma unroll
                for (int mt = 0; mt < 2; ++mt)
#pragma unroll
                    for (int g = 0; g < 4; ++g) { const int X = 64 * q + 32 * mt + 8 * g + 4 * hi; float v[4];
#pragma unroll
                        for (int e = 0; e < 4; ++e) { const int p = X + dir + e; v[e] = (p < SEQ) ? acc[mt][4 * g + e] * __expf(-(float)p * (1.f / (float)(SEQ - 1)) * adelta) : 0.f; }
                        u32x2 w; if (dir == 0) { w.x = pk2(v[0], v[1]); w.y = pk2(v[2], v[3]); *(u32x2*)(grow + 4096 + X) = w; }
                        else { w.x = pk2(v[3], v[2]); w.y = pk2(v[1], v[0]); *(u32x2*)(grow + 4092 - X) = w; } }
                if (hasctx) {
#pragma unroll
                    for (int g = 0; g < 3; ++g) { const int rr = 8 * g + 4 * hi; if (rr >= 4 && rr < 20) {
#pragma unroll
                        for (int e = 0; e < 4; ++e) { const int p = 16 * q + (rr - 4) + dir + e; const float val = (p < NCTX) ? acc[2][4 * g + e] * __expf(-(float)p * (1.f / (float)(NCTX - 1)) * adelta) : 0.f;
                            if (dir == 0) crow_[256 + p] = val; else crow_[256 - p] = val; } } } }
            }
            __syncthreads();
        }
    }
    if (F.bid == 0) { float* TB = wsp<float>(F, WS_ROPE);
        for (int idx = F.tid; idx < 64 * 32; idx += NTHREADS) { const int v = idx >> 5, k = idx & 31; const float inv = __builtin_amdgcn_exp2f(-(float)k * (13.287712379549449f / 32.0f)); const float rev = (float)v * inv * 0.15915494309189535f;
            TB[idx] = __builtin_amdgcn_cosf(rev); TB[2048 + idx] = __builtin_amdgcn_sinf(rev); } }
}

__device__ __forceinline__ void store_mod_row(const f32x4* v, const float* m0, const float* m1, bf16_t* orow, int lane) {
#pragma unroll
    for (int j = 0; j < 4; ++j) { const f32x4 a = *(const f32x4*)(m0 + 4 * lane + 256 * j), s = *(const f32x4*)(m1 + 4 * lane + 256 * j); const f32x4 u = v[j] * (s + 1.0f) + a;
        u32x2 w; w.x = pk2(u.x, u.y); w.y = pk2(u.z, u.w); *(u32x2*)(orow + 4 * lane + 256 * j) = w; }
}
__device__ __forceinline__ void store_mod_row8(const f32x4* v, const float* m0, const float* m1, unsigned char* orow, int lane) {
#pragma unroll
    for (int j = 0; j < 4; ++j) { const f32x4 a = *(const f32x4*)(m0 + 4 * lane + 256 * j), sc = *(const f32x4*)(m1 + 4 * lane + 256 * j); const f32x4 u = v[j] * (sc + 1.0f) + a;
        *(unsigned*)(orow + 4 * lane + 256 * j) = pk4_fp8(u.x, u.y, u.z, u.w); }
}
__device__ __forceinline__ int row_bsel(int row) { return row < T_LAT ? (row >> 12) : 4; }
__device__ __forceinline__ void p0b_rows(const Frame& F) {
    bf16_t* XF = wsp<bf16_t>(F, WS_XF); bf16_t* U = wsp<bf16_t>(F, WS_U); const float* MOD = wsp<float>(F, WS_MOD);
    f32x4 nv[4];
    if (F.gw < T_ALL) { const int row = F.gw; const float* src = row < T_LAT ? inptr(I_X) + (size_t)row * DM : inptr(I_CTX) + (size_t)(row - T_LAT) * DM;
#pragma unroll
        for (int j = 0; j < 4; ++j) nv[j] = *(const f32x4*)(src + 4 * F.lane + 256 * j); }
    for (int row = F.gw; row < T_ALL; row += F.NGW) {
        f32x4 v[4];
#pragma unroll
        for (int j = 0; j < 4; ++j) v[j] = nv[j];
        if (row + F.NGW < T_ALL) { const int r2 = row + F.NGW; const float* src = r2 < T_LAT ? inptr(I_X) + (size_t)r2 * DM : inptr(I_CTX) + (size_t)(r2 - T_LAT) * DM;
#pragma unroll
            for (int j = 0; j < 4; ++j) nv[j] = *(const f32x4*)(src + 4 * F.lane + 256 * j); }
#pragma unroll
        for (int j = 0; j < 4; ++j) *(u32x2*)(XF + (size_t)row * DM + 4 * F.lane + 256 * j) = f32_bf4(v[j]);
        const float* m = MOD + (size_t)row_bsel(row) * 6144;
        store_mod_row(v, m, m + 1024, U + (size_t)row * DM, F.lane);
        store_mod_row8(v, m, m + 1024, wsp<unsigned char>(F, WS_U8M) + (size_t)row * DM, F.lane);
    }
}
__device__ __forceinline__ void ln_row(f32x4* v, const float* g, const float* b, int lane) {
    float s = 0.f;
#pragma unroll
    for (int j = 0; j < 4; ++j) s += (v[j].x + v[j].y) + (v[j].z + v[j].w);
    const float mean = wave_sum(s, lane) * (1.f / DM); float s2 = 0.f;
#pragma unroll
    for (int j = 0; j < 4; ++j) { v[j] = v[j] - mean; s2 += (v[j].x * v[j].x + v[j].y * v[j].y) + (v[j].z * v[j].z + v[j].w * v[j].w); }
    const float rstd = rsqrtf(wave_sum(s2, lane) * (1.f / DM) + LN_EPS);
#pragma unroll
    for (int j = 0; j < 4; ++j) { const f32x4 gg = *(const f32x4*)(g + 4 * lane + 256 * j), bb = *(const f32x4*)(b + 4 * lane + 256 * j); v[j] = v[j] * rstd * gg + bb; }
}

__device__ __forceinline__ u32x4 ldg8(const bf16_t* p) { return *(const u32x4*)p; }
__device__ __forceinline__ u32x4 ldg8nt(const bf16_t* p) { return __builtin_nontemporal_load((const u32x4*)p); }
struct TokRaw { u32x4 bg, c0, x0, cm, xm, cp, xp, q, kv; float cs[8], sn[8]; };
__device__ __forceinline__ void tok_load(const bf16_t* ZG, const float* TBC, const float* TBS, int tok, bool need_ctx, int c8, int axis, int kf0, TokRaw& r) {
    const bool isctx = tok >= T_LAT; const int t = isctx ? (tok - T_LAT) & 255 : tok & 4095, Ls = isctx ? NCTX : SEQ;
    const bf16_t* zr = ZG + (size_t)tok * ZGW; const u32x4 z4 = {0u, 0u, 0u, 0u};
    if (!isctx || need_ctx) {
        r.bg = ldg8(zr + c8); r.c0 = ldg8(zr + 512 + c8); r.x0 = ldg8(zr + 1024 + c8);
        if (t > 0) { r.cm = ldg8(zr - ZGW + 512 + c8); r.xm = ldg8(zr - ZGW + 1024 + c8); } else { r.cm = z4; r.xm = z4; }
        if (t < Ls - 1) { r.cp = ldg8(zr + ZGW + 512 + c8); r.xp = ldg8(zr + ZGW + 1024 + c8); } else { r.cp = z4; r.xp = z4; }
        r.q = ldg8(zr + OFF_D + c8);
    } else { r.bg = z4; r.c0 = z4; r.x0 = z4; r.cm = z4; r.xm = z4; r.cp = z4; r.xp = z4; r.q = z4; }
    r.kv = ldg8(zr + OFF_D + 512 + c8);
    const int v = axis ? (t & 63) : (t >> 6);
#pragma unroll
    for (int e = 0; e < 8; ++e) { r.cs[e] = isctx ? 1.f : TBC[v * 32 + kf0 + e]; r.sn[e] = isctx ? 0.f : TBS[v * 32 + kf0 + e]; }
}
__device__ __forceinline__ void ph2_tokens(const Frame& F, int l, bool need_ctx) {
    const bf16_t* ZG = wsp<bf16_t>(F, WS_ZG); bf16_t* Y = wsp<bf16_t>(F, WS_Y);
    bf16_t* QP = wsp<bf16_t>(F, WS_QP); bf16_t* QC = wsp<bf16_t>(F, WS_QC); bf16_t* KALL = wsp<bf16_t>(F, WS_KALL); bf16_t* VALL = wsp<bf16_t>(F, WS_VALL);
    const float* TBC = wsp<float>(F, WS_ROPE); const float* TBS = TBC + 2048;
    const int lane = F.lane, c8 = 8 * lane, cc = lane & 15;
    float w0[8], w1[8], w2[8], cb[8], gq[8], gk[8];
    { const float* caw = inptr(I_CAW) + (size_t)l * 3 * 512; const float* cab = inptr(I_CAB) + (size_t)l * 512;
#pragma unroll
      for (int e = 0; e < 8; ++e) { w0[e] = caw[c8 + e]; w1[e] = caw[512 + c8 + e]; w2[e] = caw[1024 + c8 + e]; cb[e] = cab[c8 + e];
          gq[e] = inptr(I_QN)[l * 128 + 8 * cc + e]; gk[e] = inptr(I_KN)[l * 128 + 8 * cc + e]; } }
    const int axis = cc >> 3, half = (cc >> 2) & 1, kf0 = 8 * (cc & 3);
    const int tok_b = F.gw < 256 ? F.gw * 6 : 1536 + (F.gw - 256) * 9, tok_e0 = tok_b + (F.gw < 256 ? 6 : 9), tok_e = tok_e0 < T_ALL ? tok_e0 : T_ALL;
    if (tok_b >= tok_e) return;
    TokRaw cur; tok_load(ZG, TBC, TBS, tok_b, need_ctx, c8, axis, kf0, cur);
    for (int tok = tok_b; tok < tok_e; ++tok) {
        TokRaw nxt = cur; if (tok + 1 < tok_e) tok_load(ZG, TBC, TBS, tok + 1, need_ctx, c8, axis, kf0, nxt);
        const bool isctx = tok >= T_LAT; const int b = isctx ? (tok - T_LAT) >> 8 : tok >> 12, t = isctx ? (tok - T_LAT) & 255 : tok & 4095;
        if (!isctx || need_ctx) {
            float bg[8], c0[8], x0[8], cm[8], xm[8], cp[8], xp[8];
            unpack8(cur.bg, bg); unpack8(cur.c0, c0); unpack8(cur.x0, x0); unpack8(cur.cm, cm); unpack8(cur.xm, xm); unpack8(cur.cp, cp); unpack8(cur.xp, xp);
            float y[8];
#pragma unroll
            for (int e = 0; e < 8; ++e) y[e] = bg[e] * (w0[e] * (cm[e] * xm[e]) + w1[e] * (c0[e] * x0[e]) + w2[e] * (cp[e] * xp[e]) + cb[e]);
            *(u32x4*)(Y + (size_t)tok * YW + c8) = pack8(y);
        }
        if (!isctx || need_ctx) {
            float q[8]; unpack8(cur.q, q);
            float ss = 0.f;
#pragma unroll
            for (int e = 0; e < 8; ++e) ss += q[e] * q[e];
            ss += shfl_xor_l(ss, 1, lane); ss += shfl_xor_l(ss, 2, lane); ss += shfl_xor_l(ss, 4, lane); ss += shfl_xor_l(ss, 8, lane);
            const float r = rsqrtf(ss * (1.f / 128.f) + 1e-6f);
            float o[8];
#pragma unroll
            for (int e = 0; e < 8; ++e) { q[e] = q[e] * r * gq[e]; }
#pragma unroll
            for (int e = 0; e < 8; ++e) { const float pr = shfl_xor_l(q[e], 4, lane); o[e] = half ? (q[e] * cur.cs[e] + pr * cur.sn[e]) : (q[e] * cur.cs[e] - pr * cur.sn[e]); }
            const int head = lane >> 4;
            bf16_t* dst = isctx ? QC + ((size_t)(b * 4 + head) * NCTX + t) * 128 + 8 * cc : QP + ((size_t)(b * 4 + head) * SEQ + t) * 128 + 8 * cc;
            *(u32x4*)dst = pack8(o);
        }
        { const u32x4 raw = cur.kv; float k[8]; unpack8(raw, k);
            float ss = 0.f;
#pragma unroll
            for (int e = 0; e < 8; ++e) ss += k[e] * k[e];
            ss += shfl_xor_l(ss, 1, lane); ss += shfl_xor_l(ss, 2, lane); ss += shfl_xor_l(ss, 4, lane); ss += shfl_xor_l(ss, 8, lane);
            const float r = rsqrtf(ss * (1.f / 128.f) + 1e-6f);
            float o[8];
#pragma unroll
            for (int e = 0; e < 8; ++e) k[e] = k[e] * r * gk[e];
#pragma unroll
            for (int e = 0; e < 8; ++e) { const float pr = shfl_xor_l(k[e], 4, lane); o[e] = half ? (k[e] * cur.cs[e] + pr * cur.sn[e]) : (k[e] * cur.cs[e] - pr * cur.sn[e]); }
            const int hh = (lane >> 4) & 1, pos = isctx ? SEQ + t : t; const size_t off = ((size_t)(b * 2 + hh) * 4352 + pos) * 128 + 8 * cc;
            if (lane < 32) *(u32x4*)(KALL + off) = pack8(o); else *(u32x4*)(VALL + off) = raw; }
        cur = nxt;
    }
}
__device__ __forceinline__ void tr64_write(LAS unsigned char* tile, int row, int ck, u32x4 w) { *(LAS u32x4*)(tile + row * 128 + ((ck ^ ((row >> 3) & 7)) << 4)) = w; }
__device__ __forceinline__ u32x4 tr64_read(const LAS unsigned char* tile, int col, int tk) {
    unsigned short e[8];
#pragma unroll
    for (int i = 0; i < 8; ++i) e[i] = *(const LAS unsigned short*)(tile + (8 * tk + i) * 128 + ((((col >> 3) ^ tk) & 7) << 4) + (col & 7) * 2);
    u32x4 w; w.x = e[0] | ((unsigned)e[1] << 16); w.y = e[2] | ((unsigned)e[3] << 16); w.z = e[4] | ((unsigned)e[5] << 16); w.w = e[6] | ((unsigned)e[7] << 16); return w;
}
__device__ __forceinline__ void ph2_htrans(const Frame& F) {
    const bf16_t* ZG = wsp<bf16_t>(F, WS_ZG); bf16_t* ZHT = wsp<bf16_t>(F, WS_ZHT); bf16_t* ZHTC = wsp<bf16_t>(F, WS_ZHTC);
    LAS unsigned char* tile = F.lds + F.wave * 8192;
    const int lane = F.lane, rr = lane >> 3, ck = lane & 7;
    u32x4 nx[8];
    if (F.gw < 272 * 24) { const int tb = F.gw / 24, cbk = F.gw % 24, tok0 = tb * 64;
#pragma unroll
        for (int r = 0; r < 8; ++r) nx[r] = ldg8(ZG + (size_t)(tok0 + rr + 8 * r) * ZGW + OFF_H + cbk * 64 + 8 * ck); }
    for (int it = F.gw; it < 272 * 24; it += F.NGW) {
        const int tb = it / 24, cbk = it % 24, tok0 = tb * 64;
#pragma unroll
        for (int r = 0; r < 8; ++r) { const int row = rr + 8 * r; tr64_write(tile, row, ck, nx[r]); }
        if (it + F.NGW < 272 * 24) { const int it2 = it + F.NGW, tb2 = it2 / 24, cbk2 = it2 % 24, tok2 = tb2 * 64;
#pragma unroll
            for (int r = 0; r < 8; ++r) nx[r] = ldg8(ZG + (size_t)(tok2 + rr + 8 * r) * ZGW + OFF_H + cbk2 * 64 + 8 * ck); }
        LDS_WAIT();
        const bool isctx = tok0 >= T_LAT; const int b = isctx ? (tok0 - T_LAT) >> 8 : tok0 >> 12, t0 = isctx ? (tok0 - T_LAT) & 255 : tok0 & 4095;
#pragma unroll
        for (int r = 0; r < 8; ++r) { const int ch = rr + 8 * r; const u32x4 w = tr64_read(tile, ch, ck);
            bf16_t* dst = isctx ? ZHTC + ((size_t)(b * 1536 + cbk * 64 + ch) * NCTX + t0 + 8 * ck) : ZHT + ((size_t)(b * 1536 + cbk * 64 + ch) * SEQ + t0 + 8 * ck);
            *(u32x4*)dst = w; }
        LDS_WAIT();
    }
}
__device__ __forceinline__ void ph3b_ytrans(const Frame& F, bool need_ctx) {
    bf16_t* Y = wsp<bf16_t>(F, WS_Y); const bf16_t* YHT = wsp<bf16_t>(F, WS_YHT); const bf16_t* YHTC = wsp<bf16_t>(F, WS_YHTC);
    LAS unsigned char* tile = F.lds + F.wave * 8192;
    const int lane = F.lane, rr = lane >> 3, ck = lane & 7;
    const int ntb = need_ctx ? 272 : 256;
    const int skip = need_ctx ? 32 : 0; if (F.bid < skip) return;
    const int it0 = F.gw - skip * NWAVES, step = F.NGW - skip * NWAVES;
#define YT_LOAD(itx) do { const int tb_ = (itx) / 8, cbk_ = (itx) % 8, tok_ = tb_ * 64; const bool ic_ = tok_ >= T_LAT; const int b_ = ic_ ? (tok_ - T_LAT) >> 8 : tok_ >> 12, t_ = ic_ ? (tok_ - T_LAT) & 255 : tok_ & 4095; \
        _Pragma("unroll") for (int r = 0; r < 8; ++r) { const int ch = rr + 8 * r; \
            nx[r] = ldg8(ic_ ? YHTC + ((size_t)(b_ * 512 + cbk_ * 64 + ch) * NCTX + t_ + 8 * ck) : YHT + ((size_t)(b_ * 512 + cbk_ * 64 + ch) * SEQ + t_ + 8 * ck)); } } while (0)
    u32x4 nx[8];
    if (it0 < ntb * 8) YT_LOAD(it0);
    for (int it = it0; it < ntb * 8; it += step) {
        const int tb = it / 8, cbk = it % 8, tok0 = tb * 64;
#pragma unroll
        for (int r = 0; r < 8; ++r) tr64_write(tile, rr + 8 * r, ck, nx[r]);
        if (it + step < ntb * 8) YT_LOAD(it + step);
        LDS_WAIT();
#pragma unroll
        for (int r = 0; r < 8; ++r) { const int row = rr + 8 * r; *(u32x4*)(Y + (size_t)(tok0 + row) * YW + 1024 + cbk * 64 + 8 * ck) = tr64_read(tile, row, ck); }
        LDS_WAIT();
    }
#undef YT_LOAD
}

constexpr int RLD = 136;
constexpr int RREG = 128 * RLD * 2;
__device__ __forceinline__ void mma_nt128(f32x16& acc, const LAS bf16_t* A, int m0, const LAS bf16_t* Bt, int n0, int r32, int hi) {
    const LAS bf16_t* ap = A + (m0 + r32) * RLD + 8 * hi; const LAS bf16_t* bp = Bt + (n0 + r32) * RLD + 8 * hi;
#pragma unroll
    for (int k0 = 0; k0 < 128; k0 += 16) { const bf16x8 a = *(const LAS bf16x8*)(ap + k0); const bf16x8 b = *(const LAS bf16x8*)(bp + k0);
        acc = __builtin_amdgcn_mfma_f32_32x32x16_bf16(a, b, acc, 0, 0, 0); }
}
__device__ __forceinline__ void mma_nt128x2(f32x16& c0, f32x16& c1, const LAS bf16_t* A, int m0, const LAS bf16_t* Bt, int n0, int r32, int hi) {
    const LAS bf16_t* ap = A + (m0 + r32) * RLD + 8 * hi; const LAS bf16_t* bp = Bt + (n0 + r32) * RLD + 8 * hi;
#pragma unroll 2
    for (int k0 = 0; k0 < 128; k0 += 16) { const bf16x8 a = *(const LAS bf16x8*)(ap + k0); const bf16x8 b0 = *(const LAS bf16x8*)(bp + k0); const bf16x8 b1 = *(const LAS bf16x8*)(bp + 32 * RLD + k0);
        c0 = __builtin_amdgcn_mfma_f32_32x32x16_bf16(a, b0, c0, 0, 0, 0); c1 = __builtin_amdgcn_mfma_f32_32x32x16_bf16(a, b1, c1, 0, 0, 0); }
}
__device__ __forceinline__ int ret_tok0(int b, int n) { return n < 2 ? T_LAT + b * NCTX + n * 128 : b * SEQ + (n - 2) * 128; }
__device__ __forceinline__ void ph2_retkv(const Frame& F, int l) {
    bf16_t* ZG = wsp<bf16_t>(F, WS_ZG); float* KVS = wsp<float>(F, WS_KVS);
    const float* TBC = wsp<float>(F, WS_ROPE); const float* TBS = TBC + 2048;
    LAS bf16_t* VT = (LAS bf16_t*)(F.lds); LAS bf16_t* KF = (LAS bf16_t*)(F.lds + RREG); LAS bf16_t* KB = (LAS bf16_t*)(F.lds + 2 * RREG);
    const int tid = F.tid, lane = F.lane, r32 = lane & 31, hi = lane >> 5, w = F.wave;
    u32x4 raw[2][6];
#define RKV_LOAD(itx) do { const int b_ = (itx) / (4 * NCH), h_ = ((itx) / NCH) & 3, n_ = (itx) % NCH, tk_ = ret_tok0(b_, n_); \
        _Pragma("unroll") for (int r = 0; r < 2; ++r) { const int idx = tid + 512 * r, j = idx & 127, pp = idx >> 7, cc = (pp & 3) + 8 * (pp >> 2); \
            const bf16_t* zr = ZG + (size_t)(tk_ + j) * ZGW + OFF_R + h_ * 128 + 8 * cc; \
            raw[r][0] = ldg8(zr); raw[r][1] = ldg8(zr + 32); raw[r][2] = ldg8(zr + 512); raw[r][3] = ldg8(zr + 512 + 32); raw[r][4] = ldg8(zr + 1024); raw[r][5] = ldg8(zr + 1024 + 32); } } while (0)
    if (F.bid < NBATCH * 4 * NCH) RKV_LOAD(F.bid);
    for (int it = F.bid; it < NBATCH * 4 * NCH; it += F.G) {
        const int b = it / (4 * NCH), h = (it / NCH) & 3, n = it % NCH, tok0 = ret_tok0(b, n); const bool lat = n >= 2;
        const float lgf = -__expf(inptr(I_RDEC)[l * 8 + h]), lgb = -__expf(inptr(I_RDEC)[l * 8 + 4 + h]);
#pragma unroll 2
        for (int r = 0; r < 2; ++r) {
            const int idx = tid + 512 * r, j = idx & 127, pp = idx >> 7, cc = (pp & 3) + 8 * (pp >> 2);
            bf16_t* zr = ZG + (size_t)(tok0 + j) * ZGW + OFF_R + h * 128 + 8 * cc;
            float q1[8], q2[8], k1[8], k2[8]; unpack8(raw[r][0], q1); unpack8(raw[r][1], q2); unpack8(raw[r][2], k1); unpack8(raw[r][3], k2);
            const u32x4 v1raw = raw[r][4], v2raw = raw[r][5];
            const int axis = cc >> 3, kf0 = 8 * (cc & 3), p = lat ? (n - 2) * 128 + j : 0, v = axis ? (p & 63) : (p >> 6);
            float qo1[8], qo2[8], ko1[8], ko2[8];
#pragma unroll
            for (int e = 0; e < 8; ++e) { const float cs = lat ? TBC[v * 32 + kf0 + e] : 1.f, sn = lat ? TBS[v * 32 + kf0 + e] : 0.f;
                qo1[e] = q1[e] * cs - q2[e] * sn; qo2[e] = q2[e] * cs + q1[e] * sn;
                ko1[e] = (k1[e] * cs - k2[e] * sn) * 0.08838834764831845f; ko2[e] = (k2[e] * cs + k1[e] * sn) * 0.08838834764831845f; }
            if (lat) { *(u32x4*)zr = pack8(qo1); *(u32x4*)(zr + 32) = pack8(qo2); }
            const u32x4 kp1 = pack8(ko1), kp2 = pack8(ko2); *(u32x4*)(zr + 512) = kp1; *(u32x4*)(zr + 512 + 32) = kp2;
            float kr1[8], kr2[8]; unpack8(kp1, kr1); unpack8(kp2, kr2);
            const float df = __expf(lgf * (float)(127 - j)), db = __expf(lgb * (float)j);
            const bf16_t va[8] = {(bf16_t)(v1raw.x & 0xffff), (bf16_t)(v1raw.x >> 16), (bf16_t)(v1raw.y & 0xffff), (bf16_t)(v1raw.y >> 16), (bf16_t)(v1raw.z & 0xffff), (bf16_t)(v1raw.z >> 16), (bf16_t)(v1raw.w & 0xffff), (bf16_t)(v1raw.w >> 16)};
            const bf16_t vb[8] = {(bf16_t)(v2raw.x & 0xffff), (bf16_t)(v2raw.x >> 16), (bf16_t)(v2raw.y & 0xffff), (bf16_t)(v2raw.y >> 16), (bf16_t)(v2raw.z & 0xffff), (bf16_t)(v2raw.z >> 16), (bf16_t)(v2raw.w & 0xffff), (bf16_t)(v2raw.w >> 16)};
#pragma unroll
            for (int e = 0; e < 8; ++e) { const int d1 = 8 * cc + e, d2 = d1 + 32;
                VT[d1 * RLD + j] = va[e]; KF[d1 * RLD + j] = f2bf(kr1[e] * df); KB[d1 * RLD + j] = f2bf(kr1[e] * db);
                VT[d2 * RLD + j] = vb[e]; KF[d2 * RLD + j] = f2bf(kr2[e] * df); KB[d2 * RLD + j] = f2bf(kr2[e] * db); }
        }
        if (it + F.G < NBATCH * 4 * NCH) RKV_LOAD(it + F.G);
        __syncthreads();
        { const int dir = w >> 2, mt = w & 3; const LAS bf16_t* KX = dir ? KB : KF;
            f32x16 acc[4] = {};
#pragma unroll
            for (int nt = 0; nt < 4; ++nt) mma_nt128(acc[nt], VT, 32 * mt, KX, 32 * nt, r32, hi);
            float* dst = KVS + (((size_t)(b * 4 + h) * 2 + dir) * NCH + n) * 16384;
#pragma unroll
            for (int nt = 0; nt < 4; ++nt)
#pragma unroll
                for (int r = 0; r < 16; ++r) dst[(32 * mt + crow(r, hi)) * 128 + 32 * nt + r32] = acc[nt][r]; }
        __syncthreads();
    }
#undef RKV_LOAD
}
__device__ __forceinline__ void ret_scan_item(const Frame& F, int l, int item) {
    float* KVS = wsp<float>(F, WS_KVS);
    const int combo = item >> 3, part = item & 7, dir = combo & 1, h = (combo >> 1) & 3;
    const float lg = -__expf(inptr(I_RDEC)[l * 8 + dir * 4 + h]); const float cd = __expf(lg * 128.f);
    float* base = KVS + (size_t)combo * NCH * 16384 + part * 2048 + F.tid * 4;
    bf16_t* baseb = wsp<bf16_t>(F, WS_U) + (size_t)combo * NCH * 16384 + part * 2048 + F.tid * 4;
    float z0 = 0.f; asm volatile("" : "+v"(z0));
    f32x4 s = {z0, z0, z0, z0};
    f32x4 kv[34];
#pragma unroll
    for (int t = 0; t < 34; ++t) { const int n = dir ? (t < 2 ? 1 - t : 35 - t) : t; kv[t] = *(const f32x4*)(base + (size_t)n * 16384); }
#pragma unroll
    for (int t = 0; t < 34; ++t) { const int n = dir ? (t < 2 ? 1 - t : 35 - t) : t; { u32x2 o; o.x = pk2(s.x, s.y); o.y = pk2(s.z, s.w); *(u32x2*)(baseb + (size_t)n * 16384) = o; } s = s * cd + kv[t]; }
}
struct RetPre { u32x4 q[4], k[4], v[4]; };
__device__ __forceinline__ void ret_out_load(const Frame& F, int it, RetPre& p) {
    const bf16_t* ZG = wsp<bf16_t>(F, WS_ZG); const int tid = F.tid;
    const int b = it / (4 * NCH), h = (it / NCH) & 3, n = it % NCH, tok0 = ret_tok0(b, n);
#pragma unroll
    for (int r = 0; r < 4; ++r) { const int cidx = tid + 512 * r, j = cidx >> 4, cc = cidx & 15;
        const bf16_t* zr = ZG + (size_t)(tok0 + j) * ZGW + OFF_R + h * 128 + 8 * cc; p.q[r] = ldg8(zr); p.k[r] = ldg8(zr + 512);
        const int j2 = cidx & 127, c2 = cidx >> 7; p.v[r] = ldg8(ZG + (size_t)(tok0 + j2) * ZGW + OFF_R + 1024 + h * 128 + 8 * c2); }
}
__device__ __forceinline__ void ret_out_item(const Frame& F, int l, int it, RetPre& pre, int it_next) {
    const bf16_t* ZG = wsp<bf16_t>(F, WS_ZG); const bf16_t* KVB = wsp<bf16_t>(F, WS_U); bf16_t* Y = wsp<bf16_t>(F, WS_Y);
    LAS bf16_t* RQ = (LAS bf16_t*)(F.lds); LAS bf16_t* RK = (LAS bf16_t*)(F.lds + RREG); LAS bf16_t* RV = (LAS bf16_t*)(F.lds + 2 * RREG); LAS bf16_t* RP = (LAS bf16_t*)(F.lds + 3 * RREG);
    LAS float* OF = (LAS float*)(F.lds);
    int lane_i = F.lane; asm volatile("" : "+v"(lane_i));
    const int tid = F.tid, lane = lane_i, r32 = lane & 31, hi = lane >> 5, w = F.wave;
    const int b = it / (4 * NCH), h = (it / NCH) & 3, n = it % NCH, tok0 = ret_tok0(b, n);
    const float lgf = -__expf(inptr(I_RDEC)[l * 8 + h]), lgb = -__expf(inptr(I_RDEC)[l * 8 + 4 + h]);
#pragma unroll
    for (int r = 0; r < 4; ++r) {
        const int cidx = tid + 512 * r, j = cidx >> 4, cc = cidx & 15;
        *(LAS u32x4*)(RQ + j * RLD + 8 * cc) = pre.q[r]; *(LAS u32x4*)(RK + j * RLD + 8 * cc) = pre.k[r];
        const int j2 = cidx & 127, c2 = cidx >> 7;
        const u32x4 vraw = pre.v[r];
        const bf16_t vv[8] = {(bf16_t)(vraw.x & 0xffff), (bf16_t)(vraw.x >> 16), (bf16_t)(vraw.y & 0xffff), (bf16_t)(vraw.y >> 16), (bf16_t)(vraw.z & 0xffff), (bf16_t)(vraw.z >> 16), (bf16_t)(vraw.w & 0xffff), (bf16_t)(vraw.w >> 16)};
#pragma unroll
        for (int e = 0; e < 8; ++e) RV[(8 * c2 + e) * RLD + j2] = vv[e];
    }
    const bf16_t* SF = KVB + (((size_t)(b * 4 + h) * 2 + 0) * NCH + n) * 16384; const bf16_t* SB = KVB + (((size_t)(b * 4 + h) * 2 + 1) * NCH + n) * 16384;
    u32x4 sfr[4];
#pragma unroll
    for (int r = 0; r < 4; ++r) sfr[r] = ldg8(SF + (size_t)(tid + 512 * r) * 8);
    __syncthreads();
    const int mt = w >> 1, ntb = 2 * (w & 1);
    {   f32x16 s0 = {}, s1 = {};
        mma_nt128x2(s0, s1, RQ, 32 * mt, RK, 32 * ntb, r32, hi);
#pragma unroll
        for (int r = 0; r < 16; ++r) { const int i = 32 * mt + crow(r, hi);
#pragma unroll
            for (int t = 0; t < 2; ++t) { const int j = 32 * (ntb + t) + r32;
                const float d = (i > j) ? __expf(lgf * (float)(i - j)) : ((i < j) ? __expf(lgb * (float)(j - i)) : 2.f);
                RP[i * RLD + j] = f2bf((t ? s1[r] : s0[r]) * d); } }
    }
    __syncthreads();
#pragma unroll
    for (int r = 0; r < 4; ++r) { const int cidx = tid + 512 * r, row = cidx >> 4, cc = cidx & 15; *(LAS u32x4*)(RK + row * RLD + 8 * cc) = sfr[r]; }
#pragma unroll
    for (int r = 0; r < 4; ++r) sfr[r] = ldg8(SB + (size_t)(tid + 512 * r) * 8);
    __syncthreads();
    f32x16 ao0 = {}, ao1 = {};
    mma_nt128x2(ao0, ao1, RQ, 32 * mt, RK, 32 * ntb, r32, hi);
#pragma unroll
    for (int r = 0; r < 16; ++r) { const float sc = __expf(lgf * (float)(32 * mt + crow(r, hi) + 1)); ao0[r] *= sc; ao1[r] *= sc; }
    mma_nt128x2(ao0, ao1, RP, 32 * mt, RV, 32 * ntb, r32, hi);
    __syncthreads();
    {
        u32x4 gt[4];
#pragma unroll
        for (int r = 0; r < 4; ++r) { const int cidx = tid + 512 * r, j = cidx >> 4, cc = cidx & 15; gt[r] = ldg8(ZG + (size_t)(tok0 + j) * ZGW + OFF_R + 1536 + h * 128 + 8 * cc); }
#pragma unroll
        for (int r = 0; r < 4; ++r) { const int cidx = tid + 512 * r, row = cidx >> 4, cc = cidx & 15; *(LAS u32x4*)(RV + row * RLD + 8 * cc) = sfr[r]; }
#pragma unroll
        for (int r = 0; r < 4; ++r) { const int cidx = tid + 512 * r, j = cidx >> 4, cc = cidx & 15; *(LAS u32x4*)(RP + j * RLD + 8 * cc) = gt[r]; }
    }
    __syncthreads();
    f32x16 ab0 = {}, ab1 = {};
    mma_nt128x2(ab0, ab1, RQ, 32 * mt, RV, 32 * ntb, r32, hi);
    __syncthreads();
#pragma unroll
    for (int r = 0; r < 16; ++r) { const int i = 32 * mt + crow(r, hi); const float sc = __expf(lgb * (float)(128 - i));
        OF[i * 132 + 32 * ntb + r32] = ao0[r] + sc * ab0[r]; OF[i * 132 + 32 * (ntb + 1) + r32] = ao1[r] + sc * ab1[r]; }
    if (it_next >= 0) ret_out_load(F, it_next, pre);
    __syncthreads();
#pragma unroll 4
    for (int rr = 0; rr < 16; ++rr) { const int i = 16 * w + rr; const float v0 = OF[i * 132 + lane], v1 = OF[i * 132 + 64 + lane];
        const float mean = wave_sum(v0 + v1, lane) * (1.f / 128.f); const float d0 = v0 - mean, d1 = v1 - mean; const float rstd = rsqrtf(wave_sum(d0 * d0 + d1 * d1, lane) * (1.f / 128.f) + 1e-6f);
        const size_t tok = (size_t)(tok0 + i);
        const float g0 = bf1(RP[i * RLD + lane]), g1 = bf1(RP[i * RLD + 64 + lane]);
        bf16_t* yp = Y + tok * YW + 512 + h * 128; yp[lane] = f2bf(siluf_(g0) * d0 * rstd); yp[64 + lane] = f2bf(siluf_(g1) * d1 * rstd); }
    __syncthreads();
}

constexpr int HY_GCS = 16960;
constexpr int HY_URS = 13376;
constexpr int HY_PAD = 1024;
constexpr int HY_NSH = 160;
constexpr int HY_GC_OFF = 0, HY_UR_OFF = 4 * HY_GCS, HY_GT_OFF = HY_UR_OFF + 4 * HY_URS, HY_END = HY_GT_OFF + 4 * 8192;
static_assert(HY_END <= LDS_REGION, "hyena LDS");
__device__ __forceinline__ int hy_uphys(int idx) { const int L = 2 * idx; return L + ((L >> 8) << 4); }
__device__ __forceinline__ void dwconv8(const bf16_t* row, int n0, int len, float w0, float w1, float w2, float bias, float* out) {
    float z[10]; unpack8(ldg8(row + n0), z + 1);
    z[0] = n0 > 0 ? bf1(row[n0 - 1]) : 0.f; z[9] = (n0 + 8 < len) ? bf1(row[n0 + 8]) : 0.f;
#pragma unroll
    for (int e = 0; e < 8; ++e) out[e] = w0 * z[e] + w1 * z[e + 1] + w2 * z[e + 2] + bias;
}
struct HyRaw { u32x4 v[4]; bf16_t lo[4], hi[4]; };
__device__ __forceinline__ void hy_raw_load(HyRaw& R, const bf16_t* ZHT, int col, int tid) {
#pragma unroll
    for (int r = 0; r < 4; ++r) { const int gidx = tid + 512 * r, b = gidx >> 9, n0 = (gidx & 511) * 8; const bf16_t* row = ZHT + (size_t)(b * 1536 + col) * SEQ;
        R.v[r] = ldg8(row + n0); R.lo[r] = n0 > 0 ? row[n0 - 1] : (bf16_t)0; R.hi[r] = (n0 + 8 < SEQ) ? row[n0 + 8] : (bf16_t)0; }
}
__device__ __forceinline__ void hy_dw(const HyRaw& R, int r, float w0, float w1, float w2, float bias, float* out) {
    float z[10]; unpack8(R.v[r], z + 1); z[0] = bf1(R.lo[r]); z[9] = bf1(R.hi[r]);
#pragma unroll
    for (int e = 0; e < 8; ++e) out[e] = w0 * z[e] + w1 * z[e + 1] + w2 * z[e + 2] + bias;
}
__device__ __forceinline__ void hyena_item(const Frame& F, int l, int c, bool need_ctx) {
    const bf16_t* ZHT = wsp<bf16_t>(F, WS_ZHT); const bf16_t* ZHTC = wsp<bf16_t>(F, WS_ZHTC); bf16_t* YHT = wsp<bf16_t>(F, WS_YHT); bf16_t* YHTC = wsp<bf16_t>(F, WS_YHTC);
    const bf16_t* GF = wsp<bf16_t>(F, WS_GF); const float* GC = wsp<float>(F, WS_GC);
    const float* hcw = inptr(I_HCW) + (size_t)l * 3 * 1536; const float* hcb = inptr(I_HCB) + (size_t)l * 1536; const float* hsk = inptr(I_HSKIP) + (size_t)l * 2 * 512;
    LAS unsigned char* lds = F.lds; const int tid = F.tid, lane = F.lane, nt = F.wave & 3, kh = F.wave >> 2;
    LAS bf16_t* GT = (LAS bf16_t*)(lds + HY_GT_OFF);
    HyRaw rv, rg; u32x4 gr[2]; u32x2 gx[2];
    hy_raw_load(rv, ZHT, c, tid); hy_raw_load(rg, ZHT, 512 + c, tid);
#define HY_GLOAD(ord, tt) do { const bf16_t* grow = GF + (((size_t)l * 2 + (ord)) * 512 + c) * 8192; gr[0] = ldg8(grow + (tt) * 8); gr[1] = ldg8(grow + ((tt) + 512) * 8); \
        gx[0] = *(const u32x2*)(grow + (tt) * 8 + 8); gx[1] = ((tt) < 511) ? *(const u32x2*)(grow + ((tt) + 512) * 8 + 8) : (u32x2){0u, 0u}; } while (0)
    HY_GLOAD(0, tid);
    __builtin_amdgcn_sched_barrier(0);
    { unsigned z0 = 0u; asm volatile("" : "+v"(z0)); const u32x4 zz = {z0, z0, z0, z0};
      for (int i = tid; i < 4 * HY_URS / 16; i += NTHREADS) *(LAS u32x4*)(lds + HY_UR_OFF + 16 * i) = zz; }
    __syncthreads();
    { const float w0 = hcw[c], w1 = hcw[1536 + c], w2 = hcw[3072 + c], bb = hcb[c];
#pragma unroll
      for (int r = 0; r < 4; ++r) { const int gidx = tid + 512 * r, b = gidx >> 9, n0 = (gidx & 511) * 8; float y[8]; hy_dw(rv, r, w0, w1, w2, bb, y);
          LAS unsigned char* ub = lds + HY_UR_OFF + b * HY_URS;
#pragma unroll
          for (int e = 0; e < 8; ++e) *(LAS bf16_t*)(ub + hy_uphys(4096 - (n0 + e) + HY_PAD)) = f2bf(y[e]);
          __builtin_amdgcn_sched_barrier(0); } }
#pragma unroll 1
    for (int o = 0; o < 2; ++o) {
        int tid_o = tid; asm volatile("" : "+v"(tid_o));
        {
#pragma unroll
          for (int r = 0; r < 2; ++r) { const int i0 = (tid_o + 512 * r) * 8; const u32x4 w = gr[r]; const u32x2 x = gx[r];
              LAS unsigned char* cb = lds + HY_GC_OFF + i0 * 2;
              *(LAS u32x4*)(cb) = w;
              { u32x4 v; v.x = __builtin_amdgcn_alignbit(w.y, w.x, 16); v.y = __builtin_amdgcn_alignbit(w.z, w.y, 16); v.z = __builtin_amdgcn_alignbit(w.w, w.z, 16); v.w = __builtin_amdgcn_alignbit(x.x, w.w, 16); *(LAS u32x4*)(cb + HY_GCS) = v; }
              { u32x4 v; v.x = w.y; v.y = w.z; v.z = w.w; v.w = x.x; *(LAS u32x4*)(cb + 2 * HY_GCS) = v; }
              { u32x4 v; v.x = __builtin_amdgcn_alignbit(w.z, w.y, 16); v.y = __builtin_amdgcn_alignbit(w.w, w.z, 16); v.z = __builtin_amdgcn_alignbit(x.x, w.w, 16); v.w = __builtin_amdgcn_alignbit(x.y, x.x, 16); *(LAS u32x4*)(cb + 3 * HY_GCS) = v; } }
          for (int i = tid_o; i < 4 * 292; i += NTHREADS) { const int s = i / 292, k = i % 292; const int x = 8192 - s + k; if (x < 8480) ((LAS bf16_t*)(lds + HY_GC_OFF + s * HY_GCS))[x] = 0; }
          const int col = 512 * (o + 1) + c; const float w0 = hcw[col], w1 = hcw[1536 + col], w2 = hcw[3072 + col], bb = hcb[col];
#pragma unroll
          for (int r = 0; r < 4; ++r) { const int gidx = tid_o + 512 * r, b = gidx >> 9, n0 = (gidx & 511) * 8; float y[8]; hy_dw(rg, r, w0, w1, w2, bb, y);
              *(LAS u32x4*)(GT + b * 4096 + n0) = pack8(y); __builtin_amdgcn_sched_barrier(0); } }
        if (o == 0) { hy_raw_load(rg, ZHT, 1024 + c, tid_o); HY_GLOAD(1, tid_o); }
        __builtin_amdgcn_sched_barrier(0);
        __syncthreads();
        int lane_o = lane; asm volatile("" : "+v"(lane_o)); const int r32 = lane_o & 31, hi = lane_o >> 5;
        const int il = r32 >> 2, bb_ = r32 & 3;
        const LAS unsigned char* ap = lds + HY_GC_OFF + (r32 & 3) * HY_GCS + ((r32 & ~3) + 1024 * nt + 8 * hi + 16 * HY_NSH * kh) * 2;
        const LAS unsigned char* bbase = lds + HY_UR_OFF + bb_ * HY_URS; const int bL0 = 2 * (HY_PAD - 128 * il + 8 * hi + 16 * HY_NSH * kh);
#define HY_LDA(s) ({ const s16x4 _lo = *(const LAS s16x4*)(ap + 32 * (s)), _hi = *(const LAS s16x4*)(ap + 32 * (s) + 8); (bf16x8){_lo[0], _lo[1], _lo[2], _lo[3], _hi[0], _hi[1], _hi[2], _hi[3]}; })
#define HY_LDB(s) ({ const int _L = bL0 + 32 * (s); *(const LAS bf16x8*)(bbase + _L + ((_L >> 8) << 4)); })
#define HY_STEP(x0, x1, x2, x3, bcur, gnew, bnext, sn) do { __builtin_amdgcn_sched_barrier(0); acc0 = __builtin_amdgcn_mfma_f32_32x32x16_bf16(x0, bcur, acc0, 0, 0, 0); __builtin_amdgcn_sched_barrier(0); \
        gnew = HY_LDA((sn) + 7); bnext = HY_LDB((sn) + 1); __builtin_amdgcn_sched_barrier(0); \
        acc1 = __builtin_amdgcn_mfma_f32_32x32x16_bf16(x1, bcur, acc1, 0, 0, 0); acc2 = __builtin_amdgcn_mfma_f32_32x32x16_bf16(x2, bcur, acc2, 0, 0, 0); acc3 = __builtin_amdgcn_mfma_f32_32x32x16_bf16(x3, bcur, acc3, 0, 0, 0); \
        __builtin_amdgcn_sched_barrier(0); } while (0)
        f32x16 acc0 = {}, acc1 = {}, acc2 = {}, acc3 = {};
        bf16x8 g0 = HY_LDA(0), g1 = HY_LDA(1), g2 = HY_LDA(2), g3 = HY_LDA(3), g4 = HY_LDA(4), g5 = HY_LDA(5), g6 = HY_LDA(6), g7, b0 = HY_LDB(0), b1;
#pragma unroll 1
        for (int s = 0; s < HY_NSH; s += 8) {
            HY_STEP(g0, g2, g4, g6, b0, g7, b1, s);
            HY_STEP(g1, g3, g5, g7, b1, g0, b0, s + 1);
            HY_STEP(g2, g4, g6, g0, b0, g1, b1, s + 2);
            HY_STEP(g3, g5, g7, g1, b1, g2, b0, s + 3);
            HY_STEP(g4, g6, g0, g2, b0, g3, b1, s + 4);
            HY_STEP(g5, g7, g1, g3, b1, g4, b0, s + 5);
            HY_STEP(g6, g0, g2, g4, b0, g5, b1, s + 6);
            HY_STEP(g7, g1, g3, g5, b1, g6, b0, s + 7);
        }
#undef HY_LDA
#undef HY_LDB
#undef HY_STEP
        __syncthreads();
        LAS float* XCH = (LAS float*)(lds + HY_GC_OFF);
        { const f32x16 s0 = kh ? acc0 : acc2, s1 = kh ? acc1 : acc3; LAS float* xp = XCH + (size_t)(F.wave * 2) * 16 * 64 + lane_o;
#pragma unroll
          for (int r = 0; r < 16; ++r) { xp[r * 64] = s0[r]; xp[(16 + r) * 64] = s1[r]; } }
        __syncthreads();
        f32x16 o0 = kh ? acc2 : acc0, o1 = kh ? acc3 : acc1;
        { const LAS float* xp = XCH + (size_t)((F.wave ^ 4) * 2) * 16 * 64 + lane_o;
#pragma unroll
          for (int r = 0; r < 16; ++r) { o0[r] += xp[r * 64]; o1[r] += xp[(16 + r) * 64]; } }
        { const float sk = hsk[o * 512 + c]; const int nb0 = 128 * (8 * nt + il) + 64 * kh;
          LAS unsigned char* ub = lds + HY_UR_OFF + bb_ * HY_URS;
#pragma unroll
          for (int t = 0; t < 2; ++t)
#pragma unroll
              for (int g = 0; g < 4; ++g) { float yv[4];
#pragma unroll
                  for (int q = 0; q < 4; ++q) { const int n = nb0 + 32 * t + 8 * g + 4 * hi + q; const float cv = t ? o1[4 * g + q] : o0[4 * g + q];
                      const float ycur = bf1(*(const LAS bf16_t*)(ub + hy_uphys(4096 - n + HY_PAD))); const float gt = bf1(GT[bb_ * 4096 + n]); yv[q] = gt * (cv + sk * ycur); }
                  const int n4 = nb0 + 32 * t + 8 * g + 4 * hi;
                  if (o == 0) {
#pragma unroll
                      for (int q = 0; q < 4; ++q) *(LAS bf16_t*)(ub + hy_uphys(4096 - (n4 + q) + HY_PAD)) = f2bf(yv[q]); }
                  else { u32x2 pk; pk.x = pk2(yv[0], yv[1]); pk.y = pk2(yv[2], yv[3]); *(u32x2*)(YHT + (size_t)(bb_ * 512 + c) * SEQ + n4) = pk; } } }
        __syncthreads();
    }
    if (need_ctx) {
        LAS float* uc4 = (LAS float*)(lds);
        LAS float* gc = uc4 + 1024;
        LAS float* gt4 = gc + 512;
        LAS float* red4 = gt4 + 1024;
        { const float w0 = hcw[c], w1 = hcw[1536 + c], w2 = hcw[3072 + c], bb = hcb[c];
          if (tid < 128) { const int b = tid >> 5, n0 = (tid & 31) * 8; float y[8]; dwconv8(ZHTC + (size_t)(b * 1536 + c) * NCTX, n0, NCTX, w0, w1, w2, bb, y);
#pragma unroll
              for (int e = 0; e < 8; ++e) uc4[(n0 + e) * 4 + b] = y[e]; } }
#pragma unroll 1
        for (int o = 0; o < 2; ++o) {
            gc[tid] = GC[(((size_t)l * 2 + o) * 512 + c) * 512 + tid];
            { const int col = 512 * (o + 1) + c; const float w0 = hcw[col], w1 = hcw[1536 + col], w2 = hcw[3072 + col], bb = hcb[col];
              if (tid < 128) { const int b = tid >> 5, n0 = (tid & 31) * 8; float y[8]; dwconv8(ZHTC + (size_t)(b * 1536 + col) * NCTX, n0, NCTX, w0, w1, w2, bb, y);
#pragma unroll
                  for (int e = 0; e < 8; ++e) gt4[(n0 + e) * 4 + b] = y[e]; } }
            __syncthreads();
            const float sk = hsk[o * 512 + c]; const int n = tid & 255, mh = tid >> 8;
            { f32x4 acc = {0.f, 0.f, 0.f, 0.f};
#pragma unroll 8
              for (int m = 128 * mh; m < 128 * mh + 128; ++m) acc += *(const LAS f32x4*)(uc4 + 4 * m) * gc[256 + n - m];
              *(LAS f32x4*)(red4 + 4 * tid) = acc; }
            __syncthreads();
            f32x4 res = {0.f, 0.f, 0.f, 0.f};
            if (tid < 256) { const f32x4 s4 = *(const LAS f32x4*)(red4 + 4 * tid) + *(const LAS f32x4*)(red4 + 4 * (tid + 256)); const f32x4 u4 = *(const LAS f32x4*)(uc4 + 4 * n);
                res = *(const LAS f32x4*)(gt4 + 4 * n) * (s4 + u4 * sk); }
            __syncthreads();
            if (tid < 256) { *(LAS f32x4*)(uc4 + 4 * n) = res;
                if (o == 1) {
#pragma unroll
                    for (int b = 0; b < 4; ++b) YHTC[(size_t)(b * 512 + c) * NCTX + n] = f2bf(res[b]); } }
            __syncthreads();
        }
    }
}

__device__ __forceinline__ void ph4b_sum(const Frame& F, int nrows) {
    const bf16_t* ZG = wsp<bf16_t>(F, WS_ZG); bf16_t* MS = wsp<bf16_t>(F, WS_ZHT);
    u32x4 nx[2][4];
    if (F.gw < nrows) { const bf16_t* gp = ZG + (size_t)F.gw * ZGW + OFF_G;
#pragma unroll
        for (int j = 0; j < 2; ++j)
#pragma unroll
            for (int i = 0; i < 4; ++i) nx[j][i] = ldg8nt(gp + i * 1024 + 8 * F.lane + 512 * j); }
    for (int row = F.gw; row < nrows; row += F.NGW) {
        u32x4 cur[2][4];
#pragma unroll
        for (int j = 0; j < 2; ++j)
#pragma unroll
            for (int i = 0; i < 4; ++i) cur[j][i] = nx[j][i];
        if (row + F.NGW < nrows) { const bf16_t* gp = ZG + (size_t)(row + F.NGW) * ZGW + OFF_G;
#pragma unroll
            for (int j = 0; j < 2; ++j)
#pragma unroll
                for (int i = 0; i < 4; ++i) nx[j][i] = ldg8nt(gp + i * 1024 + 8 * F.lane + 512 * j); }
#pragma unroll
        for (int j = 0; j < 2; ++j) { const int col = 8 * F.lane + 512 * j; float a[8], t[8];
            unpack8(cur[j][0], a);
#pragma unroll
            for (int i = 1; i < 4; ++i) { unpack8(cur[j][i], t);
#pragma unroll
                for (int e = 0; e < 8; ++e) a[e] += t[e]; }
            *(u32x4*)(MS + (size_t)row * DM + col) = pack8(a); }
    }
}
__device__ __forceinline__ void ph6_ln1(const Frame& F, int l, int nrows, bool dry = false) {
    bf16_t* XF = wsp<bf16_t>(F, WS_XF); unsigned char* U8 = wsp<unsigned char>(F, WS_U); bf16_t* XFo = dry ? wsp<bf16_t>(F, WS_ZG) : XF; if (dry) U8 = wsp<unsigned char>(F, WS_ZG + (size_t)T_ALL * DM * 4); const float* MODl = wsp<float>(F, WS_MOD) + (size_t)l * 5 * 6144;
    const float* g = inptr(I_LNG) + (size_t)(l * 2 + 0) * DM; const float* bta = inptr(I_LNB) + (size_t)(l * 2 + 0) * DM;
    const bool moe = ((l & 1) != 0) && !dry; const int rpb = nrows / F.G, lane = F.lane; const bf16_t* MIX = wsp<bf16_t>(F, WS_Y);
    LAS float* RT = (LAS float*)(F.lds);
    LAS int* cnt = (LAS int*)(F.lds + 32768);
    LAS unsigned* rec = (LAS unsigned*)(F.lds + 32768 + 64);
    if (moe) { const float* rw = inptr(I_ROUTER) + (size_t)(l >> 1) * DM * NEXP;
        for (int i = F.tid; i < DM * NEXP; i += NTHREADS) RT[i] = rw[i];
        if (F.tid < 16) cnt[F.tid] = 0;
        __syncthreads(); }
    u32x2 nx[4]; u32x2 ny[4];
    { const int row = F.bid * rpb + F.wave;
#pragma unroll
      for (int j = 0; j < 4; ++j) { nx[j] = __builtin_nontemporal_load((const u32x2*)(XF + (size_t)row * DM + 4 * lane + 256 * j)); ny[j] = __builtin_nontemporal_load((const u32x2*)(MIX + (size_t)row * DM + 4 * lane + 256 * j)); } }
    for (int k = F.wave; k < rpb; k += NWAVES) {
        const int row = F.bid * rpb + k; bf16_t* xo = XFo + (size_t)row * DM;
        const float* m = MODl + (size_t)row_bsel(row) * 6144;
        f32x4 v[4]; u32x2 yy[4];
#pragma unroll
        for (int j = 0; j < 4; ++j) { v[j] = bf4_f32(nx[j]); yy[j] = ny[j]; }
        if (k + NWAVES < rpb) { const int rown = row + NWAVES;
#pragma unroll
            for (int j = 0; j < 4; ++j) { nx[j] = __builtin_nontemporal_load((const u32x2*)(XF + (size_t)rown * DM + 4 * lane + 256 * j)); ny[j] = __builtin_nontemporal_load((const u32x2*)(MIX + (size_t)rown * DM + 4 * lane + 256 * j)); } }
#pragma unroll
        for (int j = 0; j < 4; ++j) { const u32x2 y = yy[j]; const f32x4 mm = *(const f32x4*)(m + 2 * 1024 + 4 * lane + 256 * j);
            f32x4 f; f.x = bflo(y.x); f.y = bfhi(y.x); f.z = bflo(y.y); f.w = bfhi(y.y);
            v[j] = v[j] * ALPHA + mm * f; }
        ln_row(v, g, bta, lane);
#pragma unroll
        for (int j = 0; j < 4; ++j) *(u32x2*)(xo + 4 * lane + 256 * j) = f32_bf4(v[j]);
        store_mod_row8(v, m + 3 * 1024, m + 4 * 1024, U8 + (size_t)row * DM, lane);
        if (moe) {
            float lg[8] = {0.f, 0.f, 0.f, 0.f, 0.f, 0.f, 0.f, 0.f};
#pragma unroll
            for (int j = 0; j < 4; ++j) { const f32x4 a = *(const f32x4*)(m + 3 * 1024 + 4 * lane + 256 * j), s = *(const f32x4*)(m + 4 * 1024 + 4 * lane + 256 * j); const f32x4 u = v[j] * (s + 1.0f) + a;
#pragma unroll
                for (int c = 0; c < 4; ++c) { const LAS float* rp = RT + (size_t)(4 * lane + 256 * j + c) * 8; const f32x4 r0 = *(const LAS f32x4*)rp, r1 = *(const LAS f32x4*)(rp + 4); const float uu = u[c];
                    lg[0] += uu * r0.x; lg[1] += uu * r0.y; lg[2] += uu * r0.z; lg[3] += uu * r0.w; lg[4] += uu * r1.x; lg[5] += uu * r1.y; lg[6] += uu * r1.z; lg[7] += uu * r1.w; } }
#pragma unroll
            for (int e = 0; e < 8; ++e) lg[e] = wave_sum(lg[e], lane);
            float v0 = lg[0]; int i0 = 0;
#pragma unroll
            for (int e = 1; e < 8; ++e) if (lg[e] > v0) { v0 = lg[e]; i0 = e; }
            float v1 = -3.0e38f; int i1 = 0;
#pragma unroll
            for (int e = 0; e < 8; ++e) if (e != i0 && lg[e] > v1) { v1 = lg[e]; i1 = e; }
            const float w0 = __builtin_amdgcn_rcpf(1.f + __expf(v1 - v0)), w1 = 1.f - w0;
            if (lane == 0) { const int r0 = __hip_atomic_fetch_add(&cnt[i0], 1, __ATOMIC_RELAXED, __HIP_MEMORY_SCOPE_WORKGROUP), r1 = __hip_atomic_fetch_add(&cnt[i1], 1, __ATOMIC_RELAXED, __HIP_MEMORY_SCOPE_WORKGROUP);
                LAS unsigned* rc = rec + k * 8; rc[0] = (unsigned)i0; rc[1] = (unsigned)r0; rc[2] = (unsigned)i1; rc[3] = (unsigned)r1; rc[4] = __float_as_uint(w0); rc[5] = __float_as_uint(w1); }
        }
    }
    if (moe) {
        __syncthreads();
        if (F.tid < 8) cnt[8 + F.tid] = (int)__hip_atomic_fetch_add(F.ctl + CW_MOE + (l * 8 + F.tid) * 64, (unsigned)cnt[F.tid], __ATOMIC_RELAXED, __HIP_MEMORY_SCOPE_AGENT);
        __syncthreads();
        unsigned* PAIR = wsp<unsigned>(F, WS_PAIR);
        for (int k = F.tid; k < rpb; k += NTHREADS) { const int row = F.bid * rpb + k; const LAS unsigned* rc = rec + k * 8;
            u32x4 a; a.x = rc[0]; a.y = rc[1] + (unsigned)cnt[8 + rc[0]]; a.z = rc[2]; a.w = rc[3] + (unsigned)cnt[8 + rc[2]];
            *(u32x4*)(PAIR + (size_t)row * 8) = a; PAIR[(size_t)row * 8 + 4] = rc[4]; PAIR[(size_t)row * 8 + 5] = rc[5]; }
        __syncthreads();
    }
}
__device__ __forceinline__ void moe_tiles(const Frame& F, int l, bool moe, int nMr, int* ts  , int& ntiles) {
    int acc = 0;
#pragma unroll
    for (int e = 0; e < NEXP; ++e) { ts[e] = moe ? acc : (e ? 0x3fffffff : 0);
        const unsigned c = moe ? __hip_atomic_load(F.ctl + CW_MOE + (l * 8 + e) * 64, __ATOMIC_RELAXED, __HIP_MEMORY_SCOPE_AGENT) : 0u; acc += __builtin_amdgcn_readfirstlane((int)((c + 255u) >> 8)); }
    ntiles = moe ? acc : nMr;
}
__device__ __forceinline__ void ph7_gather(const Frame& F, int l, int nrows) {
    int ts[NEXP], ntiles; moe_tiles(F, l, true, 0, ts, ntiles);
    unsigned* PAIR = wsp<unsigned>(F, WS_PAIR); const unsigned char* U8 = wsp<unsigned char>(F, WS_U); unsigned char* XG = wsp<unsigned char>(F, WS_XG);
    u32x4 na = {0u, 0u, 0u, 0u}, nxr = {0u, 0u, 0u, 0u};
    if (F.gw < nrows) { na = *(const u32x4*)(PAIR + (size_t)F.gw * 8); nxr = ((const u32x4*)(U8 + (size_t)F.gw * DM))[F.lane]; }
    for (int tok = F.gw; tok < nrows; tok += F.NGW) {
        const u32x4 a = na, x0 = nxr;
        if (tok + F.NGW < nrows) { na = *(const u32x4*)(PAIR + (size_t)(tok + F.NGW) * 8); nxr = ((const u32x4*)(U8 + (size_t)(tok + F.NGW) * DM))[F.lane]; }
        int b0 = 0, b1 = 0;
#pragma unroll
        for (int e = 0; e < NEXP; ++e) { b0 = ((int)a.x == e) ? ts[e] : b0; b1 = ((int)a.z == e) ? ts[e] : b1; }
        const unsigned s0 = (unsigned)b0 * 256u + a.y, s1 = (unsigned)b1 * 256u + a.w;
        if (F.lane == 0) { PAIR[(size_t)tok * 8 + 6] = s0; PAIR[(size_t)tok * 8 + 7] = s1; }
        ((u32x4*)(XG + (size_t)s0 * DM))[F.lane] = x0; ((u32x4*)(XG + (size_t)s1 * DM))[F.lane] = x0;
    }
}
__device__ __forceinline__ void ph10_ln2(const Frame& F, int l, int nrows, bool dry = false) {
    bf16_t* XF = wsp<bf16_t>(F, WS_XF); bf16_t* U = dry ? wsp<bf16_t>(F, WS_ZG + (size_t)T_ALL * DM * 4) : wsp<bf16_t>(F, WS_U); bf16_t* XFo = dry ? wsp<bf16_t>(F, WS_ZG) : XF; float* OUTo = dry ? wsp<float>(F, WS_ZG) : F.out; const float* MOD = wsp<float>(F, WS_MOD);
    const float* g = inptr(I_LNG) + (size_t)(l * 2 + 1) * DM; const float* bta = inptr(I_LNB) + (size_t)(l * 2 + 1) * DM;
    const bool moe = (l & 1) != 0; const int lane = F.lane;
    const unsigned* PAIR = wsp<unsigned>(F, WS_PAIR); const bf16_t* YO = wsp<bf16_t>(F, WS_YO);
    for (int row0 = F.gw; row0 < nrows; row0 += 2 * F.NGW) {
        int rows[2]; rows[0] = row0; rows[1] = (row0 + F.NGW < nrows) ? row0 + F.NGW : row0;
        f32x4 v[2][4]; u32x2 ya[2][4], yb[2][4]; float w0[2], w1[2];
#pragma unroll
        for (int h = 0; h < 2; ++h) { const int row = rows[h]; const bf16_t* xr = XF + (size_t)row * DM;
            unsigned s0 = (unsigned)row, s1 = (unsigned)row; w0[h] = 1.f; w1[h] = 0.f;
            if (moe) { const unsigned* pr = PAIR + (size_t)row * 8; w0[h] = __uint_as_float(pr[4]); w1[h] = __uint_as_float(pr[5]); s0 = pr[6]; s1 = pr[7]; }
#pragma unroll
            for (int j = 0; j < 4; ++j) { v[h][j] = bf4_f32(__builtin_nontemporal_load((const u32x2*)(xr + 4 * lane + 256 * j)));
                ya[h][j] = __builtin_nontemporal_load((const u32x2*)(YO + (size_t)s0 * DM + 4 * lane + 256 * j)); yb[h][j] = __builtin_nontemporal_load((const u32x2*)(YO + (size_t)s1 * DM + 4 * lane + 256 * j)); } }
#pragma unroll
        for (int h = 0; h < 2; ++h) { const int row = rows[h];
            const float* m5 = MOD + ((size_t)l * 5 + row_bsel(row)) * 6144 + 5 * 1024;
#pragma unroll
            for (int j = 0; j < 4; ++j) { const u32x2 y0 = ya[h][j], y1 = yb[h][j]; const f32x4 mm = *(const f32x4*)(m5 + 4 * lane + 256 * j);
                f32x4 f; f.x = w0[h] * bflo(y0.x) + w1[h] * bflo(y1.x); f.y = w0[h] * bfhi(y0.x) + w1[h] * bfhi(y1.x); f.z = w0[h] * bflo(y0.y) + w1[h] * bflo(y1.y); f.w = w0[h] * bfhi(y0.y) + w1[h] * bfhi(y1.y);
                v[h][j] = v[h][j] * ALPHA + mm * f; }
            ln_row(v[h], g, bta, lane); }
#pragma unroll
        for (int h = 0; h < 2; ++h) { const int row = rows[h];
            if (l == DEPTH - 1) {
#pragma unroll
                for (int j = 0; j < 4; ++j) *(f32x4*)(OUTo + (size_t)row * DM + 4 * lane + 256 * j) = v[h][j];
            } else {
#pragma unroll
                for (int j = 0; j < 4; ++j) *(u32x2*)(XFo + (size_t)row * DM + 4 * lane + 256 * j) = f32_bf4(v[h][j]);
                const float* m = MOD + ((size_t)(l + 1) * 5 + row_bsel(row)) * 6144;
                store_mod_row(v[h], m, m + 1024, U + (size_t)row * DM, lane);
                if (!dry) store_mod_row8(v[h], m, m + 1024, wsp<unsigned char>(F, WS_U8M) + (size_t)row * DM, lane);
            } }
    }
}

constexpr int NPHL = 12;
constexpr int NPH = 2 + NPHL * DEPTH;
__device__ __forceinline__ bool in_range(int k, int lo, int hi) { asm volatile("" : "+s"(k)); return lo <= k && k < hi; }
__global__ void __launch_bounds__(NTHREADS, 2) mk_fwd(Args args) {
    extern __shared__ __attribute__((aligned(16))) unsigned char lds_raw[];
    Frame F;
    F.lds = (LAS unsigned char*)lds_raw + LDS_CTL; F.ldsg = lds_raw + LDS_CTL; F.lds0 = (unsigned)(uintptr_t)(LAS unsigned char*)lds_raw;
    F.out = args.out; F.ws = args.ws; F.ws0 = args.ws; F.ctl = (unsigned*)(args.ws + WS_CTL);
    F.tid = threadIdx.x; F.lane = F.tid & 63; F.wave = __builtin_amdgcn_readfirstlane(F.tid >> 6); F.wave0 = F.wave; F.G = gridDim.x; F.bid = blockIdx.x; F.gw = blockIdx.x * NWAVES + F.wave; F.NGW = F.G * NWAVES;
    volatile LAS unsigned* lctl = (volatile LAS unsigned*)((LAS unsigned char*)lds_raw);
    if (F.tid < 16) lctl[F.tid] = 0u;
    __syncthreads();
    const int lo = args.ph_lo, hi = args.ph_hi; const bool one = (hi - lo) > 1;
    XcdBarrier bar = xcd_barrier_post(F.ctl + CW_BAR, lctl);
#ifndef MK_REP
#define MK_REP 0
#endif
#ifndef MK_ONLY
#define MK_ONLY -1
#endif
#define EN(j) (MK_ONLY < 0 || MK_ONLY == (j))
#ifndef MK_SUB
#define MK_SUB -1
#endif
#define EN2(j) (MK_SUB < 0 || MK_SUB == (j))
#define IN(k) in_range((k), lo, hi)
#define SEAM(k) do { if (IN(k) && IN((k) + 1)) { xcd_barrier(bar); if (MK_REP == 12) xcd_barrier(bar); } } while (0)
#define QNEXT(headw, dst) do { if (F.tid == 0) lctl[4] = __hip_atomic_fetch_add((headw), 1u, __ATOMIC_RELAXED, __HIP_MEMORY_SCOPE_AGENT); __syncthreads(); dst = __builtin_amdgcn_readfirstlane((int)lctl[4]); __syncthreads(); } while (0)

    if (IN(0) && EN(0)) { frame_tid(F); cvt_range(F, 0, 0, CVT_NMIX + CVT_NF_D, 0); __syncthreads(); p0_mod(F); p0_filters(F); if (MK_REP == 8) { __syncthreads(); p0_mod(F); } if (MK_REP == 14) { __syncthreads(); p0_filters(F); } }
    SEAM(0);
    if (IN(1) && EN(1)) { frame_tid(F); p0b_rows(F); if (MK_REP == 15) p0b_rows(F); }
    SEAM(1);

#pragma unroll 1
    for (int l = 0; l < DEPTH; ++l) {
        const int pb = 2 + NPHL * l; const bool need_ctx = l < DEPTH - 1; const int nrows = need_ctx ? T_ALL : T_LAT, nMr = nrows / 256; const bool moe = (l & 1) != 0;
        if (IN(pb + 0) && EN(2)) { frame_tid(F); pg8::Gemm g{DM, DM, 64, 128, 32768}; pg8::GSched S; S.init(T_ALL / 256, INW / 256, F.G, F.bid, wsp<bf16_t>(F, WS_U), 256u * DM * 2, wsp<bf16_t>(F, WS_WCAT), 256u * DM * 2);
            pg8::EpiPlain E{(GAS bf16_t*)wsp<bf16_t>(F, WS_ZG), ZGW, 1.0f};
            pg8::gemm_phase(F.lds, g, S, E, F.tid);
            if (MK_REP == 5) { __syncthreads(); pg8::gemm_phase(F.lds, g, S, E, F.tid); }
            if (MK_REP == 16) { __syncthreads(); pg8::gemm_phase(F.lds, g, S, pg8::EpiNull{}, F.tid); }
            if (MK_REP == 18 || MK_REP == 19) { __syncthreads(); pg8::GSched S2; S2.init(64, MK_REP == 18 ? 4 : 8, F.G, F.bid, wsp<bf16_t>(F, WS_U), 256u * DM * 2, wsp<bf16_t>(F, WS_WCAT), 256u * DM * 2); pg8::gemm_phase(F.lds, g, S2, pg8::EpiNull{}, F.tid); }
            if (MK_REP == 20) { __syncthreads(); pg8::Gemm g2{DM, 64, 64, 32768, 32768}; pg8::gemm_phase(F.lds, g2, S, pg8::EpiNull{}, F.tid); }
            if (MK_REP == 21) { __syncthreads(); pg8::GSched S2; S2.init(T_ALL / 256, INW / 256, F.G, F.bid, wsp<bf16_t>(F, WS_U), 0u, wsp<bf16_t>(F, WS_WCAT), 0u); pg8::gemm_phase(F.lds, g, S2, pg8::EpiNull{}, F.tid); }
            if (MK_REP == 22) { __syncthreads(); pg8::Gemm g2{2 * DM, DM, DM}; pg8::gemm_phase(F.lds, g2, S, pg8::EpiNull{}, F.tid); }
            if (MK_REP == 23) { __syncthreads(); pg8::Gemm g2{DM, DM, 64, 128, 32768}; pg8::gemm_phase(F.lds, g2, S, pg8::EpiNull{}, F.tid); }
            if (MK_REP == 24) { __syncthreads(); pg8::Gemm g2{DM, 64, DM, 32768, 128}; pg8::gemm_phase(F.lds, g2, S, pg8::EpiNull{}, F.tid); }
            if (MK_REP == 25) { for (int rr = 0; rr < 3; ++rr) { __syncthreads(); pg8::SameSched S2{S}; pg8::gemm_phase(F.lds, g, S2, pg8::EpiNull{}, F.tid); } }
            if (MK_REP == 26) { for (int rr = 0; rr < 3; ++rr) { __syncthreads(); pg8::gemm_phase(F.lds, g, S, pg8::EpiNull{}, F.tid); } }
            if (MK_REP == 27) { for (int rr = 0; rr < 3; ++rr) { __syncthreads(); pg8::gemm_phase(F.lds, g, S, E, F.tid); } }
            if (MK_REP == 28) { for (int rr = 0; rr < 3; ++rr) { __syncthreads(); pg8::gemm_phase<false, 1>(F.lds, g, S, pg8::EpiNull{}, F.tid); } }
            if (MK_REP == 29) { for (int rr = 0; rr < 3; ++rr) { __syncthreads(); pg8::gemm_phase<false, 2>(F.lds, g, S, pg8::EpiNull{}, F.tid); } }
            if (MK_REP == 30) { for (int rr = 0; rr < 3; ++rr) { __syncthreads(); pg8::gemm_phase<false, 3>(F.lds, g, S, pg8::EpiNull{}, F.tid); } }
            if (MK_REP == 31) { for (int rr = 0; rr < 3; ++rr) { __syncthreads(); pg8::EpiZGNoStore E2{F.tid == 1000 ? 2.0f : 1.0f}; pg8::gemm_phase(F.lds, g, S, E2, F.tid); } }
            if (MK_REP == 32) { for (int rr = 0; rr < 3; ++rr) { __syncthreads(); pg8::EpiContig E2{(GAS unsigned char*)wsp<unsigned char>(F, WS_Y), 1.0f}; pg8::gemm_phase(F.lds, g, S, E2, F.tid); } }
            if (MK_REP == 33) { __syncthreads(); pg8::EpiContig E2{(GAS unsigned char*)wsp<unsigned char>(F, WS_Y), 1.0f}; pg8::gemm_phase(F.lds, g, S, E2, F.tid); __syncthreads(); pg8::gemm_phase(F.lds, g, S, E2, F.tid); }
            if (MK_REP == 34) { __syncthreads(); pg8::gemm_phase(F.lds, g, S, E, F.tid); __syncthreads(); pg8::gemm_phase(F.lds, g, S, E, F.tid); }
            if (MK_REP == 17) { __syncthreads(); pg8::Gemm g2{DM / 2, DM, DM}; pg8::gemm_phase(F.lds, g2, S, pg8::EpiNull{}, F.tid); } }
        if (IN(pb + 0) && EN(2)) { frame_tid(F); cvt_ffn_share<0>(F, l, ((T_ALL / 256) * (INW / 256)) % 256); }
        SEAM(pb + 0);
        if (IN(pb + 1) && EN(3)) { frame_tid(F); ph2_tokens(F, l, need_ctx); ph2_htrans(F); if (MK_REP == 1) { ph2_tokens(F, l, need_ctx); ph2_htrans(F); } __syncthreads(); ph2_retkv(F, l); }
        SEAM(pb + 1);
        if (IN(pb + 2) && EN(4)) { frame_tid(F);
            { pg8::Gemm g{DM / 2, DM / 2, 64, 128, 32768}; pg8::GSched S; S.init(nMr, 16, F.G, F.bid, wsp<unsigned char>(F, WS_U8M), 256u * DM, wsp<unsigned char>(F, WS_WG8), 256u * DM);
              pg8::EpiShift E{pg8::EpiZG{(GAS bf16_t*)wsp<bf16_t>(F, WS_ZG), (const GAS float*)(inptr(I_BGATE) + (size_t)l * 4096), 1.0f / F8_WSCALE}};
              pg8::gemm_phase<true>(F.lds, g, S, E, F.tid); }
            frame_tid(F);
            const int xcd_ = F.bid & 7, j_ = F.bid >> 3, au_ = (xcd_ >> 1) * 64 + (2 * (xcd_ & 1) + (j_ >> 4)) * 16 + (j_ & 15);
            for (int k = 0; k < 2; ++k) { const int it = k == 0 ? au_ : ((need_ctx && F.bid >= 64 && F.bid < 80) ? 256 + (F.bid - 64) : -1); if (it < 0) break;
                const bf16_t *Q, *K, *V; bf16_t* O; int seq;
                if (it < 256) { const int b = it >> 6, h = (it >> 4) & 3, qb = it & 15;
                    Q = wsp<bf16_t>(F, WS_QP) + ((size_t)(b * 4 + h) * SEQ + qb * 256) * 128; K = wsp<bf16_t>(F, WS_KALL) + (size_t)(b * 2 + (h >> 1)) * 4352 * 128; V = wsp<bf16_t>(F, WS_VALL) + (size_t)(b * 2 + (h >> 1)) * 4352 * 128;
                    O = wsp<bf16_t>(F, WS_Y) + (size_t)(b * SEQ + qb * 256) * YW + 1536 + h * 128; seq = 4352; }
                else { const int r = it - 256, b = r >> 2, h = r & 3;
                    Q = wsp<bf16_t>(F, WS_QC) + (size_t)(b * 4 + h) * NCTX * 128; K = wsp<bf16_t>(F, WS_KALL) + ((size_t)(b * 2 + (h >> 1)) * 4352 + SEQ) * 128; V = wsp<bf16_t>(F, WS_VALL) + ((size_t)(b * 2 + (h >> 1)) * 4352 + SEQ) * 128;
                    O = wsp<bf16_t>(F, WS_Y) + (size_t)(T_LAT + b * NCTX) * YW + 1536 + h * 128; seq = 256; }
                attn::attn_dense_body(Q, K, V, O, YW, seq, (char*)F.ldsg, F.tid); }
            frame_tid(F);
            for (int k = 0; k < 2; ++k) hyena_item(F, l, F.bid + 256 * k, need_ctx);
            frame_tid(F);
            for (int k = 0; k < 2; ++k) { const int it = k == 0 ? (F.bid >= 64 ? F.bid - 64 : -1) : ((F.bid >= 80 && F.bid < 144) ? 192 + (F.bid - 80) : -1); if (it < 0) break; ret_scan_item(F, l, it); }
        }
        SEAM(pb + 2);
        if (IN(pb + 3) && EN(5)) { frame_tid(F);
            for (int rep = 0; rep < (MK_REP == 4 ? 2 : 1); ++rep) {
            ph3b_ytrans(F, need_ctx); __syncthreads();
            { int it = F.bid; while (it < NBATCH * 4 * NCH && !need_ctx && (it % NCH) < 2) it += F.G;
              if (it < NBATCH * 4 * NCH) { RetPre pre; ret_out_load(F, it, pre);
                for (;;) { int nx = it + F.G; while (nx < NBATCH * 4 * NCH && !need_ctx && (nx % NCH) < 2) nx += F.G; if (nx >= NBATCH * 4 * NCH) nx = -1;
                    ret_out_item(F, l, it, pre, nx); if (nx < 0) break; it = nx; } } } }
        }
        SEAM(pb + 3);
        if (IN(pb + 4) && EN(6)) { frame_tid(F); pg8::Gemm g{512, YW, 64, 128, 32768}; pg8::GSched S; S.init(nMr, 16, F.G, F.bid, wsp<bf16_t>(F, WS_Y), 256u * YW * 2, wsp<bf16_t>(F, WS_WB), 256u * 512 * 2, 2, 512u * 2);
            pg8::EpiGate E{(GAS bf16_t*)wsp<bf16_t>(F, WS_ZG)};
            pg8::gemm_phase(F.lds, g, S, E, F.tid); }
        if (IN(pb + 4) && EN(6)) { frame_tid(F); cvt_ffn_share<1>(F, l, need_ctx ? 64 : 0); }
        SEAM(pb + 4);
        if (IN(pb + 5) && EN(13)) { frame_tid(F); ph4b_sum(F, nrows); if (MK_REP == 13) ph4b_sum(F, nrows); }
        SEAM(pb + 5);
        if (IN(pb + 6) && EN(7)) { frame_tid(F); pg8::Gemm g{DM, DM, 64, 128, 32768}; pg8::GSched S; S.init(nMr, 4, F.G, F.bid, wsp<bf16_t>(F, WS_ZHT), 256u * DM * 2, wsp<bf16_t>(F, WS_WO4), 256u * DM * 2);
            pg8::EpiPlain E{(GAS bf16_t*)wsp<bf16_t>(F, WS_Y), DM, 1.0f};
            pg8::gemm_phase(F.lds, g, S, E, F.tid);
            cvt_ffn_share<2>(F, l, need_ctx ? 16 : 0);
            if (MK_REP == 9) { __syncthreads(); pg8::gemm_phase(F.lds, g, S, E, F.tid); } }
        SEAM(pb + 6);
        if (IN(pb + 7) && EN(8)) { frame_tid(F); if (MK_REP == 16) ph6_ln1(F, l, nrows, true); ph6_ln1(F, l, nrows); }
        SEAM(pb + 7);
        if (IN(pb + 8) && EN(9)) { frame_tid(F); if (moe) { ph7_gather(F, l, nrows); if (MK_REP == 11) ph7_gather(F, l, nrows); } }
        if (moe) SEAM(pb + 8);
        if (IN(pb + 9) && EN(10)) { frame_tid(F);
            const int FF = moe ? FFE : FFD;
            pg8::Gemm g{DM / 2, DM / 2, 64, 128, 32768}; pg8::MoeSched S; S.G = F.G; S.c = F.bid; S.nN = 2 * FF / 256; moe_tiles(F, l, moe, nMr, S.ts, S.ntiles);
            S.A = (const char*)(moe ? wsp<unsigned char>(F, WS_XG) : wsp<unsigned char>(F, WS_U)); S.B = (const char*)wsp<unsigned char>(F, moe ? WS_W13 : WS_W13D); S.a_tile = 256u * DM; S.b_tile = 256u * DM;
            pg8::EpiSwiglu E{(GAS unsigned char*)wsp<unsigned char>(F, WS_HID), FF, 1.0f / F8_WSCALE};
            pg8::gemm_phase<true>(F.lds, g, S, E, F.tid);
            if (MK_REP == 6) { __syncthreads(); pg8::gemm_phase<true>(F.lds, g, S, E, F.tid); }
        }
        SEAM(pb + 9);
        if (IN(pb + 10) && EN(11)) { frame_tid(F);
            const int FF = moe ? FFE : FFD;
            pg8::Gemm g{FF / 2, FF / 2, 64, 128, 32768}; pg8::MoeSched S; S.G = F.G; S.c = F.bid; S.nN = 4; moe_tiles(F, l, moe, nMr, S.ts, S.ntiles);
            S.A = (const char*)wsp<unsigned char>(F, WS_HID); S.B = (const char*)wsp<unsigned char>(F, moe ? WS_W2 : WS_W2D); S.a_tile = 256u * (unsigned)FF; S.b_tile = 256u * (unsigned)FF;
            pg8::EpiPlain E{(GAS bf16_t*)wsp<bf16_t>(F, WS_YO), DM, 1.0f / F8_WSCALE};
            pg8::gemm_phase<true>(F.lds, g, S, E, F.tid);
            if (MK_REP == 10) { __syncthreads(); pg8::gemm_phase<true>(F.lds, g, S, E, F.tid); }
        }
        if (IN(pb + 10) && EN(11) && l + 1 < DEPTH) { frame_tid(F); int ts_[NEXP], nt_; moe_tiles(F, l, moe, nMr, ts_, nt_);
            cvt_range(F, l + 1, 0, CVT_NMIX + cvt_e1(l + 1), (nt_ * 4) & 255); }
        SEAM(pb + 10);
        if (IN(pb + 11) && EN(12)) { frame_tid(F); if (MK_REP == 17) ph10_ln2(F, l, nrows, true); ph10_ln2(F, l, nrows); }
        if (l + 1 < DEPTH) SEAM(pb + 11);
    }
#undef IN
#undef SEAM
#undef QNEXT
}

#ifndef MK_PER_PHASE
#define MK_PER_PHASE 0
#endif
extern "C" void kernel_launch(void* const* d_in, const int* in_sizes, int n_in, void* d_out, int out_size, void* d_ws, size_t ws_size, hipStream_t stream) {
    static int grid = 0;
    if (grid == 0) {
        if (n_in != N_IN || out_size != T_LAT * DM || ws_size < WS_END) { fprintf(stderr, "kernel_launch: unexpected shapes: n_in %d out %d ws %zu (need %zu)\n", n_in, out_size, ws_size, (size_t)WS_END); grid = -1; return; }
        int dev = 0, cus = 0, per_cu = 0;
        if (hipGetDevice(&dev) != hipSuccess || hipDeviceGetAttribute(&cus, hipDeviceAttributeMultiprocessorCount, dev) != hipSuccess) { grid = -1; return; }
        if (hipFuncSetAttribute((const void*)mk_fwd, hipFuncAttributeMaxDynamicSharedMemorySize, LDS_BYTES) != hipSuccess) { fprintf(stderr, "kernel_launch: hipFuncSetAttribute failed\n"); grid = -1; return; }
        if (hipOccupancyMaxActiveBlocksPerMultiprocessor(&per_cu, (const void*)mk_fwd, NTHREADS, LDS_BYTES) != hipSuccess || per_cu < 1) { fprintf(stderr, "kernel_launch: occupancy query says %d\n", per_cu); }
        (void)hipGetLastError();
        grid = cus;
        if (grid != 256) { fprintf(stderr, "kernel_launch: built for 256 CUs, got %d\n", grid); grid = -1; return; }
    }
    if (grid < 0) return;
    (void)hipMemsetAsync((char*)d_ws + WS_CTL, 0, CTL_BYTES, stream);
    Args a{};
    for (int i = 0; i < N_IN; ++i) a.in[i] = (const float*)d_in[i];
    a.out = (float*)d_out; a.ws = (unsigned char*)d_ws;
#if MK_PER_PHASE
    for (int p = 0; p < NPH; ++p) { a.ph_lo = p; a.ph_hi = p + 1; hipLaunchKernelGGL(mk_fwd, dim3(grid), dim3(NTHREADS), LDS_BYTES, stream, a); }
#else
    a.ph_lo = 0; a.ph_hi = NPH; hipLaunchKernelGGL(mk_fwd, dim3(grid), dim3(NTHREADS), LDS_BYTES, stream, a);
#endif
    const hipError_t le = hipPeekAtLastError();
    if (le != hipSuccess) fprintf(stderr, "kernel_launch: launch failed: %s\n", hipGetErrorName(le));
}
```
